# Optimizing an MI355X kernel written in HIP

```python
import jax, jax.numpy as jnp
from jax import lax
import numpy as np

D_MODEL = 1024
BATCH = 32
SEQ = 256
DEPTH = 2
DEC_BATCH = 4
DEC_SEQ = 1024
PAST_LEN = 256

GRID_W = 64
N_HEADS = 8
QK_NOPE = 64
QK_ROPE = 32
QK_DIM = QK_NOPE + QK_ROPE
V_DIM = 64
Q_LORA = 384
KV_LORA = 256
ROPE_THETA = 10000.0
Q_BLOCK = 128
LRU_WIDTH = 1024
LRU_BLOCKS = 8
LRU_BW = LRU_WIDTH // LRU_BLOCKS
CONV_W = 4
LRU_C = 8.0
FF_HIDDEN = -(-8 * D_MODEL // (3 * 256)) * 256
N_MOD = 6
EPS = 1e-6
OFF_KV = Q_LORA
OFF_KR = OFF_KV + KV_LORA
OFF_LX = OFF_KR + QK_ROPE
OFF_LG = OFF_LX + LRU_WIDTH
OFF_MG = OFF_LG + LRU_WIDTH
IN_COLS = OFF_MG + 2 * D_MODEL

kernel_name = "hybrid_mla_rglru_diffusion_step"


def rms_norm(x, g):
    xf = x.astype(jnp.float32)
    y = xf * lax.rsqrt(jnp.mean(xf * xf, axis=-1, keepdims=True) + EPS)
    return (y * g.astype(jnp.float32)).astype(x.dtype)


def axial_rope_tables(n_tokens):
    rows = n_tokens // GRID_W
    row = jnp.repeat(jnp.arange(rows, dtype=jnp.float32), GRID_W)
    col = jnp.tile(jnp.arange(GRID_W, dtype=jnp.float32), rows)
    n_freq = QK_ROPE // 4
    inv = ROPE_THETA ** (-jnp.arange(n_freq, dtype=jnp.float32) / n_freq)
    ang = jnp.concatenate([row[:, None] * inv, col[:, None] * inv], axis=-1)
    return jnp.cos(ang), jnp.sin(ang)


def apply_rope(x, cos, sin):
    half = QK_ROPE // 2
    x1 = x[..., :half].astype(jnp.float32)
    x2 = x[..., half:].astype(jnp.float32)
    return jnp.concatenate([x1 * cos - x2 * sin, x1 * sin + x2 * cos], axis=-1).astype(x.dtype)


def attend(q, k, v):
    b, lq, h, dk = q.shape
    nb = lq // Q_BLOCK
    qb = jnp.swapaxes(q.reshape(b, nb, Q_BLOCK, h, dk), 0, 1)
    scale = dk ** -0.5

    def block(qi):
        s = jnp.einsum("bqhd,bkhd->bhqk", qi, k, preferred_element_type=jnp.float32) * scale
        p = jax.nn.softmax(s, axis=-1).astype(v.dtype)
        return jnp.einsum("bhqk,bkhd->bqhd", p, v)

    o = lax.map(block, qb)
    return jnp.swapaxes(o, 0, 1).reshape(b, lq, h * v.shape[-1])


def centred_conv(x, w, b):
    L = x.shape[1]
    xp = jnp.pad(x, ((0, 0), (CONV_W // 2, CONV_W - 1 - CONV_W // 2), (0, 0)))
    out = b
    for t in range(CONV_W):
        out = out + xp[:, t:t + L] * w[t]
    return out


def block_diag(x, w, b):
    bsz, L, _ = x.shape
    y = jnp.einsum("blnd,nde->blne", x.reshape(bsz, L, LRU_BLOCKS, LRU_BW), w)
    return y.reshape(bsz, L, LRU_WIDTH) + b


def rg_lru_direction(x, w_rg, b_rg, w_ig, b_ig, lam, h0, reverse):
    r = jax.nn.sigmoid(block_diag(x, w_rg, b_rg).astype(jnp.float32))
    i = jax.nn.sigmoid(block_diag(x, w_ig, b_ig).astype(jnp.float32))
    log_a = -LRU_C * jax.nn.softplus(-lam.astype(jnp.float32)) * r
    a = jnp.exp(log_a)
    u = jnp.sqrt(-jnp.expm1(2.0 * log_a)) * i * x.astype(jnp.float32)

    def step(h, au):
        a_t, u_t = au
        h = a_t * h + u_t
        return h, h

    h_last, hs = lax.scan(step, h0.astype(jnp.float32),
                          (jnp.swapaxes(a, 0, 1), jnp.swapaxes(u, 0, 1)), reverse=reverse)
    return jnp.swapaxes(hs, 0, 1), h_last


def mixer(h, p, latent, ckv_ctx, krope_ctx, hf0, hb0):
    b, L, _ = h.shape
    proj = h @ p["w_in"]
    q_lat = proj[..., :OFF_KV]
    kv_lat = proj[..., OFF_KV:OFF_KR]
    k_rope = proj[..., OFF_KR:OFF_LX]
    lru_x = proj[..., OFF_LX:OFF_LG]
    lru_gate = proj[..., OFF_LG:OFF_MG]
    merge = proj[..., OFF_MG:]
    q = (rms_norm(q_lat, p["g_q"]) @ p["w_q_up"]).reshape(b, L, N_HEADS, QK_DIM)
    q_nope, q_rope = q[..., :QK_NOPE], q[..., QK_NOPE:]
    ckv = rms_norm(kv_lat, p["g_kv"])
    if latent:
        cos, sin = axial_rope_tables(L)
        q_rope = apply_rope(q_rope, cos[:, None, :], sin[:, None, :])
        k_rope = apply_rope(k_rope, cos, sin)
        ckv_keys = jnp.concatenate([ckv, ckv_ctx.astype(ckv.dtype)], axis=1)
        krope_keys = jnp.concatenate([k_rope, krope_ctx.astype(k_rope.dtype)], axis=1)
    else:
        ckv_keys, krope_keys = ckv, k_rope
    lk = ckv_keys.shape[1]
    kv = (ckv_keys @ p["w_kv_up"]).reshape(b, lk, N_HEADS, QK_NOPE + V_DIM)
    k = jnp.concatenate([kv[..., :QK_NOPE],
                         jnp.broadcast_to(krope_keys[:, :, None, :], (b, lk, N_HEADS, QK_ROPE))], axis=-1)
    v = kv[..., QK_NOPE:]
    q = jnp.concatenate([q_nope, q_rope], axis=-1)
    y_mla = attend(q, k, v) @ p["w_o_mla"]
    xc = centred_conv(lru_x, p["conv_w"], p["conv_b"])
    hf_seq, hf = rg_lru_direction(xc, p["w_rg"][0], p["b_rg"][0], p["w_ig"][0], p["b_ig"][0],
                                  p["lru_lambda"][0], hf0, False)
    hb_seq, hb = rg_lru_direction(xc, p["w_rg"][1], p["b_rg"][1], p["w_ig"][1], p["b_ig"][1],
                                  p["lru_lambda"][1], hb0, True)
    y_lru = ((hf_seq + hb_seq).astype(h.dtype) * jax.nn.gelu(lru_gate)) @ p["w_o_lru"]
    gates = jax.nn.sigmoid(merge.astype(jnp.float32)).astype(h.dtype)
    y = (gates[..., :D_MODEL] * y_mla + gates[..., D_MODEL:] * y_lru) @ p["w_out"]
    return y, ckv, k_rope, hf, hb


def swiglu(h, p):
    gu = h @ p["w_ffn_in"]
    return (jax.nn.silu(gu[..., :FF_HIDDEN]) * gu[..., FF_HIDDEN:]) @ p["w_ffn_out"]


def layer(x, mod, p, latent, ckv_ctx, krope_ctx, hf0, hb0):
    sh1, sc1, g1, sh2, sc2, g2 = jnp.split(mod, N_MOD, axis=-1)
    h = rms_norm(x, p["g_pre_mix"]) * (1.0 + sc1) + sh1
    y, ckv, krope, hf, hb = mixer(h, p, latent, ckv_ctx, krope_ctx, hf0, hb0)
    x = x + g1 * rms_norm(y, p["g_post_mix"])
    h = rms_norm(x, p["g_pre_ffn"]) * (1.0 + sc2) + sh2
    x = x + g2 * rms_norm(swiglu(h, p), p["g_post_ffn"])
    return x, ckv, krope, hf, hb


def setup_inputs(seed: int = 0) -> dict:
    key = jax.random.key(seed)
    ks = jax.random.split(key, 40)

    def nrm(k, shape, scale):
        return jax.random.normal(k, shape, jnp.float32) * scale

    a0 = jax.random.uniform(ks[30], (DEPTH, 2, LRU_WIDTH), jnp.float32, 0.9, 0.999)
    s0 = a0 ** (1.0 / LRU_C)
    lam = jnp.log(s0) - jnp.log1p(-s0)
    return {
        "x_prompt": nrm(ks[0], (BATCH, SEQ, D_MODEL), 1.0),
        "x_sample": nrm(ks[1], (DEC_BATCH, DEC_SEQ, D_MODEL), 1.0),
        "cache_ckv": nrm(ks[2], (DEC_BATCH, DEPTH, PAST_LEN, KV_LORA), 1.0),
        "cache_krope": nrm(ks[3], (DEC_BATCH, DEPTH, PAST_LEN, QK_ROPE), 1.0),
        "state_lru_fwd": nrm(ks[4], (DEC_BATCH, DEPTH, LRU_WIDTH), 0.5),
        "state_lru_bwd": nrm(ks[5], (DEC_BATCH, DEPTH, LRU_WIDTH), 0.5),
        "c": nrm(ks[6], (DEC_BATCH, D_MODEL), 1.0),
        "c_ctx": nrm(ks[7], (D_MODEL,), 1.0),
        "w_mod": nrm(ks[8], (DEPTH, D_MODEL, N_MOD * D_MODEL), 0.5 * D_MODEL ** -0.5),
        "b_mod": nrm(ks[9], (DEPTH, N_MOD * D_MODEL), 0.1),
        "g_pre_mix": 1.0 + nrm(ks[10], (DEPTH, D_MODEL), 0.05),
        "g_post_mix": 1.0 + nrm(ks[11], (DEPTH, D_MODEL), 0.05),
        "g_pre_ffn": 1.0 + nrm(ks[12], (DEPTH, D_MODEL), 0.05),
        "g_post_ffn": 1.0 + nrm(ks[13], (DEPTH, D_MODEL), 0.05),
        "w_in": nrm(ks[14], (DEPTH, D_MODEL, IN_COLS), D_MODEL ** -0.5),
        "g_q": 1.0 + nrm(ks[15], (DEPTH, Q_LORA), 0.05),
        "w_q_up": nrm(ks[16], (DEPTH, Q_LORA, N_HEADS * QK_DIM), Q_LORA ** -0.5),
        "g_kv": 1.0 + nrm(ks[17], (DEPTH, KV_LORA), 0.05),
        "w_kv_up": nrm(ks[18], (DEPTH, KV_LORA, N_HEADS * (QK_NOPE + V_DIM)), KV_LORA ** -0.5),
        "w_o_mla": nrm(ks[19], (DEPTH, N_HEADS * V_DIM, D_MODEL), (N_HEADS * V_DIM) ** -0.5),
        "conv_w": nrm(ks[20], (DEPTH, CONV_W, LRU_WIDTH), CONV_W ** -0.5),
        "conv_b": nrm(ks[21], (DEPTH, LRU_WIDTH), 0.02),
        "w_rg": nrm(ks[22], (DEPTH, 2, LRU_BLOCKS, LRU_BW, LRU_BW), LRU_BW ** -0.5),
        "b_rg": nrm(ks[23], (DEPTH, 2, LRU_WIDTH), 0.1),
        "w_ig": nrm(ks[24], (DEPTH, 2, LRU_BLOCKS, LRU_BW, LRU_BW), LRU_BW ** -0.5),
        "b_ig": nrm(ks[25], (DEPTH, 2, LRU_WIDTH), 0.1),
        "lru_lambda": lam,
        "w_o_lru": nrm(ks[26], (DEPTH, LRU_WIDTH, D_MODEL), LRU_WIDTH ** -0.5),
        "w_out": nrm(ks[27], (DEPTH, D_MODEL, D_MODEL), D_MODEL ** -0.5),
        "w_ffn_in": nrm(ks[28], (DEPTH, D_MODEL, 2 * FF_HIDDEN), D_MODEL ** -0.5),
        "w_ffn_out": nrm(ks[29], (DEPTH, FF_HIDDEN, D_MODEL), FF_HIDDEN ** -0.5),
    }


def reference(x_prompt, x_sample, cache_ckv, cache_krope, state_lru_fwd, state_lru_bwd, c, c_ctx,
              w_mod, b_mod, g_pre_mix, g_post_mix, g_pre_ffn, g_post_ffn, w_in, g_q, w_q_up, g_kv,
              w_kv_up, w_o_mla, conv_w, conv_b, w_rg, b_rg, w_ig, b_ig, lru_lambda, w_o_lru, w_out,
              w_ffn_in, w_ffn_out):
    def params(l):
        return {"g_pre_mix": g_pre_mix[l], "g_post_mix": g_post_mix[l], "g_pre_ffn": g_pre_ffn[l],
                "g_post_ffn": g_post_ffn[l], "w_in": w_in[l], "g_q": g_q[l], "w_q_up": w_q_up[l],
                "g_kv": g_kv[l], "w_kv_up": w_kv_up[l], "w_o_mla": w_o_mla[l], "conv_w": conv_w[l],
                "conv_b": conv_b[l], "w_rg": w_rg[l], "b_rg": b_rg[l], "w_ig": w_ig[l], "b_ig": b_ig[l],
                "lru_lambda": lru_lambda[l], "w_o_lru": w_o_lru[l], "w_out": w_out[l],
                "w_ffn_in": w_ffn_in[l], "w_ffn_out": w_ffn_out[l]}

    x = x_prompt
    bp = x_prompt.shape[0]
    zeros_state = jnp.zeros((bp, LRU_WIDTH), jnp.float32)
    ckvs, kropes, hfs, hbs = [], [], [], []
    for l in range(DEPTH):
        mod_ctx = jax.nn.silu(c_ctx) @ w_mod[l] + b_mod[l]
        x, ckv, krope, hf, hb = layer(x, mod_ctx, params(l), False, None, None, zeros_state, zeros_state)
        ckvs.append(ckv)
        kropes.append(krope)
        hfs.append(hf)
        hbs.append(hb)
    y_prompt = x
    new_ckv = jnp.stack(ckvs, axis=1).astype(x_prompt.dtype)
    new_krope = jnp.stack(kropes, axis=1).astype(x_prompt.dtype)
    new_lru_fwd = jnp.stack(hfs, axis=1).astype(x_prompt.dtype)
    new_lru_bwd = jnp.stack(hbs, axis=1).astype(x_prompt.dtype)

    x = x_sample
    for l in range(DEPTH):
        mod_lat = (jax.nn.silu(c) @ w_mod[l] + b_mod[l])[:, None, :]
        x, _, _, _, _ = layer(x, mod_lat, params(l), True, cache_ckv[:, l], cache_krope[:, l],
                              state_lru_fwd[:, l], state_lru_bwd[:, l])
    y_sample = x
    return (y_prompt, y_sample, new_ckv, new_krope, new_lru_fwd, new_lru_bwd)
```

```cpp
#include <hip/hip_runtime.h>
#include <hip/hip_cooperative_groups.h>
#include <cstdio>
namespace cg = cooperative_groups;

#ifndef ONE_LAUNCH
#define ONE_LAUNCH 1
#endif

#ifndef PHMASK
#define PHMASK 0xffff
#endif
#define PHK(k) if constexpr (((PHMASK) >> (k)) & 1)
#ifndef LSCALE
#define LSCALE 1.0f
#endif
#ifndef MSCALE
#define MSCALE 1.0f
#endif
#ifndef FSCALE
#define FSCALE 1.0f
#endif
#ifndef OS0
#define OS0 1.0f
#endif
#ifndef OS1
#define OS1 1.0f
#endif
#ifndef OS2
#define OS2 1.0f
#endif
#ifndef OS3
#define OS3 1.0f
#endif
#ifndef OS4
#define OS4 1.0f
#endif
#ifndef OS5
#define OS5 1.0f
#endif
#ifndef ZMASK
#define ZMASK(row, col) false
#endif
#ifndef HSCALE
#define HSCALE 1.0f
#endif
#ifndef BSCALE
#define BSCALE 1.0f
#endif
#ifndef GGVAL
#define GGVAL(x) (x)
#endif
#ifndef GLVAL
#define GLVAL(x) (x)
#endif
#ifndef GLOFF
#define GLOFF 1024
#endif
#ifndef ZSCALE
#define ZSCALE 1.0f
#endif
#define LAS __attribute__((address_space(3)))
typedef unsigned short bf16_t;
typedef short bf16x8 __attribute__((ext_vector_type(8)));
typedef float f32x4 __attribute__((ext_vector_type(4)));
typedef float f32x2 __attribute__((ext_vector_type(2)));
typedef unsigned u32x4 __attribute__((ext_vector_type(4)));
typedef unsigned u32x2 __attribute__((ext_vector_type(2)));

constexpr int D = 1024, MT = 12288, MP = 8192, NKEY = 13312, FF = 2816;
constexpr int INCP = 4864;
constexpr int NTHREADS = 512, LDS_BYTES = 131072;
constexpr float EPS = 1e-6f;
constexpr float LOG2E = 1.4426950408889634f;
constexpr float QSCALE = 0.10206207261596577f * 1.4426950408889634f;

constexpr size_t OFF_CKV = 12582912, OFF_KR = 16777216, OFF_LF = 17301504, OFF_LB = 17367040;

constexpr size_t WS_MODV = 0;
constexpr size_t WS_ROPE = WS_MODV + 2 * 5 * 6144 * 4;
constexpr size_t WS_WIN = WS_ROPE + 2 * 1024 * 16 * 4;
constexpr size_t WS_WFFI = WS_WIN + (size_t)INCP * 1024 * 2;
constexpr size_t WS_WFFO = WS_WFFI + (size_t)5632 * 1024 * 2;
constexpr size_t WS_WOUT = WS_WFFO + (size_t)1024 * 2816 * 2;
constexpr size_t WS_WOLRU = WS_WOUT + (size_t)1024 * 1024 * 2;
constexpr size_t WS_WOMLA = WS_WOLRU + (size_t)1024 * 1024 * 2;
constexpr size_t WS_WQ = WS_WOMLA + (size_t)1024 * 512 * 2;
constexpr size_t WS_WKV = WS_WQ + (size_t)768 * 384 * 2;
constexpr size_t WS_WG = WS_WKV + (size_t)1024 * 256 * 2;
constexpr size_t WS_HBF = WS_WG + (size_t)2 * 8 * 256 * 128 * 2;
constexpr size_t WS_QN = WS_HBF;
constexpr size_t WS_KEYS = WS_QN + (size_t)MT * 384 * 2;
constexpr size_t WS_KRB = WS_KEYS + (size_t)NKEY * 256 * 2;
constexpr size_t WS_AO = WS_HBF;
constexpr size_t WS_PSM = WS_HBF + (size_t)MT * 1024 * 2;
constexpr size_t WS_QB = WS_PSM;
constexpr size_t WS_KN = WS_QB + (size_t)MT * 768 * 2;
constexpr size_t WS_Z = WS_PSM;
constexpr size_t WS_LX = WS_PSM + (size_t)MT * 768 * 4;
constexpr size_t WS_GG = WS_LX + (size_t)MT * 1024 * 4;
constexpr size_t WS_SG = WS_GG + (size_t)MT * 1024 * 2;
constexpr size_t WS_HID = WS_GG;
constexpr size_t WS_VT = WS_SG + (size_t)MT * 2048 * 2;
constexpr size_t WS_HF = WS_VT + (size_t)512 * NKEY * 2;
constexpr size_t WS_END = WS_HF + (size_t)MT * 1024 * 2;

struct Params {
    const float* in[31];
    float* out;
    unsigned char* ws;
    int ph_lo, ph_hi, coop, pad;
};
enum { I_XP = 0, I_XS, I_CCKV, I_CKR, I_SF, I_SB, I_C, I_CCTX, I_WMOD, I_BMOD, I_GPM, I_GQM, I_GPF, I_GQF, I_WIN, I_GQ, I_WQUP, I_GKV,
       I_WKVUP, I_WOMLA, I_CONVW, I_CONVB, I_WRG, I_BRG, I_WIG, I_BIG, I_LAM, I_WOLRU, I_WOUT, I_WFFI, I_WFFO };

__device__ __forceinline__ unsigned char* opq(unsigned char* x) { asm volatile("" : "+s"(x)); return x; }
__device__ __forceinline__ int ozero() { int t = 0; asm volatile("" : "+s"(t)); return t; }
__device__ __forceinline__ int otid() { int t = threadIdx.x; asm volatile("" : "+v"(t)); return t; }
__device__ __forceinline__ int obid() { int t = blockIdx.x; asm volatile("" : "+s"(t)); return t; }
__device__ __forceinline__ int ogrid() { int t = gridDim.x; asm volatile("" : "+s"(t)); return t; }
__device__ __forceinline__ unsigned cvt_pk_bf16(float lo, float hi) { unsigned r; asm volatile("v_cvt_pk_bf16_f32 %0, %1, %2" : "=v"(r) : "v"(lo), "v"(hi)); return r; }
__device__ __forceinline__ float bf2f(bf16_t b) { return __uint_as_float(((unsigned)b) << 16); }
__device__ __forceinline__ bf16_t f2bf(float f) { return (bf16_t)(cvt_pk_bf16(f, 0.f) & 0xffffu); }
__device__ __forceinline__ float wave_sum(float v) {
#pragma unroll
    for (int o = 32; o >= 1; o >>= 1) v += __shfl_xor(v, o);
    return v;
}
__device__ __forceinline__ float fast_sigmoid(float x) { return __builtin_amdgcn_rcpf(1.0f + __builtin_amdgcn_exp2f(-x * LOG2E)); }
__device__ __forceinline__ float gelu_tanh(float x) { const float z = 1.5957691216057308f * (x + 0.044715f * x * x * x); return x * fast_sigmoid(z); }
__device__ __forceinline__ int keyrow_of(int t) { return t < MP ? t : MP + ((t - MP) >> 10) * 1280 + ((t - MP) & 1023); }

namespace pg8 {
constexpr int BM = 256, BK = 64, HALF = 128, HTB = HALF * BK * 2, NXCD = 8, WGM = 8;
__device__ __forceinline__ int lds_byte(int r, int c) { const int st = (r >> 4) * 2 + (c >> 5), rr = r & 15, cc = c & 31, ob = rr * 64 + cc * 2; return st * 1024 + (ob ^ (((ob >> 9) & 1) << 5)); }
__device__ __forceinline__ void stage_rc(int b, int& R, int& C) { const int st = b / 1024, sb = b % 1024, swz = sb ^ (((sb >> 9) & 1) << 5); R = (st >> 1) * 16 + swz / 64; C = (st & 1) * 32 + (swz % 64) / 2; }
__device__ __forceinline__ int perm32(int rho) { const int n = rho >> 4, i = rho & 15; return 8 * (i >> 2) + 4 * n + (i & 3); }
struct Unit { int pm, pn; };
struct Gemm { const bf16_t* A; const bf16_t* Bt; int M, N, K; };
struct StaticOrder {
    int nM, nN, nwg, G, c;
    __device__ void init(int M, int N, int G_, int c_) { nM = M / BM; nN = N / BM; nwg = nM * nN; G = G_; c = c_; }
    __device__ bool next(int i, Unit& u) const {
        const int L = i * G + c; if (L >= nwg) return false;
        int wgid = L; { const int q = nwg / NXCD, r = nwg % NXCD, xcd = wgid % NXCD, off = wgid / NXCD; wgid = (xcd < r ? xcd * (q + 1) : r * (q + 1) + (xcd - r) * q) + off; }
        const int nig = WGM * nN, gid = wgid / nig, fm = gid * WGM, gsz = (nM - fm) < WGM ? (nM - fm) : WGM;
        u.pm = fm + ((wgid % nig) % gsz); u.pn = (wgid % nig) / gsz; return true;
    }
};
template <class Epi>
__device__ __forceinline__ void gemm_phase(LAS unsigned char* lds, const Gemm g, const StaticOrder& S, const Epi& E) {
    int tid_ = threadIdx.x; asm volatile("" : "+v"(tid_));
    const int tid = tid_, wid = __builtin_amdgcn_readfirstlane(tid >> 6), lane = tid & 63, wr = wid >> 2, wc = wid & 3, fr = lane & 15, fq = lane >> 4;
    const int K = g.K, nt = K / BK;
    unsigned voffA[2], voffB[2];
#pragma unroll
    for (int i = 0; i < 2; ++i) { int R, C; stage_rc(tid * 16 + i * 8192, R, C); const int Rb = Epi::PERM ? ((R & ~31) + perm32(R & 31)) : R;
        voffA[i] = (unsigned)(R * K + C) * 2u; voffB[i] = (unsigned)(Rb * K + C) * 2u; }
    const size_t kstep = (size_t)(BK * 2);
    const size_t hstep = (size_t)HALF * K * 2;
    const size_t tstep = 2 * hstep;
    const unsigned ldsw = (unsigned)wid * 1024u;
    const int aoff = lds_byte(wr * 64 + fr, fq * 8), boff = lds_byte(wc * 32 + fr, fq * 8);
#define PG8_SA(b, h) (((b) * 2 + (h)) * HTB)
#define PG8_SB(b, h) ((4 + (b) * 2 + (h)) * HTB)
#define PG8_STAGE(bufoff, gbase, voff) do { _Pragma("unroll") for (int _i = 0; _i < 2; ++_i) \
        __builtin_amdgcn_global_load_lds((const unsigned*)((const char*)(gbase) + (voff)[_i]), (LAS unsigned*)(lds + (bufoff) + ldsw + _i * 8192), 16, 0, 0); } while (0)
#define PG8_LDA(dst, b, h) do { _Pragma("unroll") for (int m = 0; m < 4; ++m) _Pragma("unroll") for (int k = 0; k < 2; ++k) dst[m][k] = *(const LAS bf16x8*)(lds + PG8_SA(b, h) + aoff + m * 2048 + k * 1024); } while (0)
#define PG8_LDB(dst, b, h) do { _Pragma("unroll") for (int n = 0; n < 2; ++n) _Pragma("unroll") for (int k = 0; k < 2; ++k) dst[n][k] = *(const LAS bf16x8*)(lds + PG8_SB(b, h) + boff + n * 2048 + k * 1024); } while (0)
#define PG8_MMA(ai, bj, At, Bt) do { __builtin_amdgcn_s_setprio(1); _Pragma("unroll") for (int m = 0; m < 4; ++m) _Pragma("unroll") for (int n = 0; n < 2; ++n) _Pragma("unroll") for (int k = 0; k < 2; ++k) \
        acc[ai][bj][m][n] = __builtin_amdgcn_mfma_f32_16x16x32_bf16(Bt[n][k], At[m][k], acc[ai][bj][m][n], 0, 0, 0); __builtin_amdgcn_s_setprio(0); } while (0)
#define PG8_WAIT_V(n) asm volatile("s_waitcnt vmcnt(" #n ")" ::: "memory")
#define PG8_WAIT_L(n) asm volatile("s_waitcnt lgkmcnt(" #n ")" ::: "memory")
#define PG8_BAR __builtin_amdgcn_s_barrier()
#define PG8_SCHED __builtin_amdgcn_sched_barrier(0)
    Unit cur, nxt; int ui = 0;
    if (!S.next(0, cur)) return;
    f32x4 acc[2][2][4][2];
#pragma unroll
    for (int a = 0; a < 2; ++a)
#pragma unroll
        for (int b = 0; b < 2; ++b)
#pragma unroll
            for (int m = 0; m < 4; ++m)
#pragma unroll
                for (int n = 0; n < 2; ++n) acc[a][b][m][n] = (f32x4){0.f, 0.f, 0.f, 0.f};
    bf16x8 At[4][2], B0[2][2], B1[2][2];
    const char* cA = (const char*)g.A + (size_t)cur.pm * tstep; const char* cB = (const char*)g.Bt + (size_t)cur.pn * tstep;
    PG8_STAGE(PG8_SB(0, 0), cB, voffB); PG8_STAGE(PG8_SA(0, 0), cA, voffA); PG8_STAGE(PG8_SB(0, 1), cB + hstep, voffB); PG8_STAGE(PG8_SA(0, 1), cA + hstep, voffA);
    if (wr == 1) PG8_BAR;
    PG8_WAIT_V(4); PG8_BAR;
    PG8_STAGE(PG8_SB(1, 0), cB + kstep, voffB); PG8_STAGE(PG8_SA(1, 0), cA + kstep, voffA); PG8_STAGE(PG8_SB(1, 1), cB + hstep + kstep, voffB);
    PG8_WAIT_V(6); PG8_BAR;
    for (;;) {
        const bool has_next = S.next(ui + 1, nxt);
        const char* nA = has_next ? (const char*)g.A + (size_t)nxt.pm * tstep : cA; const char* nB = has_next ? (const char*)g.Bt + (size_t)nxt.pn * tstep : cB;
        for (int t = 0; t < nt; t += 2) {
            const bool last = (t == nt - 2);
            const char* a1 = cA + (size_t)(t + 1) * kstep;
            const char* a2 = last ? nA : cA + (size_t)(t + 2) * kstep; const char* b2 = last ? nB : cB + (size_t)(t + 2) * kstep;
            const char* a3 = a2 + kstep; const char* b3 = b2 + kstep;
            PG8_LDB(B0, 0, 0); PG8_SCHED; PG8_LDA(At, 0, 0); PG8_STAGE(PG8_SA(1, 1), a1 + hstep, voffA);
            PG8_WAIT_L(8); PG8_BAR; PG8_WAIT_L(0); PG8_MMA(0, 0, At, B0); PG8_BAR; PG8_SCHED;
            PG8_LDB(B1, 0, 1); PG8_STAGE(PG8_SB(0, 0), b2, voffB);
            PG8_BAR; PG8_WAIT_L(0); PG8_MMA(0, 1, At, B1); PG8_BAR;
            PG8_LDA(At, 0, 1); PG8_STAGE(PG8_SA(0, 0), a2, voffA);
            PG8_BAR; PG8_WAIT_L(0); PG8_MMA(1, 0, At, B0); PG8_BAR; PG8_SCHED;
            PG8_STAGE(PG8_SB(0, 1), b2 + hstep, voffB);
            PG8_WAIT_V(6); PG8_BAR; PG8_MMA(1, 1, At, B1); PG8_BAR;
            PG8_LDB(B0, 1, 0); PG8_SCHED; PG8_LDA(At, 1, 0); PG8_STAGE(PG8_SA(0, 1), a2 + hstep, voffA);
            PG8_WAIT_L(8); PG8_BAR; PG8_WAIT_L(0); PG8_MMA(0, 0, At, B0); PG8_BAR; PG8_SCHED;
            PG8_LDB(B1, 1, 1); PG8_STAGE(PG8_SB(1, 0), b3, voffB);
            PG8_BAR; PG8_WAIT_L(0); PG8_MMA(0, 1, At, B1); PG8_BAR;
            PG8_LDA(At, 1, 1); PG8_STAGE(PG8_SA(1, 0), a3, voffA);
            PG8_BAR; PG8_WAIT_L(0); PG8_MMA(1, 0, At, B0); PG8_BAR; PG8_SCHED;
            PG8_STAGE(PG8_SB(1, 1), b3 + hstep, voffB);
            PG8_WAIT_V(6); PG8_BAR; PG8_MMA(1, 1, At, B1); PG8_BAR;
        }
        E(acc, cur, wr, wc, fr, fq);
        if (!has_next) break;
#pragma unroll
        for (int a = 0; a < 2; ++a)
#pragma unroll
            for (int b = 0; b < 2; ++b)
#pragma unroll
                for (int m = 0; m < 4; ++m)
#pragma unroll
                    for (int n = 0; n < 2; ++n) acc[a][b][m][n] = (f32x4){0.f, 0.f, 0.f, 0.f};
        cur = nxt; cA = nA; cB = nB; ++ui;
    }
    PG8_WAIT_V(0);
    if (wr == 0) PG8_BAR;
    PG8_BAR;
#undef PG8_SA
#undef PG8_SB
#undef PG8_STAGE
#undef PG8_LDA
#undef PG8_LDB
#undef PG8_MMA
#undef PG8_WAIT_V
#undef PG8_WAIT_L
#undef PG8_BAR
#undef PG8_SCHED
}
}
using pg8::Unit;
typedef f32x4 AccT[2][2][4][2];

__device__ __forceinline__ u32x4 pack8(f32x4 a, f32x4 b) { u32x4 w; w.x = cvt_pk_bf16(a[0], a[1]); w.y = cvt_pk_bf16(a[2], a[3]); w.z = cvt_pk_bf16(b[0], b[1]); w.w = cvt_pk_bf16(b[2], b[3]); return w; }
__device__ __forceinline__ u32x2 pack4(f32x4 a) { u32x2 w; w.x = cvt_pk_bf16(a[0], a[1]); w.y = cvt_pk_bf16(a[2], a[3]); return w; }
__device__ __forceinline__ void unpack8(u32x4 w, f32x4& a, f32x4& b) {
    a[0] = __uint_as_float(w.x << 16); a[1] = __uint_as_float(w.x & 0xffff0000u); a[2] = __uint_as_float(w.y << 16); a[3] = __uint_as_float(w.y & 0xffff0000u);
    b[0] = __uint_as_float(w.z << 16); b[1] = __uint_as_float(w.z & 0xffff0000u); b[2] = __uint_as_float(w.w << 16); b[3] = __uint_as_float(w.w & 0xffff0000u);
}

struct EpiIn {
    static constexpr bool PERM = true;
    float* psm; float* lx; bf16_t* gg; bf16_t* sg; bf16_t* g2;
    __device__ __forceinline__ void operator()(const AccT& acc, const Unit& u, int wr, int wc, int fr, int fq) const {
        const int row0 = u.pm * 256 + wr * 64 + fr, colb = u.pn * 256 + wc * 32 + 8 * fq;
#pragma unroll
        for (int ai = 0; ai < 2; ++ai)
#pragma unroll
            for (int m = 0; m < 4; ++m) {
                const size_t row = (size_t)(row0 + ai * 128 + m * 16);
#pragma unroll
                for (int bj = 0; bj < 2; ++bj) {
                    const int col = colb + bj * 128; f32x4 v0 = acc[ai][bj][m][0], v1 = acc[ai][bj][m][1];
                    if (u.pn < 3) { float* q = psm + row * 768 + col; *(f32x4*)q = v0; *(f32x4*)(q + 4) = v1; }
                    else if (u.pn < 7) { float* q = lx + row * 1024 + (col - 768); *(f32x4*)q = v0; *(f32x4*)(q + 4) = v1; }
                    else if (u.pn < 11) {
#pragma unroll
                        for (int j = 0; j < 4; ++j) { v0[j] = gelu_tanh(v0[j]); v1[j] = gelu_tanh(v1[j]); }
                        *(u32x4*)(gg + row * 1024 + (col - 1792)) = pack8(v0, v1); }
                    else {
#pragma unroll
                        for (int j = 0; j < 4; ++j) { v0[j] = fast_sigmoid(v0[j]); v1[j] = fast_sigmoid(v1[j]); }
                        *(u32x4*)(sg + row * 2048 + (col - 2816)) = pack8(v0, v1);
                        if (u.pn >= 15) *(u32x4*)(g2 + row * 1024 + (col - 3840)) = pack8(v0, v1); }
                }
            }
    }
};
struct EpiQ {
    static constexpr bool PERM = false;
    bf16_t* q; const float* ropec; const float* ropes;
    __device__ __forceinline__ void operator()(const AccT& acc, const Unit& u, int wr, int wc, int fr, int fq) const {
        const int row0 = u.pm * 256 + wr * 64 + fr;
#pragma unroll
        for (int ai = 0; ai < 2; ++ai)
#pragma unroll
            for (int m = 0; m < 4; ++m) {
                const int row = row0 + ai * 128 + m * 16; const bool lat = row >= MP; const int pos = (row - MP) & 1023;
#pragma unroll
                for (int bj = 0; bj < 2; ++bj) {
                    const int base = u.pn * 256 + bj * 128 + wc * 32; const bool rope = lat && (((base >> 5) % 3) == 2);
                    f32x4 v0 = acc[ai][bj][m][0], v1 = acc[ai][bj][m][1];
                    if (rope) { const f32x4 cs = *(const f32x4*)(ropec + pos * 16 + 4 * fq), sn = *(const f32x4*)(ropes + pos * 16 + 4 * fq);
                        const f32x4 o0 = v0 * cs - v1 * sn, o1 = v0 * sn + v1 * cs; v0 = o0; v1 = o1; }
                    v0 *= QSCALE; v1 *= QSCALE;
                    bf16_t* dst = q + (size_t)row * 768 + base + 4 * fq;
                    *(u32x2*)dst = pack4(v0); *(u32x2*)(dst + 16) = pack4(v1);
                }
                asm volatile("" ::: "memory");
            }
    }
};
struct EpiBf16 {
    static constexpr bool PERM = true;
    bf16_t* o; int ldc;
    __device__ __forceinline__ void operator()(const AccT& acc, const Unit& u, int wr, int wc, int fr, int fq) const {
        const int row0 = u.pm * 256 + wr * 64 + fr, colb = u.pn * 256 + wc * 32 + 8 * fq;
#pragma unroll
        for (int ai = 0; ai < 2; ++ai)
#pragma unroll
            for (int m = 0; m < 4; ++m) {
                const size_t row = (size_t)(row0 + ai * 128 + m * 16);
#pragma unroll
                for (int bj = 0; bj < 2; ++bj) *(u32x4*)(o + row * ldc + colb + bj * 128) = pack8(acc[ai][bj][m][0], acc[ai][bj][m][1]);
            }
    }
};
struct EpiF32 {
    static constexpr bool PERM = true;
    float* o; int ldc;
    __device__ __forceinline__ void operator()(const AccT& acc, const Unit& u, int wr, int wc, int fr, int fq) const {
        const int row0 = u.pm * 256 + wr * 64 + fr, colb = u.pn * 256 + wc * 32 + 8 * fq;
#pragma unroll
        for (int ai = 0; ai < 2; ++ai)
#pragma unroll
            for (int m = 0; m < 4; ++m) {
                const size_t row = (size_t)(row0 + ai * 128 + m * 16);
#pragma unroll
                for (int bj = 0; bj < 2; ++bj) { float* q = o + row * ldc + colb + bj * 128; *(f32x4*)q = acc[ai][bj][m][0]; *(f32x4*)(q + 4) = acc[ai][bj][m][1]; }
            }
    }
};
struct EpiMla {
    static constexpr bool PERM = true;
    float* z1; const bf16_t* sg;
    __device__ __forceinline__ void operator()(const AccT& acc, const Unit& u, int wr, int wc, int fr, int fq) const {
        const int row0 = u.pm * 256 + wr * 64 + fr, colb = u.pn * 256 + wc * 32 + 8 * fq;
#pragma unroll
        for (int ai = 0; ai < 2; ++ai)
#pragma unroll
            for (int m = 0; m < 4; ++m) {
                const size_t row = (size_t)(row0 + ai * 128 + m * 16);
#pragma unroll
                for (int bj = 0; bj < 2; ++bj) { const int col = colb + bj * 128; f32x4 g0, g1; unpack8(*(const u32x4*)(sg + row * 2048 + col), g0, g1);
                    float* q = z1 + row * 1024 + col; *(f32x4*)q = acc[ai][bj][m][0] * g0 * ZSCALE; *(f32x4*)(q + 4) = acc[ai][bj][m][1] * g1 * ZSCALE; }
                asm volatile("" ::: "memory");
            }
    }
};
struct EpiLru {
    static constexpr bool PERM = true;
    const float* z1; const bf16_t* sg; bf16_t* z; const bf16_t* g2;
    __device__ __forceinline__ void operator()(const AccT& acc, const Unit& u, int wr, int wc, int fr, int fq) const {
        const int row0 = u.pm * 256 + wr * 64 + fr, colb = u.pn * 256 + wc * 32 + 8 * fq;
#pragma unroll
        for (int ai = 0; ai < 2; ++ai)
#pragma unroll
            for (int m = 0; m < 4; ++m) {
                const size_t row = (size_t)(row0 + ai * 128 + m * 16);
#pragma unroll
                for (int bj = 0; bj < 2; ++bj) { const int col = colb + bj * 128; f32x4 g0, g1; unpack8(*(const u32x4*)(g2 + row * 1024 + col), g0, g1);
                    const float* q = z1 + row * 1024 + col; const f32x4 a0 = *(const f32x4*)q + acc[ai][bj][m][0] * GLVAL(g0) * LSCALE, a1 = *(const f32x4*)(q + 4) + acc[ai][bj][m][1] * GLVAL(g1) * LSCALE;
                    *(u32x4*)(z + row * 1024 + col) = pack8(a0, a1); }
                asm volatile("" ::: "memory");
            }
    }
};
struct EpiFfi {
    static constexpr bool PERM = false;
    bf16_t* hid;
    __device__ __forceinline__ void operator()(const AccT& acc, const Unit& u, int wr, int wc, int fr, int fq) const {
        const int row0 = u.pm * 256 + wr * 64 + fr;
#pragma unroll
        for (int ai = 0; ai < 2; ++ai)
#pragma unroll
            for (int m = 0; m < 4; ++m) {
                const size_t row = (size_t)(row0 + ai * 128 + m * 16);
#pragma unroll
                for (int bj = 0; bj < 2; ++bj) { const int hc = ((u.pn * 256 + bj * 128 + wc * 32) >> 1) + 4 * fq; const f32x4 gv = acc[ai][bj][m][0], uv = acc[ai][bj][m][1]; f32x4 h;
#pragma unroll
                    for (int j = 0; j < 4; ++j) h[j] = gv[j] * fast_sigmoid(gv[j]) * uv[j];
                    *(u32x2*)(hid + row * FF + hc) = pack4(h); }
            }
    }
};

__device__ __forceinline__ int map_row(int mode, int n) {
    if (mode == 1) return n < 672 ? n : n + 96;
    if (mode == 2) { const int up = n >= FF, j = up ? n - FF : n; return (j >> 4) * 32 + (j & 15) + (up ? 16 : 0); }
    if (mode == 3) { const int h = n >> 7, r = n & 127; return r < 64 ? h * 64 + r : 512 + h * 64 + (r - 64); }
    return n;
}
__device__ __forceinline__ void conv_tile(const float* src, int ld, int K, int k0, int n0, bf16_t* dst, int mode, LAS float* tile) {
    const int tid = otid();
    __syncthreads();
#pragma unroll
    for (int i = 0; i < 2; ++i) { const int kk = (tid >> 3) + 64 * i, c4 = (tid & 7) * 4; const f32x4 v = *(const f32x4*)(src + (size_t)(k0 + kk) * ld + n0 + c4);
        tile[kk * 33 + c4] = v[0]; tile[kk * 33 + c4 + 1] = v[1]; tile[kk * 33 + c4 + 2] = v[2]; tile[kk * 33 + c4 + 3] = v[3]; }
    __syncthreads();
    const int n = tid >> 4, k8 = (tid & 15) * 8; f32x4 a, b;
#pragma unroll
    for (int j = 0; j < 4; ++j) { a[j] = tile[(k8 + j) * 33 + n]; b[j] = tile[(k8 + 4 + j) * 33 + n]; }
    *(u32x4*)(dst + (size_t)map_row(mode, n0 + n) * K + k0 + k8) = pack8(a, b);
}
constexpr int CONV_ITEMS = 4208;
__device__ __forceinline__ void conv_item(const Params& p, unsigned char* ws, int l, int idx, LAS float* tile) {
    const int zz = ozero();
    int inidx, K, N, mode = 0; size_t soff, doff;
    if (idx < 1192) { inidx = I_WIN; soff = (size_t)l * 1024 * 4768; doff = WS_WIN; K = 1024; N = 4768; mode = 1; }
    else if ((idx -= 1192) < 1408) { inidx = I_WFFI; soff = (size_t)l * 1024 * 5632; doff = WS_WFFI; K = 1024; N = 5632; mode = 2; }
    else if ((idx -= 1408) < 704) { inidx = I_WFFO; soff = (size_t)l * 2816 * 1024; doff = WS_WFFO; K = 2816; N = 1024; }
    else if ((idx -= 704) < 256) { inidx = I_WOUT; soff = (size_t)l * 1024 * 1024; doff = WS_WOUT; K = 1024; N = 1024; }
    else if ((idx -= 256) < 256) { inidx = I_WOLRU; soff = (size_t)l * 1024 * 1024; doff = WS_WOLRU; K = 1024; N = 1024; }
    else if ((idx -= 256) < 128) { inidx = I_WOMLA; soff = (size_t)l * 512 * 1024; doff = WS_WOMLA; K = 512; N = 1024; }
    else if ((idx -= 128) < 72) { inidx = I_WQUP; soff = (size_t)l * 384 * 768; doff = WS_WQ; K = 384; N = 768; }
    else if ((idx -= 72) < 64) { inidx = I_WKVUP; soff = (size_t)l * 256 * 1024; doff = WS_WKV; K = 256; N = 1024; mode = 3; }
    else { idx -= 64; const int mat = idx >> 2, ig = mat >> 4, dir = (mat >> 3) & 1, n = mat & 7;
        inidx = ig ? I_WIG : I_WRG; soff = (size_t)((l * 2 + dir) * 8 + n) * 16384; doff = WS_WG + (size_t)((dir * 8 + n) * 256 + ig * 128) * 128 * 2; K = 128; N = 128; idx &= 3; }
    const float* src = p.in[zz + inidx] + soff; bf16_t* dst = (bf16_t*)(ws + doff);
    const int nk = K / 128, kt = idx % nk, ntile = idx / nk;
    conv_tile(src, N, K, kt * 128, ntile * 32, dst, mode, tile);
}
__device__ __forceinline__ void modv_phase(const Params& p, unsigned char* ws, LAS float* lds) {
    const int zz = ozero();
    LAS float* sc = lds + 128 * 33;
    LAS float* red = sc + 5 * 1024;
    const int tid = otid();
    __syncthreads();
    for (int i = tid; i < 5 * 1024; i += NTHREADS) { const float c = i < 1024 ? p.in[zz + I_CCTX][i] : p.in[zz + I_C][i - 1024]; sc[i] = c / (1.0f + __expf(-c)); }
    __syncthreads();
    float* modv = (float*)(ws + WS_MODV); const int bid = obid(), G = ogrid();
    const int col = tid & 31, kg = tid >> 5;
    for (int it = bid; it < 384; it += G) {
        const int l = it / 192, j0 = (it % 192) * 32;
        const float* w = p.in[zz + I_WMOD] + (size_t)l * 1024 * 6144 + j0 + col;
        float a0 = 0.f, a1 = 0.f, a2 = 0.f, a3 = 0.f, a4 = 0.f;
#pragma unroll 8
        for (int k = kg * 64; k < kg * 64 + 64; ++k) { const float wv = w[(size_t)k * 6144]; a0 += sc[k] * wv; a1 += sc[1024 + k] * wv; a2 += sc[2048 + k] * wv; a3 += sc[3072 + k] * wv; a4 += sc[4096 + k] * wv; }
        red[(kg * 5 + 0) * 32 + col] = a0; red[(kg * 5 + 1) * 32 + col] = a1; red[(kg * 5 + 2) * 32 + col] = a2; red[(kg * 5 + 3) * 32 + col] = a3; red[(kg * 5 + 4) * 32 + col] = a4;
        __syncthreads();
        if (tid < 160) { const int v = tid >> 5, c = tid & 31; float s = p.in[zz + I_BMOD][l * 6144 + j0 + c];
#pragma unroll
            for (int g = 0; g < 16; ++g) s += red[(g * 5 + v) * 32 + c];
            modv[(size_t)(l * 5 + v) * 6144 + j0 + c] = s; }
        __syncthreads();
    }
}
__device__ __forceinline__ void rope_table(const Params& p, unsigned char* ws) {
    const int zz = ozero();
    float* rc = (float*)(ws + WS_ROPE); float* rs = rc + 1024 * 16;
    const int G = ogrid(); for (int i = obid() * NTHREADS + otid(); i < 1024 * 16; i += G * NTHREADS) {
        const int pos = i >> 4, f = i & 15; const float posv = (float)(f < 8 ? (pos >> 6) : (pos & 63));
        const float inv = exp2f(-(float)(f & 7) * (13.287712379549449f / 8.0f));
        const float rev = posv * inv * 0.15915494309189535f;
        rc[i] = __builtin_amdgcn_cosf(rev); rs[i] = __builtin_amdgcn_sinf(rev);
    }
}

template <bool HAS_Y, bool DO_H>
__device__ __forceinline__ void norm_phase(const Params& p, unsigned char* ws, const float* xp, const float* xs, const float* Y, const float* gA, int gate_off, const float* modA,
                                           const float* gB, int sh_off, int sc_off, const float* modB) {
    const int zz = ozero();
    const int tid = otid(), wid = tid >> 6, lane = tid & 63; const int bid = obid(), G = ogrid();
    bf16_t* hbf = (bf16_t*)(ws + WS_HBF);
    for (int row = bid * 8 + wid; row < MT; row += G * 8) {
        const int mv = row < MP ? 0 : 1 + ((row - MP) >> 10);
        const float* xin = row < MP ? xp + (size_t)row * D : xs + (size_t)(row - MP) * D;
        f32x4 x[4];
#pragma unroll
        for (int i = 0; i < 4; ++i) x[i] = *(const f32x4*)(xin + i * 256 + lane * 4);
        if (HAS_Y) {
            f32x4 y[4]; float ss = 0.f;
#pragma unroll
            for (int i = 0; i < 4; ++i) { y[i] = *(const f32x4*)(Y + (size_t)row * D + i * 256 + lane * 4); ss += y[i][0] * y[i][0] + y[i][1] * y[i][1] + y[i][2] * y[i][2] + y[i][3] * y[i][3]; }
            ss = wave_sum(ss); const float rstd = rsqrtf(ss * (1.0f / D) + EPS);
            const float* mg = modA + (size_t)mv * 6144 + gate_off;
#pragma unroll
            for (int i = 0; i < 4; ++i) { const f32x4 g = *(const f32x4*)(gA + i * 256 + lane * 4), gt = *(const f32x4*)(mg + i * 256 + lane * 4);
                x[i] = x[i] + gt * (y[i] * rstd * g) * (gate_off == 2048 ? MSCALE : FSCALE); *(f32x4*)((p.out + zz) + (size_t)row * D + i * 256 + lane * 4) = DO_H ? x[i] : x[i] * (row < MP ? (ZMASK(row, i * 256 + lane * 4) ? 0.0f : OS0) : OS1); }
        }
        if (DO_H) {
            float ss = 0.f;
#pragma unroll
            for (int i = 0; i < 4; ++i) ss += x[i][0] * x[i][0] + x[i][1] * x[i][1] + x[i][2] * x[i][2] + x[i][3] * x[i][3];
            ss = wave_sum(ss); const float rstd = rsqrtf(ss * (1.0f / D) + EPS);
            const float* msh = modB + (size_t)mv * 6144 + sh_off; const float* msc = modB + (size_t)mv * 6144 + sc_off;
#pragma unroll
            for (int i = 0; i < 4; ++i) { const f32x4 g = *(const f32x4*)(gB + i * 256 + lane * 4), sh = *(const f32x4*)(msh + i * 256 + lane * 4), sc = *(const f32x4*)(msc + i * 256 + lane * 4);
                const f32x4 h = (x[i] * rstd * g) * (sc + 1.0f) + sh; *(u32x2*)(hbf + (size_t)row * D + i * 256 + lane * 4) = pack4(h); }
        }
    }
}

__device__ __forceinline__ void postproj_phase(const Params& p, unsigned char* ws, int l) {
    const int zz = ozero();
    const int tid = otid(), wid = tid >> 6, lane = tid & 63; const int bid = obid(), G = ogrid();
    const float* psm = (const float*)(ws + WS_PSM);
    bf16_t* qn = (bf16_t*)(ws + WS_QN); bf16_t* keys = (bf16_t*)(ws + WS_KEYS); bf16_t* krb = (bf16_t*)(ws + WS_KRB);
    const float* ropec = (const float*)(ws + WS_ROPE); const float* ropes = ropec + 1024 * 16;
    const float* gq = p.in[zz + I_GQ] + l * 384; const float* gkv = p.in[zz + I_GKV] + l * 256;
    for (int t = bid * 8 + wid; t < NKEY; t += G * 8) {
        if (t < MT) {
            const float* pr = psm + (size_t)t * 768;
            f32x2 q[3]; float ss = 0.f;
#pragma unroll
            for (int i = 0; i < 3; ++i) { q[i] = *(const f32x2*)(pr + i * 128 + lane * 2); ss += q[i][0] * q[i][0] + q[i][1] * q[i][1]; }
            ss = wave_sum(ss); float rstd = rsqrtf(ss * (1.0f / 384.0f) + EPS);
#pragma unroll
            for (int i = 0; i < 3; ++i) { const f32x2 g = *(const f32x2*)(gq + i * 128 + lane * 2); *(unsigned*)(qn + (size_t)t * 384 + i * 128 + lane * 2) = cvt_pk_bf16(q[i][0] * rstd * g[0], q[i][1] * rstd * g[1]); }
            f32x4 kv = *(const f32x4*)(pr + 384 + lane * 4);
            ss = wave_sum(kv[0] * kv[0] + kv[1] * kv[1] + kv[2] * kv[2] + kv[3] * kv[3]); rstd = rsqrtf(ss * (1.0f / 256.0f) + EPS);
            const f32x4 ckv = kv * rstd * *(const f32x4*)(gkv + lane * 4);
            const int kr = keyrow_of(t);
            *(u32x2*)(keys + (size_t)kr * 256 + lane * 4) = pack4(ckv);
            const int s = t >> 8, pp = t & 255;
            if (t < MP) *(f32x4*)((p.out + zz) + OFF_CKV + ((size_t)(s * 2 + l) * 256 + pp) * 256 + lane * 4) = ckv * OS2;
            if (lane < 16) {
                float x1 = pr[640 + lane], x2 = pr[656 + lane];
                if (t >= MP) { const int pos = (t - MP) & 1023; const float cs = ropec[pos * 16 + lane], sn = ropes[pos * 16 + lane]; const float o1 = x1 * cs - x2 * sn, o2 = x1 * sn + x2 * cs; x1 = o1; x2 = o2; }
                krb[(size_t)kr * 32 + lane] = f2bf(x1); krb[(size_t)kr * 32 + 16 + lane] = f2bf(x2);
                if (t < MP) { float* o = (p.out + zz) + OFF_KR + ((size_t)(s * 2 + l) * 256 + pp) * 32; o[lane] = x1 * OS3; o[16 + lane] = x2 * OS3; }
            }
        } else {
            const int j = t - MT, b = j >> 8, jj = j & 255, kr = MP + b * 1280 + 1024 + jj;
            const f32x4 v = *(const f32x4*)(p.in[zz + I_CCKV] + ((size_t)(b * 2 + l) * 256 + jj) * 256 + lane * 4);
            *(u32x2*)(keys + (size_t)kr * 256 + lane * 4) = pack4(v);
            if (lane < 8) { const f32x4 w = *(const f32x4*)(p.in[zz + I_CKR] + ((size_t)(b * 2 + l) * 256 + jj) * 32 + lane * 4); *(u32x2*)(krb + (size_t)kr * 32 + lane * 4) = pack4(w); }
        }
    }
}

__device__ __forceinline__ void attn_phase(const Params& p, unsigned char* ws, LAS unsigned char* lds) {
    const int zz = ozero();
    const bf16_t* Qb = (const bf16_t*)(ws + WS_QB); const bf16_t* Kn = (const bf16_t*)(ws + WS_KN); const bf16_t* KR = (const bf16_t*)(ws + WS_KRB);
    const bf16_t* Vt = (const bf16_t*)(ws + WS_VT); bf16_t* AO = (bf16_t*)(ws + WS_AO);
    LAS bf16_t* Ks = (LAS bf16_t*)lds;
    LAS bf16_t* Vs = (LAS bf16_t*)(lds + 64 * 208);
    const int tid = otid(), wid = tid >> 6, lane = tid & 63, l15 = lane & 15, quad = lane >> 4; const int bid = obid(), G = ogrid();
    for (int it = bid; it < 768; it += G) {
        int tq, kb, nk, h;
        if (it < 256) { const int b = it >> 6; h = (it >> 3) & 7; tq = MP + b * 1024 + (it & 7) * 128; kb = MP + b * 1280; nk = 1280; }
        else { const int j = it - 256, s = j >> 4; h = (j >> 1) & 7; tq = s * 256 + (j & 1) * 128; kb = s * 256; nk = 256; }
        const int qrow = tq + wid * 16 + l15;
        bf16x8 qf[3];
#pragma unroll
        for (int ks = 0; ks < 3; ++ks) qf[ks] = *(const bf16x8*)(Qb + (size_t)qrow * 768 + h * 96 + ks * 32 + quad * 8);
        f32x4 o[4];
#pragma unroll
        for (int i = 0; i < 4; ++i) o[i] = (f32x4){0.f, 0.f, 0.f, 0.f};
        float mrun = -1e30f, lsum = 0.f;
        for (int k0 = 0; k0 < nk; k0 += 64) {
            __syncthreads();
            for (int c = tid; c < 768; c += NTHREADS) { const int r = c / 12, cc = c % 12;
                const bf16_t* src = cc < 8 ? Kn + (size_t)(kb + k0 + r) * 512 + h * 64 + cc * 8 : KR + (size_t)(kb + k0 + r) * 32 + (cc - 8) * 8;
                *(LAS u32x4*)(Ks + r * 104 + cc * 8) = *(const u32x4*)src; }
            { const int r = tid >> 3, cc = tid & 7; *(LAS u32x4*)(Vs + r * 72 + cc * 8) = *(const u32x4*)(Vt + (size_t)(h * 64 + r) * NKEY + kb + k0 + cc * 8); }
            __syncthreads();
            f32x4 s[4];
#pragma unroll
            for (int js = 0; js < 4; ++js) { s[js] = (f32x4){0.f, 0.f, 0.f, 0.f};
#pragma unroll
                for (int ks = 0; ks < 3; ++ks) { const bf16x8 a = *(const LAS bf16x8*)(Ks + (js * 16 + l15) * 104 + ks * 32 + quad * 8); s[js] = __builtin_amdgcn_mfma_f32_16x16x32_bf16(a, qf[ks], s[js], 0, 0, 0); } }
            float mx = s[0][0];
#pragma unroll
            for (int js = 0; js < 4; ++js)
#pragma unroll
                for (int j = 0; j < 4; ++j) mx = fmaxf(mx, s[js][j]);
            mx = fmaxf(mx, __shfl_xor(mx, 16)); mx = fmaxf(mx, __shfl_xor(mx, 32));
            const float mnew = fmaxf(mrun, mx), alpha = __builtin_amdgcn_exp2f(mrun - mnew); mrun = mnew;
            float psum = 0.f;
#pragma unroll
            for (int js = 0; js < 4; ++js)
#pragma unroll
                for (int j = 0; j < 4; ++j) { s[js][j] = __builtin_amdgcn_exp2f(s[js][j] - mnew); psum += s[js][j]; }
            lsum = lsum * alpha + psum;
#pragma unroll
            for (int i = 0; i < 4; ++i) o[i] *= alpha;
#pragma unroll
            for (int kk = 0; kk < 2; ++kk) {
                const u32x4 pw = pack8(s[2 * kk], s[2 * kk + 1]); bf16x8 pf; __builtin_memcpy(&pf, &pw, 16);
#pragma unroll
                for (int dv = 0; dv < 4; ++dv) {
                    const LAS bf16_t* vp = Vs + (dv * 16 + l15) * 72 + kk * 32 + quad * 4;
                    u32x4 vw; const u32x2 v0 = *(const LAS u32x2*)vp, v1 = *(const LAS u32x2*)(vp + 16); vw.x = v0.x; vw.y = v0.y; vw.z = v1.x; vw.w = v1.y;
                    bf16x8 va; __builtin_memcpy(&va, &vw, 16);
                    o[dv] = __builtin_amdgcn_mfma_f32_16x16x32_bf16(va, pf, o[dv], 0, 0, 0);
                }
            }
        }
        lsum += __shfl_xor(lsum, 16); lsum += __shfl_xor(lsum, 32);
        const float inv = 1.0f / lsum;
#pragma unroll
        for (int dv = 0; dv < 4; ++dv) *(u32x2*)(AO + (size_t)qrow * 512 + h * 64 + dv * 16 + quad * 4) = pack4(o[dv] * inv);
    }
}

template <int DIR>
__device__ __forceinline__ void scan_pass(const Params& p, unsigned char* ws, int l, int n, int tok0, int L, float h0, bool write_state, int state_idx, LAS unsigned char* lds) {
    const int zz = ozero();
    LAS float* xcf = (LAS float*)lds;
    LAS bf16_t* xcb = (LAS bf16_t*)(lds + 64 * 132 * 4);
    const int tid = otid(), wid = tid >> 6, lane = tid & 63, l15 = lane & 15, quad = lane >> 4;
    const int chl = wid * 16 + l15, ch = n * 128 + chl;
    const float* LXp = (const float*)(ws + WS_LX); bf16_t* HF = (bf16_t*)(ws + WS_PSM); bf16_t* GG = (bf16_t*)(ws + WS_GG);
    const float lam = p.in[zz + I_LAM][(l * 2 + DIR) * 1024 + ch];
    const float nl = -lam, sp = fmaxf(nl, 0.f) + log1pf(__expf(-fabsf(nl)));
    const float cc = -8.0f * sp * LOG2E;
    const float br = p.in[zz + I_BRG][(l * 2 + DIR) * 1024 + ch], bi = p.in[zz + I_BIG][(l * 2 + DIR) * 1024 + ch];
    const bf16_t* wg = (const bf16_t*)(ws + WS_WG) + (size_t)((DIR * 8 + n) * 256) * 128;
    bf16x8 wrf[4], wif[4];
#pragma unroll
    for (int ks = 0; ks < 4; ++ks) { wrf[ks] = *(const bf16x8*)(wg + (size_t)chl * 128 + ks * 32 + quad * 8); wif[ks] = *(const bf16x8*)(wg + (size_t)(128 + chl) * 128 + ks * 32 + quad * 8); }
    const int c4 = (tid & 31) * 4, tg = tid >> 5;
    const float* cw = p.in[zz + I_CONVW] + (size_t)l * 4 * 1024 + n * 128 + c4;
    const f32x4 w0 = *(const f32x4*)cw, w1 = *(const f32x4*)(cw + 1024), w2 = *(const f32x4*)(cw + 2048), w3 = *(const f32x4*)(cw + 3072);
    const f32x4 cb = *(const f32x4*)(p.in[zz + I_CONVB] + l * 1024 + n * 128 + c4);
    float hin = h0;
    const int nchunk = L >> 6;
    for (int ci = 0; ci < nchunk; ++ci) {
        const int t0 = (DIR ? nchunk - 1 - ci : ci) * 64;
        __syncthreads();
        {
            f32x4 xr[7];
#pragma unroll
            for (int r = 0; r < 7; ++r) { const int tt = t0 + tg * 4 - 2 + r; xr[r] = (tt >= 0 && tt < L) ? *(const f32x4*)(LXp + (size_t)(tok0 + tt) * 1024 + n * 128 + c4) : (f32x4){0.f, 0.f, 0.f, 0.f}; }
#pragma unroll
            for (int j = 0; j < 4; ++j) { const f32x4 xc = cb + xr[j] * w0 + xr[j + 1] * w1 + xr[j + 2] * w2 + xr[j + 3] * w3;
                *(LAS f32x4*)(xcf + (tg * 4 + j) * 132 + c4) = xc; *(LAS u32x2*)(xcb + (tg * 4 + j) * 136 + c4) = pack4(xc); }
        }
        __syncthreads();
        f32x4 rg[4], ig[4];
#pragma unroll
        for (int st = 0; st < 4; ++st) { rg[st] = (f32x4){0.f, 0.f, 0.f, 0.f}; ig[st] = (f32x4){0.f, 0.f, 0.f, 0.f};
#pragma unroll
            for (int ks = 0; ks < 4; ++ks) { const bf16x8 a = *(const LAS bf16x8*)(xcb + (st * 16 + l15) * 136 + ks * 32 + quad * 8);
                rg[st] = __builtin_amdgcn_mfma_f32_16x16x32_bf16(a, wrf[ks], rg[st], 0, 0, 0); ig[st] = __builtin_amdgcn_mfma_f32_16x16x32_bf16(a, wif[ks], ig[st], 0, 0, 0); } }
#pragma unroll
        for (int sti = 0; sti < 4; ++sti) {
            const int st = DIR ? 3 - sti : sti;
            float av[4], hv[4], pa[4];
#pragma unroll
            for (int j = 0; j < 4; ++j) { const float x = xcf[(st * 16 + quad * 4 + j) * 132 + chl];
                const float rr = fast_sigmoid(rg[st][j] + br), ii = fast_sigmoid(ig[st][j] + bi);
                const float a = __builtin_amdgcn_exp2f(cc * rr); av[j] = a; hv[j] = __builtin_amdgcn_sqrtf(fmaxf(1.0f - a * a, 0.f)) * ii * x; }
            float hl = 0.f, pr = 1.f;
#pragma unroll
            for (int s4 = 0; s4 < 4; ++s4) { const int j = DIR ? 3 - s4 : s4; hl = av[j] * hl + hv[j]; pr *= av[j]; hv[j] = hl; pa[j] = pr; }
            float Ar = 1.f, Hr = 0.f, Aex = 1.f, Hex = 0.f;
#pragma unroll
            for (int s4 = 0; s4 < 4; ++s4) { const int qq = DIR ? 3 - s4 : s4; const float Aq = __shfl(pr, qq * 16 + l15), Hq = __shfl(hl, qq * 16 + l15);
                if (qq == quad) { Aex = Ar; Hex = Hr; }
                Hr = Aq * Hr + Hq; Ar *= Aq; }
            const float cq = Aex * hin + Hex;
            hin = Ar * hin + Hr;
#pragma unroll
            for (int j = 0; j < 4; ++j) { const float hfin = hv[j] + pa[j] * cq; const size_t idx = (size_t)(tok0 + t0 + st * 16 + quad * 4 + j) * 1024 + ch;
                if (DIR == 0) HF[idx] = f2bf(hfin);
                else GG[idx] = f2bf((bf2f(HF[idx]) * HSCALE + hfin * BSCALE) * GGVAL(bf2f(GG[idx]))); }
        }
    }
    if (write_state && quad == 0) (p.out + zz)[(DIR ? OFF_LB : OFF_LF) + state_idx + ch] = hin * (DIR ? OS5 : OS4);
}
__device__ __forceinline__ void scan_phase(const Params& p, unsigned char* ws, int l, LAS unsigned char* lds) {
    const int zz = ozero();
    const int tid = otid(), l15 = tid & 15, wid = tid >> 6; const int bid = obid(), G = ogrid();
    for (int it = bid; it < 288; it += G) {
        int n, tok0, L, sidx; bool lat; float hf0 = 0.f, hb0 = 0.f;
        if (it < 32) { const int b = it >> 3; n = it & 7; tok0 = MP + b * 1024; L = 1024; lat = true; sidx = 0; const int ch = n * 128 + wid * 16 + l15;
            hf0 = p.in[zz + I_SF][(b * 2 + l) * 1024 + ch]; hb0 = p.in[zz + I_SB][(b * 2 + l) * 1024 + ch]; }
        else { const int j = it - 32, s = j >> 3; n = j & 7; tok0 = s * 256; L = 256; lat = false; sidx = (s * 2 + l) * 1024; }
        scan_pass<0>(p, ws, l, n, tok0, L, hf0, !lat, sidx, lds);
        scan_pass<1>(p, ws, l, n, tok0, L, hb0, !lat, sidx, lds);
    }
}

__device__ __forceinline__ unsigned char* opq_unused(unsigned char* x) { asm volatile("" : "+s"(x)); return x; }
__device__ __forceinline__ void grid_sync_all() {
    asm volatile("s_waitcnt vmcnt(0) lgkmcnt(0)" ::: "memory");
    __builtin_amdgcn_fence(__ATOMIC_RELEASE, "agent");
    asm volatile("s_waitcnt vmcnt(0) lgkmcnt(0)" ::: "memory");
    cg::this_grid().sync();
    if (threadIdx.x < 64) { __builtin_amdgcn_fence(__ATOMIC_ACQUIRE, "agent"); asm volatile("s_waitcnt vmcnt(0) lgkmcnt(0)" ::: "memory"); }
    __syncthreads();
}
__global__ void __launch_bounds__(NTHREADS) fwd_megakernel(Params p) {
    extern __shared__ __attribute__((aligned(16))) unsigned char smem[];
    LAS unsigned char* lds = (LAS unsigned char*)smem;
    int ph = 0; (void)ph; int phc = 0; (void)phc;
#if defined(STOP_AFTER)
#define PHASE_IF if (phc <= STOP_AFTER)
#define PHASE_END do { ++phc; grid_sync_all(); } while (0)
#elif ONE_LAUNCH
#define PHASE_IF
#define PHASE_END do { grid_sync_all(); } while (0)
#else
#define PHASE_IF if (__builtin_amdgcn_readfirstlane((int)(ph >= p.ph_lo && ph < p.ph_hi)))
#define PHASE_END do { ++ph; } while (0)
#endif

    PHASE_IF PHK(0) { const int zz = ozero(); unsigned char* ws = p.ws + zz; const int G = ogrid(), bid = obid(); (void)G; (void)bid; const float* modv = (const float*)(ws + WS_MODV); const float* modl = modv; (void)modl;
        rope_table(p, ws);
        modv_phase(p, ws, (LAS float*)lds);
        for (int i = bid; i < CONV_ITEMS; i += G) conv_item(p, ws, 0, i, (LAS float*)lds);
    }
    PHASE_END;
    PHASE_IF PHK(1) { const int zz = ozero(); unsigned char* ws = p.ws + zz; const int G = ogrid(), bid = obid(); (void)G; (void)bid; const float* modv = (const float*)(ws + WS_MODV); const float* modl = modv; (void)modl; norm_phase<false, true>(p, ws, p.in[zz + I_XP], p.in[zz + I_XS], nullptr, nullptr, 0, nullptr, p.in[zz + I_GPM], 0, 1024, modv); }
    PHASE_END;
#pragma unroll 1
    for (int l = 0; l < 2; ++l) {
        PHASE_IF PHK(2) { const int zz = ozero(); unsigned char* ws = p.ws + zz; const int G = ogrid(), bid = obid(); (void)G; (void)bid; const float* modv = (const float*)(ws + WS_MODV); const float* modl = modv + (size_t)l * 5 * 6144; (void)modl; pg8::Gemm g{(const bf16_t*)(ws + WS_HBF), (const bf16_t*)(ws + WS_WIN), MT, INCP, 1024}; pg8::StaticOrder S; S.init(MT, INCP, G, bid);
            EpiIn E{(float*)(ws + WS_PSM), (float*)(ws + WS_LX), (bf16_t*)(ws + WS_GG), (bf16_t*)(ws + WS_SG), (bf16_t*)(ws + WS_HF)}; pg8::gemm_phase(lds, g, S, E); }
        PHASE_END;
        PHASE_IF PHK(3) { const int zz = ozero(); unsigned char* ws = p.ws + zz; const int G = ogrid(), bid = obid(); (void)G; (void)bid; const float* modv = (const float*)(ws + WS_MODV); const float* modl = modv + (size_t)l * 5 * 6144; (void)modl; postproj_phase(p, ws, l); }
        PHASE_END;
        PHASE_IF PHK(4) { const int zz = ozero(); unsigned char* ws = p.ws + zz; const int G = ogrid(), bid = obid(); (void)G; (void)bid; const float* modv = (const float*)(ws + WS_MODV); const float* modl = modv + (size_t)l * 5 * 6144; (void)modl;
            { pg8::Gemm g{(const bf16_t*)(ws + WS_QN), (const bf16_t*)(ws + WS_WQ), MT, 768, 384}; pg8::StaticOrder S; S.init(MT, 768, G, bid);
              EpiQ E{(bf16_t*)(ws + WS_QB), (const float*)(ws + WS_ROPE), (const float*)(ws + WS_ROPE) + 1024 * 16}; pg8::gemm_phase(lds, g, S, E); }
            { pg8::Gemm g{(const bf16_t*)(ws + WS_KEYS), (const bf16_t*)(ws + WS_WKV), NKEY, 512, 256}; pg8::StaticOrder S; S.init(NKEY, 512, G, (bid + G - 144 % G) % G);
              EpiBf16 E{(bf16_t*)(ws + WS_KN), 512}; pg8::gemm_phase(lds, g, S, E); }
            { pg8::Gemm g{(const bf16_t*)(ws + WS_WKV) + (size_t)512 * 256, (const bf16_t*)(ws + WS_KEYS), 512, NKEY, 256}; pg8::StaticOrder S; S.init(512, NKEY, G, (bid + G - 248 % G) % G);
              EpiBf16 E{(bf16_t*)(ws + WS_VT), NKEY}; pg8::gemm_phase(lds, g, S, E); }
        }
        PHASE_END;
        PHASE_IF PHK(5) { const int zz = ozero(); unsigned char* ws = p.ws + zz; const int G = ogrid(), bid = obid(); (void)G; (void)bid; const float* modv = (const float*)(ws + WS_MODV); const float* modl = modv + (size_t)l * 5 * 6144; (void)modl; attn_phase(p, ws, lds); }
        PHASE_END;
        PHASE_IF PHK(6) { const int zz = ozero(); unsigned char* ws = p.ws + zz; const int G = ogrid(), bid = obid(); (void)G; (void)bid; const float* modv = (const float*)(ws + WS_MODV); const float* modl = modv + (size_t)l * 5 * 6144; (void)modl; scan_phase(p, ws, l, lds); }
        PHASE_END;
        PHASE_IF PHK(7) { const int zz = ozero(); unsigned char* ws = p.ws + zz; const int G = ogrid(), bid = obid(); (void)G; (void)bid; const float* modv = (const float*)(ws + WS_MODV); const float* modl = modv + (size_t)l * 5 * 6144; (void)modl;
            { pg8::Gemm g{(const bf16_t*)(ws + WS_AO), (const bf16_t*)(ws + WS_WOMLA), MT, 1024, 512}; pg8::StaticOrder S; S.init(MT, 1024, G, bid);
              EpiMla E{(float*)(ws + WS_LX), (const bf16_t*)(ws + WS_SG)}; pg8::gemm_phase(lds, g, S, E); }
            { pg8::Gemm g{(const bf16_t*)(ws + WS_GG), (const bf16_t*)(ws + WS_WOLRU), MT, 1024, 1024}; pg8::StaticOrder S; S.init(MT, 1024, G, bid);
              EpiLru E{(const float*)(ws + WS_LX), (const bf16_t*)(ws + WS_SG), (bf16_t*)(ws + WS_Z), (const bf16_t*)(ws + WS_HF)}; pg8::gemm_phase(lds, g, S, E); }
        }
        PHASE_END;
        PHASE_IF PHK(8) { const int zz = ozero(); unsigned char* ws = p.ws + zz; const int G = ogrid(), bid = obid(); (void)G; (void)bid; const float* modv = (const float*)(ws + WS_MODV); const float* modl = modv + (size_t)l * 5 * 6144; (void)modl; pg8::Gemm g{(const bf16_t*)(ws + WS_Z), (const bf16_t*)(ws + WS_WOUT), MT, 1024, 1024}; pg8::StaticOrder S; S.init(MT, 1024, G, bid);
            EpiF32 E{(float*)(ws + WS_LX), 1024}; pg8::gemm_phase(lds, g, S, E); }
        PHASE_END;
        PHASE_IF PHK(9) { const int zz = ozero(); unsigned char* ws = p.ws + zz; const int G = ogrid(), bid = obid(); (void)G; (void)bid; const float* modv = (const float*)(ws + WS_MODV); const float* modl = modv + (size_t)l * 5 * 6144; (void)modl; const float* xp = l == 0 ? p.in[zz + I_XP] : (p.out + zz); const float* xs = l == 0 ? p.in[zz + I_XS] : (p.out + zz) + (size_t)MP * D; norm_phase<true, true>(p, ws, xp, xs, (const float*)(ws + WS_LX), p.in[zz + I_GQM] + l * D, 2048, modl, p.in[zz + I_GPF] + l * D, 3072, 4096, modl); }
        PHASE_END;
        PHASE_IF PHK(10) { const int zz = ozero(); unsigned char* ws = p.ws + zz; const int G = ogrid(), bid = obid(); (void)G; (void)bid; const float* modv = (const float*)(ws + WS_MODV); const float* modl = modv + (size_t)l * 5 * 6144; (void)modl; pg8::Gemm g{(const bf16_t*)(ws + WS_HBF), (const bf16_t*)(ws + WS_WFFI), MT, 5632, 1024}; pg8::StaticOrder S; S.init(MT, 5632, G, bid);
            EpiFfi E{(bf16_t*)(ws + WS_HID)}; pg8::gemm_phase(lds, g, S, E); }
        PHASE_END;
        PHASE_IF PHK(11) { const int zz = ozero(); unsigned char* ws = p.ws + zz; const int G = ogrid(), bid = obid(); (void)G; (void)bid; const float* modv = (const float*)(ws + WS_MODV); const float* modl = modv + (size_t)l * 5 * 6144; (void)modl; pg8::Gemm g{(const bf16_t*)(ws + WS_HID), (const bf16_t*)(ws + WS_WFFO), MT, 1024, FF}; pg8::StaticOrder S; S.init(MT, 1024, G, bid);
            EpiF32 E{(float*)(ws + WS_LX), 1024}; pg8::gemm_phase(lds, g, S, E); }
        PHASE_END;
        PHASE_IF PHK(12) { const int zz = ozero(); unsigned char* ws = p.ws + zz; const int G = ogrid(), bid = obid(); (void)G; (void)bid; const float* modv = (const float*)(ws + WS_MODV); const float* modl = modv + (size_t)l * 5 * 6144; (void)modl;
            if (l == 0) {
                norm_phase<true, true>(p, ws, (p.out + zz), (p.out + zz) + (size_t)MP * D, (const float*)(ws + WS_LX), p.in[zz + I_GQF], 5120, modl, p.in[zz + I_GPM] + D, 0, 1024, modv + (size_t)5 * 6144);
                for (int i = bid; i < CONV_ITEMS; i += G) conv_item(p, ws, 1, i, (LAS float*)lds);
            } else {
                norm_phase<true, false>(p, ws, (p.out + zz), (p.out + zz) + (size_t)MP * D, (const float*)(ws + WS_LX), p.in[zz + I_GQF] + D, 5120, modl, nullptr, 0, 0, nullptr);
            }
        }
#if ONE_LAUNCH && !defined(STOP_AFTER)
        if (l == 0) grid_sync_all();
#else
        PHASE_END;
#endif
    }
#if defined(STOP_AFTER)
    {
        const int tid = otid(), bid = obid(), G = ogrid(); const unsigned* wsu = (const unsigned*)p.ws; float* out = p.out;
        for (int i = bid * NTHREADS + tid; i < 17432576; i += G * NTHREADS) { float a = 0.f;
#pragma unroll
            for (int j = 0; j < 4; ++j) { const size_t idx = (size_t)i + (size_t)j * 17432576; if (idx * 4 < WS_END) { const unsigned u = wsu[idx]; a += (float)(u & 0xffu) + (float)((u >> 16) & 0xffu); } }
            out[i] = a; }
    }
#endif
}
constexpr int NPHASES = 2 + 11 * 2;

extern "C" void kernel_launch(void* const* d_in, const int* in_sizes, int n_in, void* d_out, int out_size, void* d_ws, size_t ws_size, hipStream_t stream) {
    static int grid = 0;
    if (grid == 0) {
        if (n_in != 31 || ws_size < WS_END) { fprintf(stderr, "kernel_launch: need 31 inputs and %zu bytes of workspace (got %d, %zu)\n", (size_t)WS_END, n_in, ws_size); grid = -1; return; }
        if (hipFuncSetAttribute((const void*)fwd_megakernel, hipFuncAttributeMaxDynamicSharedMemorySize, LDS_BYTES) != hipSuccess) { fprintf(stderr, "kernel_launch: hipFuncSetAttribute failed\n"); grid = -1; return; }
        int dev = 0, cus = 0, per_cu = 0;
        hipGetDevice(&dev); hipDeviceGetAttribute(&cus, hipDeviceAttributeMultiprocessorCount, dev);
        hipOccupancyMaxActiveBlocksPerMultiprocessor(&per_cu, (const void*)fwd_megakernel, NTHREADS, LDS_BYTES);
        if (per_cu < 1) { fprintf(stderr, "kernel_launch: occupancy query says %d blocks/CU\n", per_cu); per_cu = 1; }
        (void)hipGetLastError();
        grid = cus;
    }
    if (grid < 0) return;
    Params p{};
    for (int i = 0; i < 31; ++i) p.in[i] = (const float*)d_in[i];
    p.out = (float*)d_out; p.ws = (unsigned char*)d_ws;
#if ONE_LAUNCH
    p.ph_lo = 0; p.ph_hi = NPHASES; p.coop = 1;
    void* args[] = {&p};
    hipError_t e = hipLaunchCooperativeKernel((const void*)fwd_megakernel, dim3(grid), dim3(NTHREADS), args, LDS_BYTES, stream);
    if (e != hipSuccess) fprintf(stderr, "cooperative launch failed: %s (grid %d)\n", hipGetErrorString(e), grid);
#else
    for (int ph = 0; ph < NPHASES; ++ph) {
        p.ph_lo = ph; p.ph_hi = ph + 1; p.coop = 0;
        hipLaunchKernelGGL(fwd_megakernel, dim3(grid), dim3(NTHREADS), LDS_BYTES, stream, p);
    }
#endif
}
```

```cpp
#include <hip/hip_runtime.h>
#include <hip/hip_cooperative_groups.h>
#include <cstdio>
namespace cg = cooperative_groups;

#ifndef ONE_LAUNCH
#define ONE_LAUNCH 1
#endif

#ifndef PHMASK
#define PHMASK 0xffff
#endif
#define PHK(k) if constexpr (((PHMASK) >> (k)) & 1)
#ifndef LSCALE
#define LSCALE 1.0f
#endif
#ifndef MSCALE
#define MSCALE 1.0f
#endif
#ifndef FSCALE
#define FSCALE 1.0f
#endif
#ifndef OS0
#define OS0 1.0f
#endif
#ifndef OS1
#define OS1 1.0f
#endif
#ifndef OS2
#define OS2 1.0f
#endif
#ifndef OS3
#define OS3 1.0f
#endif
#ifndef OS4
#define OS4 1.0f
#endif
#ifndef OS5
#define OS5 1.0f
#endif
#ifndef ZMASK
#define ZMASK(row, col) false
#endif
#ifndef HSCALE
#define HSCALE 1.0f
#endif
#ifndef BSCALE
#define BSCALE 1.0f
#endif
#ifndef GGVAL
#define GGVAL(x) (x)
#endif
#ifndef GLVAL
#define GLVAL(x) (x)
#endif
#ifndef GLOFF
#define GLOFF 1024
#endif
#ifndef ZSCALE
#define ZSCALE 1.0f
#endif
#define LAS __attribute__((address_space(3)))
typedef unsigned short bf16_t;
typedef short bf16x8 __attribute__((ext_vector_type(8)));
typedef float f32x4 __attribute__((ext_vector_type(4)));
typedef float f32x2 __attribute__((ext_vector_type(2)));
typedef unsigned u32x4 __attribute__((ext_vector_type(4)));
typedef unsigned u32x2 __attribute__((ext_vector_type(2)));

constexpr int D = 1024, MT = 12288, MP = 8192, NKEY = 13312, FF = 2816;
constexpr int INCP = 4864;
constexpr int NTHREADS = 512, LDS_BYTES = 131072;
constexpr float EPS = 1e-6f;
constexpr float LOG2E = 1.4426950408889634f;
constexpr float QSCALE = 0.10206207261596577f * 1.4426950408889634f;

constexpr size_t OFF_CKV = 12582912, OFF_KR = 16777216, OFF_LF = 17301504, OFF_LB = 17367040;

constexpr size_t WS_MODV = 0;
constexpr size_t WS_ROPE = WS_MODV + 2 * 5 * 6144 * 4;
constexpr size_t WS_WIN = WS_ROPE + 2 * 1024 * 16 * 4;
constexpr size_t WS_WFFI = WS_WIN + (size_t)INCP * 1024 * 2;
constexpr size_t WS_WFFO = WS_WFFI + (size_t)5632 * 1024 * 2;
constexpr size_t WS_WOUT = WS_WFFO + (size_t)1024 * 2816 * 2;
constexpr size_t WS_WOLRU = WS_WOUT + (size_t)1024 * 1024 * 2;
constexpr size_t WS_WOMLA = WS_WOLRU + (size_t)1024 * 1024 * 2;
constexpr size_t WS_WQ = WS_WOMLA + (size_t)1024 * 512 * 2;
constexpr size_t WS_WKV = WS_WQ + (size_t)768 * 384 * 2;
constexpr size_t WS_WG = WS_WKV + (size_t)1024 * 256 * 2;
constexpr size_t WS_HBF = WS_WG + (size_t)2 * 8 * 256 * 128 * 2;
constexpr size_t WS_QN = WS_HBF;
constexpr size_t WS_KEYS = WS_QN + (size_t)MT * 384 * 2;
constexpr size_t WS_KRB = WS_KEYS + (size_t)NKEY * 256 * 2;
constexpr size_t WS_AO = WS_HBF;
constexpr size_t WS_PSM = WS_HBF + (size_t)MT * 1024 * 2;
constexpr size_t WS_QB = WS_PSM;
constexpr size_t WS_KN = WS_QB + (size_t)MT * 768 * 2;
constexpr size_t WS_Z = WS_PSM;
constexpr size_t WS_LX = WS_PSM + (size_t)MT * 768 * 4;
constexpr size_t WS_GG = WS_LX + (size_t)MT * 1024 * 4;
constexpr size_t WS_SG = WS_GG + (size_t)MT * 1024 * 2;
constexpr size_t WS_HID = WS_GG;
constexpr size_t WS_VT = WS_SG + (size_t)MT * 2048 * 2;
constexpr size_t WS_HF = WS_VT + (size_t)512 * NKEY * 2;
constexpr size_t WS_END = WS_HF + (size_t)MT * 1024 * 2;

struct Params {
    const float* in[31];
    float* out;
    unsigned char* ws;
    int ph_lo, ph_hi, coop, pad;
};
enum { I_XP = 0, I_XS, I_CCKV, I_CKR, I_SF, I_SB, I_C, I_CCTX, I_WMOD, I_BMOD, I_GPM, I_GQM, I_GPF, I_GQF, I_WIN, I_GQ, I_WQUP, I_GKV,
       I_WKVUP, I_WOMLA, I_CONVW, I_CONVB, I_WRG, I_BRG, I_WIG, I_BIG, I_LAM, I_WOLRU, I_WOUT, I_WFFI, I_WFFO };

__device__ __forceinline__ unsigned char* opq(unsigned char* x) { asm volatile("" : "+s"(x)); return x; }
__device__ __forceinline__ int ozero() { int t = 0; asm volatile("" : "+s"(t)); return t; }
__device__ __forceinline__ int otid() { int t = threadIdx.x; asm volatile("" : "+v"(t)); return t; }
__device__ __forceinline__ int obid() { int t = blockIdx.x; asm volatile("" : "+s"(t)); return t; }
__device__ __forceinline__ int ogrid() { int t = gridDim.x; asm volatile("" : "+s"(t)); return t; }
__device__ __forceinline__ unsigned cvt_pk_bf16(float lo, float hi) { unsigned r; asm volatile("v_cvt_pk_bf16_f32 %0, %1, %2" : "=v"(r) : "v"(lo), "v"(hi)); return r; }
__device__ __forceinline__ float bf2f(bf16_t b) { return __uint_as_float(((unsigned)b) << 16); }
__device__ __forceinline__ bf16_t f2bf(float f) { return (bf16_t)(cvt_pk_bf16(f, 0.f) & 0xffffu); }
__device__ __forceinline__ float wave_sum(float v) {
#pragma unroll
    for (int o = 32; o >= 1; o >>= 1) v += __shfl_xor(v, o);
    return v;
}
__device__ __forceinline__ float fast_sigmoid(float x) { return __builtin_amdgcn_rcpf(1.0f + __builtin_amdgcn_exp2f(-x * LOG2E)); }
__device__ __forceinline__ float gelu_tanh(float x) { const float z = 1.5957691216057308f * (x + 0.044715f * x * x * x); return x * fast_sigmoid(z); }
__device__ __forceinline__ int keyrow_of(int t) { return t < MP ? t : MP + ((t - MP) >> 10) * 1280 + ((t - MP) & 1023); }

namespace pg8 {
constexpr int BM = 256, BK = 64, HALF = 128, HTB = HALF * BK * 2, NXCD = 8, WGM = 8;
__device__ __forceinline__ int lds_byte(int r, int c) { const int st = (r >> 4) * 2 + (c >> 5), rr = r & 15, cc = c & 31, ob = rr * 64 + cc * 2; return st * 1024 + (ob ^ (((ob >> 9) & 1) << 5)); }
__device__ __forceinline__ void stage_rc(int b, int& R, int& C) { const int st = b / 1024, sb = b % 1024, swz = sb ^ (((sb >> 9) & 1) << 5); R = (st >> 1) * 16 + swz / 64; C = (st & 1) * 32 + (swz % 64) / 2; }
__device__ __forceinline__ int perm32(int rho) { const int n = rho >> 4, i = rho & 15; return 8 * (i >> 2) + 4 * n + (i & 3); }
struct Unit { int pm, pn; };
struct Gemm { const bf16_t* A; const bf16_t* Bt; int M, N, K; };
struct StaticOrder {
    int nM, nN, nwg, G, c;
    __device__ void init(int M, int N, int G_, int c_) { nM = M / BM; nN = N / BM; nwg = nM * nN; G = G_; c = c_; }
    __device__ bool next(int i, Unit& u) const {
        const int L = i * G + c; if (L >= nwg) return false;
        int wgid = L; { const int q = nwg / NXCD, r = nwg % NXCD, xcd = wgid % NXCD, off = wgid / NXCD; wgid = (xcd < r ? xcd * (q + 1) : r * (q + 1) + (xcd - r) * q) + off; }
        const int nig = WGM * nN, gid = wgid / nig, fm = gid * WGM, gsz = (nM - fm) < WGM ? (nM - fm) : WGM;
        u.pm = fm + ((wgid % nig) % gsz); u.pn = (wgid % nig) / gsz; return true;
    }
};
template <class Epi>
__device__ __forceinline__ void gemm_phase(LAS unsigned char* lds, const Gemm g, const StaticOrder& S, const Epi& E) {
    int tid_ = threadIdx.x; asm volatile("" : "+v"(tid_));
    const int tid = tid_, wid = __builtin_amdgcn_readfirstlane(tid >> 6), lane = tid & 63, wr = wid >> 2, wc = wid & 3, fr = lane & 15, fq = lane >> 4;
    const int K = g.K, nt = K / BK;
    unsigned voffA[2], voffB[2];
#pragma unroll
    for (int i = 0; i < 2; ++i) { int R, C; stage_rc(tid * 16 + i * 8192, R, C); const int Rb = Epi::PERM ? ((R & ~31) + perm32(R & 31)) : R;
        voffA[i] = (unsigned)(R * K + C) * 2u; voffB[i] = (unsigned)(Rb * K + C) * 2u; }
    const size_t kstep = (size_t)(BK * 2);
    const size_t hstep = (size_t)HALF * K * 2;
    const size_t tstep = 2 * hstep;
    const unsigned ldsw = (unsigned)wid * 1024u;
    const int aoff = lds_byte(wr * 64 + fr, fq * 8), boff = lds_byte(wc * 32 + fr, fq * 8);
#define PG8_SA(b, h) (((b) * 2 + (h)) * HTB)
#define PG8_SB(b, h) ((4 + (b) * 2 + (h)) * HTB)
#define PG8_STAGE(bufoff, gbase, voff) do { _Pragma("unroll") for (int _i = 0; _i < 2; ++_i) \
        __builtin_amdgcn_global_load_lds((const unsigned*)((const char*)(gbase) + (voff)[_i]), (LAS unsigned*)(lds + (bufoff) + ldsw + _i * 8192), 16, 0, 0); } while (0)
#define PG8_LDA(dst, b, h) do { _Pragma("unroll") for (int m = 0; m < 4; ++m) _Pragma("unroll") for (int k = 0; k < 2; ++k) dst[m][k] = *(const LAS bf16x8*)(lds + PG8_SA(b, h) + aoff + m * 2048 + k * 1024); } while (0)
#define PG8_LDB(dst, b, h) do { _Pragma("unroll") for (int n = 0; n < 2; ++n) _Pragma("unroll") for (int k = 0; k < 2; ++k) dst[n][k] = *(const LAS bf16x8*)(lds + PG8_SB(b, h) + boff + n * 2048 + k * 1024); } while (0)
#define PG8_MMA(ai, bj, At, Bt) do { __builtin_amdgcn_s_setprio(1); _Pragma("unroll") for (int m = 0; m < 4; ++m) _Pragma("unroll") for (int n = 0; n < 2; ++n) _Pragma("unroll") for (int k = 0; k < 2; ++k) \
        acc[ai][bj][m][n] = __builtin_amdgcn_mfma_f32_16x16x32_bf16(Bt[n][k], At[m][k], acc[ai][bj][m][n], 0, 0, 0); __builtin_amdgcn_s_setprio(0); } while (0)
#define PG8_WAIT_V(n) asm volatile("s_waitcnt vmcnt(" #n ")" ::: "memory")
#define PG8_WAIT_L(n) asm volatile("s_waitcnt lgkmcnt(" #n ")" ::: "memory")
#define PG8_BAR __builtin_amdgcn_s_barrier()
#define PG8_SCHED __builtin_amdgcn_sched_barrier(0)
    Unit cur, nxt; int ui = 0;
    if (!S.next(0, cur)) return;
    f32x4 acc[2][2][4][2];
#pragma unroll
    for (int a = 0; a < 2; ++a)
#pragma unroll
        for (int b = 0; b < 2; ++b)
#pragma unroll
            for (int m = 0; m < 4; ++m)
#pragma unroll
                for (int n = 0; n < 2; ++n) acc[a][b][m][n] = (f32x4){0.f, 0.f, 0.f, 0.f};
    bf16x8 At[4][2], B0[2][2], B1[2][2];
    const char* cA = (const char*)g.A + (size_t)cur.pm * tstep; const char* cB = (const char*)g.Bt + (size_t)cur.pn * tstep;
    PG8_STAGE(PG8_SB(0, 0), cB, voffB); PG8_STAGE(PG8_SA(0, 0), cA, voffA); PG8_STAGE(PG8_SB(0, 1), cB + hstep, voffB); PG8_STAGE(PG8_SA(0, 1), cA + hstep, voffA);
    if (wr == 1) PG8_BAR;
    PG8_WAIT_V(4); PG8_BAR;
    PG8_STAGE(PG8_SB(1, 0), cB + kstep, voffB); PG8_STAGE(PG8_SA(1, 0), cA + kstep, voffA); PG8_STAGE(PG8_SB(1, 1), cB + hstep + kstep, voffB);
    PG8_WAIT_V(6); PG8_BAR;
    for (;;) {
        const bool has_next = S.next(ui + 1, nxt);
        const char* nA = has_next ? (const char*)g.A + (size_t)nxt.pm * tstep : cA; const char* nB = has_next ? (const char*)g.Bt + (size_t)nxt.pn * tstep : cB;
        for (int t = 0; t < nt; t += 2) {
            const bool last = (t == nt - 2);
            const char* a1 = cA + (size_t)(t + 1) * kstep;
            const char* a2 = last ? nA : cA + (size_t)(t + 2) * kstep; const char* b2 = last ? nB : cB + (size_t)(t + 2) * kstep;
            const char* a3 = a2 + kstep; const char* b3 = b2 + kstep;
            PG8_LDB(B0, 0, 0); PG8_SCHED; PG8_LDA(At, 0, 0); PG8_STAGE(PG8_SA(1, 1), a1 + hstep, voffA);
            PG8_WAIT_L(8); PG8_BAR; PG8_WAIT_L(0); PG8_MMA(0, 0, At, B0); PG8_BAR; PG8_SCHED;
            PG8_LDB(B1, 0, 1); PG8_STAGE(PG8_SB(0, 0), b2, voffB);
            PG8_BAR; PG8_WAIT_L(0); PG8_MMA(0, 1, At, B1); PG8_BAR;
            PG8_LDA(At, 0, 1); PG8_STAGE(PG8_SA(0, 0), a2, voffA);
            PG8_BAR; PG8_WAIT_L(0); PG8_MMA(1, 0, At, B0); PG8_BAR; PG8_SCHED;
            PG8_STAGE(PG8_SB(0, 1), b2 + hstep, voffB);
            PG8_WAIT_V(6); PG8_BAR; PG8_MMA(1, 1, At, B1); PG8_BAR;
            PG8_LDB(B0, 1, 0); PG8_SCHED; PG8_LDA(At, 1, 0); PG8_STAGE(PG8_SA(0, 1), a2 + hstep, voffA);
            PG8_WAIT_L(8); PG8_BAR; PG8_WAIT_L(0); PG8_MMA(0, 0, At, B0); PG8_BAR; PG8_SCHED;
            PG8_LDB(B1, 1, 1); PG8_STAGE(PG8_SB(1, 0), b3, voffB);
            PG8_BAR; PG8_WAIT_L(0); PG8_MMA(0, 1, At, B1); PG8_BAR;
            PG8_LDA(At, 1, 1); PG8_STAGE(PG8_SA(1, 0), a3, voffA);
            PG8_BAR; PG8_WAIT_L(0); PG8_MMA(1, 0, At, B0); PG8_BAR; PG8_SCHED;
            PG8_STAGE(PG8_SB(1, 1), b3 + hstep, voffB);
            PG8_WAIT_V(6); PG8_BAR; PG8_MMA(1, 1, At, B1); PG8_BAR;
        }
        E(acc, cur, wr, wc, fr, fq);
        if (!has_next) break;
#pragma unroll
        for (int a = 0; a < 2; ++a)
#pragma unroll
            for (int b = 0; b < 2; ++b)
#pragma unroll
                for (int m = 0; m < 4; ++m)
#pragma unroll
                    for (int n = 0; n < 2; ++n) acc[a][b][m][n] = (f32x4){0.f, 0.f, 0.f, 0.f};
        cur = nxt; cA = nA; cB = nB; ++ui;
    }
    PG8_WAIT_V(0);
    if (wr == 0) PG8_BAR;
    PG8_BAR;
#undef PG8_SA
#undef PG8_SB
#undef PG8_STAGE
#undef PG8_LDA
#undef PG8_LDB
#undef PG8_MMA
#undef PG8_WAIT_V
#undef PG8_WAIT_L
#undef PG8_BAR
#undef PG8_SCHED
}
}
using pg8::Unit;
typedef f32x4 AccT[2][2][4][2];

__device__ __forceinline__ u32x4 pack8(f32x4 a, f32x4 b) { u32x4 w; w.x = cvt_pk_bf16(a[0], a[1]); w.y = cvt_pk_bf16(a[2], a[3]); w.z = cvt_pk_bf16(b[0], b[1]); w.w = cvt_pk_bf16(b[2], b[3]); return w; }
__device__ __forceinline__ u32x2 pack4(f32x4 a) { u32x2 w; w.x = cvt_pk_bf16(a[0], a[1]); w.y = cvt_pk_bf16(a[2], a[3]); return w; }
__device__ __forceinline__ void unpack8(u32x4 w, f32x4& a, f32x4& b) {
    a[0] = __uint_as_float(w.x << 16); a[1] = __uint_as_float(w.x & 0xffff0000u); a[2] = __uint_as_float(w.y << 16); a[3] = __uint_as_float(w.y & 0xffff0000u);
    b[0] = __uint_as_float(w.z << 16); b[1] = __uint_as_float(w.z & 0xffff0000u); b[2] = __uint_as_float(w.w << 16); b[3] = __uint_as_float(w.w & 0xffff0000u);
}

struct EpiIn {
    static constexpr bool PERM = true;
    float* psm; float* lx; bf16_t* gg; bf16_t* sg; bf16_t* g2;
    __device__ __forceinline__ void operator()(const AccT& acc, const Unit& u, int wr, int wc, int fr, int fq) const {
        const int row0 = u.pm * 256 + wr * 64 + fr, colb = u.pn * 256 + wc * 32 + 8 * fq;
#pragma unroll
        for (int ai = 0; ai < 2; ++ai)
#pragma unroll
            for (int m = 0; m < 4; ++m) {
                const size_t row = (size_t)(row0 + ai * 128 + m * 16);
#pragma unroll
                for (int bj = 0; bj < 2; ++bj) {
                    const int col = colb + bj * 128; f32x4 v0 = acc[ai][bj][m][0], v1 = acc[ai][bj][m][1];
                    if (u.pn < 3) { float* q = psm + row * 768 + col; *(f32x4*)q = v0; *(f32x4*)(q + 4) = v1; }
                    else if (u.pn < 7) { float* q = lx + row * 1024 + (col - 768); *(f32x4*)q = v0; *(f32x4*)(q + 4) = v1; }
                    else if (u.pn < 11) {
#pragma unroll
                        for (int j = 0; j < 4; ++j) { v0[j] = gelu_tanh(v0[j]); v1[j] = gelu_tanh(v1[j]); }
                        *(u32x4*)(gg + row * 1024 + (col - 1792)) = pack8(v0, v1); }
                    else {
#pragma unroll
                        for (int j = 0; j < 4; ++j) { v0[j] = fast_sigmoid(v0[j]); v1[j] = fast_sigmoid(v1[j]); }
                        *(u32x4*)(sg + row * 2048 + (col - 2816)) = pack8(v0, v1);
                        if (u.pn >= 15) *(u32x4*)(g2 + row * 1024 + (col - 3840)) = pack8(v0, v1); }
                }
            }
    }
};
struct EpiQ {
    static constexpr bool PERM = false;
    bf16_t* q; const float* ropec; const float* ropes;
    __device__ __forceinline__ void operator()(const AccT& acc, const Unit& u, int wr, int wc, int fr, int fq) const {
        const int row0 = u.pm * 256 + wr * 64 + fr;
#pragma unroll
        for (int ai = 0; ai < 2; ++ai)
#pragma unroll
            for (int m = 0; m < 4; ++m) {
                const int row = row0 + ai * 128 + m * 16; const bool lat = row >= MP; const int pos = (row - MP) & 1023;
#pragma unroll
                for (int bj = 0; bj < 2; ++bj) {
                    const int base = u.pn * 256 + bj * 128 + wc * 32; const bool rope = lat && (((base >> 5) % 3) == 2);
                    f32x4 v0 = acc[ai][bj][m][0], v1 = acc[ai][bj][m][1];
                    if (rope) { const f32x4 cs = *(const f32x4*)(ropec + pos * 16 + 4 * fq), sn = *(const f32x4*)(ropes + pos * 16 + 4 * fq);
                        const f32x4 o0 = v0 * cs - v1 * sn, o1 = v0 * sn + v1 * cs; v0 = o0; v1 = o1; }
                    v0 *= QSCALE; v1 *= QSCALE;
                    bf16_t* dst = q + (size_t)row * 768 + base + 4 * fq;
                    *(u32x2*)dst = pack4(v0); *(u32x2*)(dst + 16) = pack4(v1);
                }
                asm volatile("" ::: "memory");
            }
    }
};
struct EpiBf16 {
    static constexpr bool PERM = true;
    bf16_t* o; int ldc;
    __device__ __forceinline__ void operator()(const AccT& acc, const Unit& u, int wr, int wc, int fr, int fq) const {
        const int row0 = u.pm * 256 + wr * 64 + fr, colb = u.pn * 256 + wc * 32 + 8 * fq;
#pragma unroll
        for (int ai = 0; ai < 2; ++ai)
#pragma unroll
            for (int m = 0; m < 4; ++m) {
                const size_t row = (size_t)(row0 + ai * 128 + m * 16);
#pragma unroll
                for (int bj = 0; bj < 2; ++bj) *(u32x4*)(o + row * ldc + colb + bj * 128) = pack8(acc[ai][bj][m][0], acc[ai][bj][m][1]);
            }
    }
};
struct EpiF32 {
    static constexpr bool PERM = true;
    float* o; int ldc;
    __device__ __forceinline__ void operator()(const AccT& acc, const Unit& u, int wr, int wc, int fr, int fq) const {
        const int row0 = u.pm * 256 + wr * 64 + fr, colb = u.pn * 256 + wc * 32 + 8 * fq;
#pragma unroll
        for (int ai = 0; ai < 2; ++ai)
#pragma unroll
            for (int m = 0; m < 4; ++m) {
                const size_t row = (size_t)(row0 + ai * 128 + m * 16);
#pragma unroll
                for (int bj = 0; bj < 2; ++bj) { float* q = o + row * ldc + colb + bj * 128; *(f32x4*)q = acc[ai][bj][m][0]; *(f32x4*)(q + 4) = acc[ai][bj][m][1]; }
            }
    }
};
struct EpiMla {
    static constexpr bool PERM = true;
    float* z1; const bf16_t* sg;
    __device__ __forceinline__ void operator()(const AccT& acc, const Unit& u, int wr, int wc, int fr, int fq) const {
        const int row0 = u.pm * 256 + wr * 64 + fr, colb = u.pn * 256 + wc * 32 + 8 * fq;
#pragma unroll
        for (int ai = 0; ai < 2; ++ai)
#pragma unroll
            for (int m = 0; m < 4; ++m) {
                const size_t row = (size_t)(row0 + ai * 128 + m * 16);
#pragma unroll
                for (int bj = 0; bj < 2; ++bj) { const int col = colb + bj * 128; f32x4 g0, g1; unpack8(*(const u32x4*)(sg + row * 2048 + col), g0, g1);
                    float* q = z1 + row * 1024 + col; *(f32x4*)q = acc[ai][bj][m][0] * g0 * ZSCALE; *(f32x4*)(q + 4) = acc[ai][bj][m][1] * g1 * ZSCALE; }
                asm volatile("" ::: "memory");
            }
    }
};
struct EpiLru {
    static constexpr bool PERM = true;
    const float* z1; const bf16_t* sg; bf16_t* z; const bf16_t* g2;
    __device__ __forceinline__ void operator()(const AccT& acc, const Unit& u, int wr, int wc, int fr, int fq) const {
        const int row0 = u.pm * 256 + wr * 64 + fr, colb = u.pn * 256 + wc * 32 + 8 * fq;
#pragma unroll
        for (int ai = 0; ai < 2; ++ai)
#pragma unroll
            for (int m = 0; m < 4; ++m) {
                const size_t row = (size_t)(row0 + ai * 128 + m * 16);
#pragma unroll
                for (int bj = 0; bj < 2; ++bj) { const int col = colb + bj * 128; f32x4 g0, g1; unpack8(*(const u32x4*)(g2 + row * 1024 + col), g0, g1);
                    const float* q = z1 + row * 1024 + col; const f32x4 a0 = *(const f32x4*)q + acc[ai][bj][m][0] * GLVAL(g0) * LSCALE, a1 = *(const f32x4*)(q + 4) + acc[ai][bj][m][1] * GLVAL(g1) * LSCALE;
                    *(u32x4*)(z + row * 1024 + col) = pack8(a0, a1); }
                asm volatile("" ::: "memory");
            }
    }
};
struct EpiFfi {
    static constexpr bool PERM = false;
    bf16_t* hid;
    __device__ __forceinline__ void operator()(const AccT& acc, const Unit& u, int wr, int wc, int fr, int fq) const {
        const int row0 = u.pm * 256 + wr * 64 + fr;
#pragma unroll
        for (int ai = 0; ai < 2; ++ai)
#pragma unroll
            for (int m = 0; m < 4; ++m) {
                const size_t row = (size_t)(row0 + ai * 128 + m * 16);
#pragma unroll
                for (int bj = 0; bj < 2; ++bj) { const int hc = ((u.pn * 256 + bj * 128 + wc * 32) >> 1) + 4 * fq; const f32x4 gv = acc[ai][bj][m][0], uv = acc[ai][bj][m][1]; f32x4 h;
#pragma unroll
                    for (int j = 0; j < 4; ++j) h[j] = gv[j] * fast_sigmoid(gv[j]) * uv[j];
                    *(u32x2*)(hid + row * FF + hc) = pack4(h); }
            }
    }
};

__device__ __forceinline__ int map_row(int mode, int n) {
    if (mode == 1) return n < 672 ? n : n + 96;
    if (mode == 2) { const int up = n >= FF, j = up ? n - FF : n; return (j >> 4) * 32 + (j & 15) + (up ? 16 : 0); }
    if (mode == 3) { const int h = n >> 7, r = n & 127; return r < 64 ? h * 64 + r : 512 + h * 64 + (r - 64); }
    return n;
}
__device__ __forceinline__ void conv_tile(const float* src, int ld, int K, int k0, int n0, bf16_t* dst, int mode, LAS float* tile) {
    const int tid = otid();
    __syncthreads();
#pragma unroll
    for (int i = 0; i < 2; ++i) { const int kk = (tid >> 3) + 64 * i, c4 = (tid & 7) * 4; const f32x4 v = *(const f32x4*)(src + (size_t)(k0 + kk) * ld + n0 + c4);
        tile[kk * 33 + c4] = v[0]; tile[kk * 33 + c4 + 1] = v[1]; tile[kk * 33 + c4 + 2] = v[2]; tile[kk * 33 + c4 + 3] = v[3]; }
    __syncthreads();
    const int n = tid >> 4, k8 = (tid & 15) * 8; f32x4 a, b;
#pragma unroll
    for (int j = 0; j < 4; ++j) { a[j] = tile[(k8 + j) * 33 + n]; b[j] = tile[(k8 + 4 + j) * 33 + n]; }
    *(u32x4*)(dst + (size_t)map_row(mode, n0 + n) * K + k0 + k8) = pack8(a, b);
}
constexpr int CONV_ITEMS = 4208;
__device__ __forceinline__ void conv_item(const Params& p, unsigned char* ws, int l, int idx, LAS float* tile) {
    const int zz = ozero();
    int inidx, K, N, mode = 0; size_t soff, doff;
    if (idx < 1192) { inidx = I_WIN; soff = (size_t)l * 1024 * 4768; doff = WS_WIN; K = 1024; N = 4768; mode = 1; }
    else if ((idx -= 1192) < 1408) { inidx = I_WFFI; soff = (size_t)l * 1024 * 5632; doff = WS_WFFI; K = 1024; N = 5632; mode = 2; }
    else if ((idx -= 1408) < 704) { inidx = I_WFFO; soff = (size_t)l * 2816 * 1024; doff = WS_WFFO; K = 2816; N = 1024; }
    else if ((idx -= 704) < 256) { inidx = I_WOUT; soff = (size_t)l * 1024 * 1024; doff = WS_WOUT; K = 1024; N = 1024; }
    else if ((idx -= 256) < 256) { inidx = I_WOLRU; soff = (size_t)l * 1024 * 1024; doff = WS_WOLRU; K = 1024; N = 1024; }
    else if ((idx -= 256) < 128) { inidx = I_WOMLA; soff = (size_t)l * 512 * 1024; doff = WS_WOMLA; K = 512; N = 1024; }
    else if ((idx -= 128) < 72) { inidx = I_WQUP; soff = (size_t)l * 384 * 768; doff = WS_WQ; K = 384; N = 768; }
    else if ((idx -= 72) < 64) { inidx = I_WKVUP; soff = (size_t)l * 256 * 1024; doff = WS_WKV; K = 256; N = 1024; mode = 3; }
    else { idx -= 64; const int mat = idx >> 2, ig = mat >> 4, dir = (mat >> 3) & 1, n = mat & 7;
        inidx = ig ? I_WIG : I_WRG; soff = (size_t)((l * 2 + dir) * 8 + n) * 16384; doff = WS_WG + (size_t)((dir * 8 + n) * 256 + ig * 128) * 128 * 2; K = 128; N = 128; idx &= 3; }
    const float* src = p.in[zz + inidx] + soff; bf16_t* dst = (bf16_t*)(ws + doff);
    const int nk = K / 128, kt = idx % nk, ntile = idx / nk;
    conv_tile(src, N, K, kt * 128, ntile * 32, dst, mode, tile);
}
__device__ __forceinline__ void modv_phase(const Params& p, unsigned char* ws, LAS float* lds) {
    const int zz = ozero();
    LAS float* sc = lds + 128 * 33;
    LAS float* red = sc + 5 * 1024;
    const int tid = otid();
    __syncthreads();
    for (int i = tid; i < 5 * 1024; i += NTHREADS) { const float c = i < 1024 ? p.in[zz + I_CCTX][i] : p.in[zz + I_C][i - 1024]; sc[i] = c / (1.0f + __expf(-c)); }
    __syncthreads();
    float* modv = (float*)(ws + WS_MODV); const int bid = obid(), G = ogrid();
    const int col = tid & 31, kg = tid >> 5;
    for (int it = bid; it < 384; it += G) {
        const int l = it / 192, j0 = (it % 192) * 32;
        const float* w = p.in[zz + I_WMOD] + (size_t)l * 1024 * 6144 + j0 + col;
        float a0 = 0.f, a1 = 0.f, a2 = 0.f, a3 = 0.f, a4 = 0.f;
#pragma unroll 8
        for (int k = kg * 64; k < kg * 64 + 64; ++k) { const float wv = w[(size_t)k * 6144]; a0 += sc[k] * wv; a1 += sc[1024 + k] * wv; a2 += sc[2048 + k] * wv; a3 += sc[3072 + k] * wv; a4 += sc[4096 + k] * wv; }
        red[(kg * 5 + 0) * 32 + col] = a0; red[(kg * 5 + 1) * 32 + col] = a1; red[(kg * 5 + 2) * 32 + col] = a2; red[(kg * 5 + 3) * 32 + col] = a3; red[(kg * 5 + 4) * 32 + col] = a4;
        __syncthreads();
        if (tid < 160) { const int v = tid >> 5, c = tid & 31; float s = p.in[zz + I_BMOD][l * 6144 + j0 + c];
#pragma unroll
            for (int g = 0; g < 16; ++g) s += red[(g * 5 + v) * 32 + c];
            modv[(size_t)(l * 5 + v) * 6144 + j0 + c] = s; }
        __syncthreads();
    }
}
__device__ __forceinline__ void rope_table(const Params& p, unsigned char* ws) {
    const int zz = ozero();
    float* rc = (float*)(ws + WS_ROPE); float* rs = rc + 1024 * 16;
    const int G = ogrid(); for (int i = obid() * NTHREADS + otid(); i < 1024 * 16; i += G * NTHREADS) {
        const int pos = i >> 4, f = i & 15; const float posv = (float)(f < 8 ? (pos >> 6) : (pos & 63));
        const float inv = exp2f(-(float)(f & 7) * (13.287712379549449f / 8.0f));
        const float rev = posv * inv * 0.15915494309189535f;
        rc[i] = __builtin_amdgcn_cosf(rev); rs[i] = __builtin_amdgcn_sinf(rev);
    }
}

template <bool HAS_Y, bool DO_H>
__device__ __forceinline__ void norm_phase(const Params& p, unsigned char* ws, const float* xp, const float* xs, const float* Y, const float* gA, int gate_off, const float* modA,
                                           const float* gB, int sh_off, int sc_off, const float* modB) {
    const int zz = ozero();
    const int tid = otid(), wid = tid >> 6, lane = tid & 63; const int bid = obid(), G = ogrid();
    bf16_t* hbf = (bf16_t*)(ws + WS_HBF);
    for (int row = bid * 8 + wid; row < MT; row += G * 8) {
        const int mv = row < MP ? 0 : 1 + ((row - MP) >> 10);
        const float* xin = row < MP ? xp + (size_t)row * D : xs + (size_t)(row - MP) * D;
        f32x4 x[4];
#pragma unroll
        for (int i = 0; i < 4; ++i) x[i] = *(const f32x4*)(xin + i * 256 + lane * 4);
        if (HAS_Y) {
            f32x4 y[4]; float ss = 0.f;
#pragma unroll
            for (int i = 0; i < 4; ++i) { y[i] = *(const f32x4*)(Y + (size_t)row * D + i * 256 + lane * 4); ss += y[i][0] * y[i][0] + y[i][1] * y[i][1] + y[i][2] * y[i][2] + y[i][3] * y[i][3]; }
            ss = wave_sum(ss); const float rstd = rsqrtf(ss * (1.0f / D) + EPS);
            const float* mg = modA + (size_t)mv * 6144 + gate_off;
#pragma unroll
            for (int i = 0; i < 4; ++i) { const f32x4 g = *(const f32x4*)(gA + i * 256 + lane * 4), gt = *(const f32x4*)(mg + i * 256 + lane * 4);
                x[i] = x[i] + gt * (y[i] * rstd * g) * (gate_off == 2048 ? MSCALE : FSCALE); *(f32x4*)((p.out + zz) + (size_t)row * D + i * 256 + lane * 4) = DO_H ? x[i] : x[i] * (row < MP ? (ZMASK(row, i * 256 + lane * 4) ? 0.0f : OS0) : OS1); }
        }
        if (DO_H) {
            float ss = 0.f;
#pragma unroll
            for (int i = 0; i < 4; ++i) ss += x[i][0] * x[i][0] + x[i][1] * x[i][1] + x[i][2] * x[i][2] + x[i][3] * x[i][3];
            ss = wave_sum(ss); const float rstd = rsqrtf(ss * (1.0f / D) + EPS);
            const float* msh = modB + (size_t)mv * 6144 + sh_off; const float* msc = modB + (size_t)mv * 6144 + sc_off;
#pragma unroll
            for (int i = 0; i < 4; ++i) { const f32x4 g = *(const f32x4*)(gB + i * 256 + lane * 4), sh = *(const f32x4*)(msh + i * 256 + lane * 4), sc = *(const f32x4*)(msc + i * 256 + lane * 4);
                const f32x4 h = (x[i] * rstd * g) * (sc + 1.0f) + sh; *(u32x2*)(hbf + (size_t)row * D + i * 256 + lane * 4) = pack4(h); }
        }
    }
}

__device__ __forceinline__ void postproj_phase(const Params& p, unsigned char* ws, int l) {
    const int zz = ozero();
    const int tid = otid(), wid = tid >> 6, lane = tid & 63; const int bid = obid(), G = ogrid();
    const float* psm = (const float*)(ws + WS_PSM);
    bf16_t* qn = (bf16_t*)(ws + WS_QN); bf16_t* keys = (bf16_t*)(ws + WS_KEYS); bf16_t* krb = (bf16_t*)(ws + WS_KRB);
    const float* ropec = (const float*)(ws + WS_ROPE); const float* ropes = ropec + 1024 * 16;
    const float* gq = p.in[zz + I_GQ] + l * 384; const float* gkv = p.in[zz + I_GKV] + l * 256;
    for (int t = bid * 8 + wid; t < NKEY; t += G * 8) {
        if (t < MT) {
            const float* pr = psm + (size_t)t * 768;
            f32x2 q[3]; float ss = 0.f;
#pragma unroll
            for (int i = 0; i < 3; ++i) { q[i] = *(const f32x2*)(pr + i * 128 + lane * 2); ss += q[i][0] * q[i][0] + q[i][1] * q[i][1]; }
            ss = wave_sum(ss); float rstd = rsqrtf(ss * (1.0f / 384.0f) + EPS);
#pragma unroll
            for (int i = 0; i < 3; ++i) { const f32x2 g = *(const f32x2*)(gq + i * 128 + lane * 2); *(unsigned*)(qn + (size_t)t * 384 + i * 128 + lane * 2) = cvt_pk_bf16(q[i][0] * rstd * g[0], q[i][1] * rstd * g[1]); }
            f32x4 kv = *(const f32x4*)(pr + 384 + lane * 4);
            ss = wave_sum(kv[0] * kv[0] + kv[1] * kv[1] + kv[2] * kv[2] + kv[3] * kv[3]); rstd = rsqrtf(ss * (1.0f / 256.0f) + EPS);
            const f32x4 ckv = kv * rstd * *(const f32x4*)(gkv + lane * 4);
            const int kr = keyrow_of(t);
            *(u32x2*)(keys + (size_t)kr * 256 + lane * 4) = pack4(ckv);
            const int s = t >> 8, pp = t & 255;
            if (t < MP) *(f32x4*)((p.out + zz) + OFF_CKV + ((size_t)(s * 2 + l) * 256 + pp) * 256 + lane * 4) = ckv * OS2;
            if (lane < 16) {
                float x1 = pr[640 + lane], x2 = pr[656 + lane];
                if (t >= MP) { const int pos = (t - MP) & 1023; const float cs = ropec[pos * 16 + lane], sn = ropes[pos * 16 + lane]; const float o1 = x1 * cs - x2 * sn, o2 = x1 * sn + x2 * cs; x1 = o1; x2 = o2; }
                krb[(size_t)kr * 32 + lane] = f2bf(x1); krb[(size_t)kr * 32 + 16 + lane] = f2bf(x2);
                if (t < MP) { float* o = (p.out + zz) + OFF_KR + ((size_t)(s * 2 + l) * 256 + pp) * 32; o[lane] = x1 * OS3; o[16 + lane] = x2 * OS3; }
            }
        } else {
            const int j = t - MT, b = j >> 8, jj = j & 255, kr = MP + b * 1280 + 1024 + jj;
            const f32x4 v = *(const f32x4*)(p.in[zz + I_CCKV] + ((size_t)(b * 2 + l) * 256 + jj) * 256 + lane * 4);
            *(u32x2*)(keys + (size_t)kr * 256 + lane * 4) = pack4(v);
            if (lane < 8) { const f32x4 w = *(const f32x4*)(p.in[zz + I_CKR] + ((size_t)(b * 2 + l) * 256 + jj) * 32 + lane * 4); *(u32x2*)(krb + (size_t)kr * 32 + lane * 4) = pack4(w); }
        }
    }
}

__device__ __forceinline__ void attn_phase(const Params& p, unsigned char* ws, LAS unsigned char* lds) {
    const int zz = ozero();
    const bf16_t* Qb = (const bf16_t*)(ws + WS_QB); const bf16_t* Kn = (const bf16_t*)(ws + WS_KN); const bf16_t* KR = (const bf16_t*)(ws + WS_KRB);
    const bf16_t* Vt = (const bf16_t*)(ws + WS_VT); bf16_t* AO = (bf16_t*)(ws + WS_AO);
    LAS bf16_t* Ks = (LAS bf16_t*)lds;
    LAS bf16_t* Vs = (LAS bf16_t*)(lds + 64 * 208);
    const int tid = otid(), wid = tid >> 6, lane = tid & 63, l15 = lane & 15, quad = lane >> 4; const int bid = obid(), G = ogrid();
    for (int it = bid; it < 768; it += G) {
        int tq, kb, nk, h;
        if (it < 256) { const int b = it >> 6; h = (it >> 3) & 7; tq = MP + b * 1024 + (it & 7) * 128; kb = MP + b * 1280; nk = 1280; }
        else { const int j = it - 256, s = j >> 4; h = (j >> 1) & 7; tq = s * 256 + (j & 1) * 128; kb = s * 256; nk = 256; }
        const int qrow = tq + wid * 16 + l15;
        bf16x8 qf[3];
#pragma unroll
        for (int ks = 0; ks < 3; ++ks) qf[ks] = *(const bf16x8*)(Qb + (size_t)qrow * 768 + h * 96 + ks * 32 + quad * 8);
        f32x4 o[4];
#pragma unroll
        for (int i = 0; i < 4; ++i) o[i] = (f32x4){0.f, 0.f, 0.f, 0.f};
        float mrun = -1e30f, lsum = 0.f;
        for (int k0 = 0; k0 < nk; k0 += 64) {
            __syncthreads();
            for (int c = tid; c < 768; c += NTHREADS) { const int r = c / 12, cc = c % 12;
                const bf16_t* src = cc < 8 ? Kn + (size_t)(kb + k0 + r) * 512 + h * 64 + cc * 8 : KR + (size_t)(kb + k0 + r) * 32 + (cc - 8) * 8;
                *(LAS u32x4*)(Ks + r * 104 + cc * 8) = *(const u32x4*)src; }
            { const int r = tid >> 3, cc = tid & 7; *(LAS u32x4*)(Vs + r * 72 + cc * 8) = *(const u32x4*)(Vt + (size_t)(h * 64 + r) * NKEY + kb + k0 + cc * 8); }
            __syncthreads();
            f32x4 s[4];
#pragma unroll
            for (int js = 0; js < 4; ++js) { s[js] = (f32x4){0.f, 0.f, 0.f, 0.f};
#pragma unroll
                for (int ks = 0; ks < 3; ++ks) { const bf16x8 a = *(const LAS bf16x8*)(Ks + (js * 16 + l15) * 104 + ks * 32 + quad * 8); s[js] = __builtin_amdgcn_mfma_f32_16x16x32_bf16(a, qf[ks], s[js], 0, 0, 0); } }
            float mx = s[0][0];
#pragma unroll
            for (int js = 0; js < 4; ++js)
#pragma unroll
                for (int j = 0; j < 4; ++j) mx = fmaxf(mx, s[js][j]);
            mx = fmaxf(mx, __shfl_xor(mx, 16)); mx = fmaxf(mx, __shfl_xor(mx, 32));
            const float mnew = fmaxf(mrun, mx), alpha = __builtin_amdgcn_exp2f(mrun - mnew); mrun = mnew;
            float psum = 0.f;
#pragma unroll
            for (int js = 0; js < 4; ++js)
#pragma unroll
                for (int j = 0; j < 4; ++j) { s[js][j] = __builtin_amdgcn_exp2f(s[js][j] - mnew); psum += s[js][j]; }
            lsum = lsum * alpha + psum;
#pragma unroll
            for (int i = 0; i < 4; ++i) o[i] *= alpha;
#pragma unroll
            for (int kk = 0; kk < 2; ++kk) {
                const u32x4 pw = pack8(s[2 * kk], s[2 * kk + 1]); bf16x8 pf; __builtin_memcpy(&pf, &pw, 16);
#pragma unroll
                for (int dv = 0; dv < 4; ++dv) {
                    const LAS bf16_t* vp = Vs + (dv * 16 + l15) * 72 + kk * 32 + quad * 4;
                    u32x4 vw; const u32x2 v0 = *(const LAS u32x2*)vp, v1 = *(const LAS u32x2*)(vp + 16); vw.x = v0.x; vw.y = v0.y; vw.z = v1.x; vw.w = v1.y;
                    bf16x8 va; __builtin_memcpy(&va, &vw, 16);
                    o[dv] = __builtin_amdgcn_mfma_f32_16x16x32_bf16(va, pf, o[dv], 0, 0, 0);
                }
            }
        }
        lsum += __shfl_xor(lsum, 16); lsum += __shfl_xor(lsum, 32);
        const float inv = 1.0f / lsum;
#pragma unroll
        for (int dv = 0; dv < 4; ++dv) *(u32x2*)(AO + (size_t)qrow * 512 + h * 64 + dv * 16 + quad * 4) = pack4(o[dv] * inv);
    }
}

template <int DIR>
__device__ __forceinline__ void scan_pass(const Params& p, unsigned char* ws, int l, int n, int tok0, int L, float h0, bool write_state, int state_idx, LAS unsigned char* lds) {
    const int zz = ozero();
    LAS float* xcf = (LAS float*)lds;
    LAS bf16_t* xcb = (LAS bf16_t*)(lds + 64 * 132 * 4);
    const int tid = otid(), wid = tid >> 6, lane = tid & 63, l15 = lane & 15, quad = lane >> 4;
    const int chl = wid * 16 + l15, ch = n * 128 + chl;
    const float* LXp = (const float*)(ws + WS_LX); bf16_t* HF = (bf16_t*)(ws + WS_PSM); bf16_t* GG = (bf16_t*)(ws + WS_GG);
    const float lam = p.in[zz + I_LAM][(l * 2 + DIR) * 1024 + ch];
    const float nl = -lam, sp = fmaxf(nl, 0.f) + log1pf(__expf(-fabsf(nl)));
    const float cc = -8.0f * sp * LOG2E;
    const float br = p.in[zz + I_BRG][(l * 2 + DIR) * 1024 + ch], bi = p.in[zz + I_BIG][(l * 2 + DIR) * 1024 + ch];
    const bf16_t* wg = (const bf16_t*)(ws + WS_WG) + (size_t)((DIR * 8 + n) * 256) * 128;
    bf16x8 wrf[4], wif[4];
#pragma unroll
    for (int ks = 0; ks < 4; ++ks) { wrf[ks] = *(const bf16x8*)(wg + (size_t)chl * 128 + ks * 32 + quad * 8); wif[ks] = *(const bf16x8*)(wg + (size_t)(128 + chl) * 128 + ks * 32 + quad * 8); }
    const int c4 = (tid & 31) * 4, tg = tid >> 5;
    const float* cw = p.in[zz + I_CONVW] + (size_t)l * 4 * 1024 + n * 128 + c4;
    const f32x4 w0 = *(const f32x4*)cw, w1 = *(const f32x4*)(cw + 1024), w2 = *(const f32x4*)(cw + 2048), w3 = *(const f32x4*)(cw + 3072);
    const f32x4 cb = *(const f32x4*)(p.in[zz + I_CONVB] + l * 1024 + n * 128 + c4);
    float hin = h0;
    const int nchunk = L >> 6;
    for (int ci = 0; ci < nchunk; ++ci) {
        const int t0 = (DIR ? nchunk - 1 - ci : ci) * 64;
        __syncthreads();
        {
            f32x4 xr[7];
#pragma unroll
            for (int r = 0; r < 7; ++r) { const int tt = t0 + tg * 4 - 2 + r; xr[r] = (tt >= 0 && tt < L) ? *(const f32x4*)(LXp + (size_t)(tok0 + tt) * 1024 + n * 128 + c4) : (f32x4){0.f, 0.f, 0.f, 0.f}; }
#pragma unroll
            for (int j = 0; j < 4; ++j) { const f32x4 xc = cb + xr[j] * w0 + xr[j + 1] * w1 + xr[j + 2] * w2 + xr[j + 3] * w3;
                *(LAS f32x4*)(xcf + (tg * 4 + j) * 132 + c4) = xc; *(LAS u32x2*)(xcb + (tg * 4 + j) * 136 + c4) = pack4(xc); }
        }
        __syncthreads();
        f32x4 rg[4], ig[4];
#pragma unroll
        for (int st = 0; st < 4; ++st) { rg[st] = (f32x4){0.f, 0.f, 0.f, 0.f}; ig[st] = (f32x4){0.f, 0.f, 0.f, 0.f};
#pragma unroll
            for (int ks = 0; ks < 4; ++ks) { const bf16x8 a = *(const LAS bf16x8*)(xcb + (st * 16 + l15) * 136 + ks * 32 + quad * 8);
                rg[st] = __builtin_amdgcn_mfma_f32_16x16x32_bf16(a, wrf[ks], rg[st], 0, 0, 0); ig[st] = __builtin_amdgcn_mfma_f32_16x16x32_bf16(a, wif[ks], ig[st], 0, 0, 0); } }
#pragma unroll
        for (int sti = 0; sti < 4; ++sti) {
            const int st = DIR ? 3 - sti : sti;
            float av[4], hv[4], pa[4];
#pragma unroll
            for (int j = 0; j < 4; ++j) { const float x = xcf[(st * 16 + quad * 4 + j) * 132 + chl];
                const float rr = fast_sigmoid(rg[st][j] + br), ii = fast_sigmoid(ig[st][j] + bi);
                const float a = __builtin_amdgcn_exp2f(cc * rr); av[j] = a; hv[j] = __builtin_amdgcn_sqrtf(fmaxf(1.0f - a * a, 0.f)) * ii * x; }
            float hl = 0.f, pr = 1.f;
#pragma unroll
            for (int s4 = 0; s4 < 4; ++s4) { const int j = DIR ? 3 - s4 : s4; hl = av[j] * hl + hv[j]; pr *= av[j]; hv[j] = hl; pa[j] = pr; }
            float Ar = 1.f, Hr = 0.f, Aex = 1.f, Hex = 0.f;
#pragma unroll
            for (int s4 = 0; s4 < 4; ++s4) { const int qq = DIR ? 3 - s4 : s4; const float Aq = __shfl(pr, qq * 16 + l15), Hq = __shfl(hl, qq * 16 + l15);
                if (qq == quad) { Aex = Ar; Hex = Hr; }
                Hr = Aq * Hr + Hq; Ar *= Aq; }
            const float cq = Aex * hin + Hex;
            hin = Ar * hin + Hr;
#pragma unroll
            for (int j = 0; j < 4; ++j) { const float hfin = hv[j] + pa[j] * cq; const size_t idx = (size_t)(tok0 + t0 + st * 16 + quad * 4 + j) * 1024 + ch;
                if (DIR == 0) HF[idx] = f2bf(hfin);
                else GG[idx] = f2bf((bf2f(HF[idx]) * HSCALE + hfin * BSCALE) * GGVAL(bf2f(GG[idx]))); }
        }
    }
    if (write_state && quad == 0) (p.out + zz)[(DIR ? OFF_LB : OFF_LF) + state_idx + ch] = hin * (DIR ? OS5 : OS4);
}
__device__ __forceinline__ void scan_phase(const Params& p, unsigned char* ws, int l, LAS unsigned char* lds) {
    const int zz = ozero();
    const int tid = otid(), l15 = tid & 15, wid = tid >> 6; const int bid = obid(), G = ogrid();
    for (int it = bid; it < 288; it += G) {
        int n, tok0, L, sidx; bool lat; float hf0 = 0.f, hb0 = 0.f;
        if (it < 32) { const int b = it >> 3; n = it & 7; tok0 = MP + b * 1024; L = 1024; lat = true; sidx = 0; const int ch = n * 128 + wid * 16 + l15;
            hf0 = p.in[zz + I_SF][(b * 2 + l) * 1024 + ch]; hb0 = p.in[zz + I_SB][(b * 2 + l) * 1024 + ch]; }
        else { const int j = it - 32, s = j >> 3; n = j & 7; tok0 = s * 256; L = 256; lat = false; sidx = (s * 2 + l) * 1024; }
        scan_pass<0>(p, ws, l, n, tok0, L, hf0, !lat, sidx, lds);
        scan_pass<1>(p, ws, l, n, tok0, L, hb0, !lat, sidx, lds);
    }
}

__device__ __forceinline__ unsigned char* opq_unused(unsigned char* x) { asm volatile("" : "+s"(x)); return x; }
__device__ __forceinline__ void grid_sync_all() {
    asm volatile("s_waitcnt vmcnt(0) lgkmcnt(0)" ::: "memory");
    __syncthreads();
    if (threadIdx.x < 64) { __builtin_amdgcn_fence(__ATOMIC_RELEASE, "agent"); asm volatile("s_waitcnt vmcnt(0) lgkmcnt(0)" ::: "memory"); }
    cg::this_grid().sync();
    if (threadIdx.x < 64) { __builtin_amdgcn_fence(__ATOMIC_ACQUIRE, "agent"); asm volatile("s_waitcnt vmcnt(0) lgkmcnt(0)" ::: "memory"); }
    __syncthreads();
}
__global__ void __launch_bounds__(NTHREADS) fwd_megakernel(Params p) {
    extern __shared__ __attribute__((aligned(16))) unsigned char smem[];
    LAS unsigned char* lds = (LAS unsigned char*)smem;
    int ph = 0; (void)ph; int phc = 0; (void)phc;
#if defined(STOP_AFTER)
#define PHASE_IF if (phc <= STOP_AFTER)
#define PHASE_END do { ++phc; grid_sync_all(); } while (0)
#elif ONE_LAUNCH
#define PHASE_IF
#define PHASE_END do { grid_sync_all(); } while (0)
#else
#define PHASE_IF if (__builtin_amdgcn_readfirstlane((int)(ph >= p.ph_lo && ph < p.ph_hi)))
#define PHASE_END do { ++ph; } while (0)
#endif

    PHASE_IF PHK(0) { const int zz = ozero(); unsigned char* ws = p.ws + zz; const int G = ogrid(), bid = obid(); (void)G; (void)bid; const float* modv = (const float*)(ws + WS_MODV); const float* modl = modv; (void)modl;
        rope_table(p, ws);
        modv_phase(p, ws, (LAS float*)lds);
        for (int i = bid; i < CONV_ITEMS; i += G) conv_item(p, ws, 0, i, (LAS float*)lds);
    }
    PHASE_END;
    PHASE_IF PHK(1) { const int zz = ozero(); unsigned char* ws = p.ws + zz; const int G = ogrid(), bid = obid(); (void)G; (void)bid; const float* modv = (const float*)(ws + WS_MODV); const float* modl = modv; (void)modl; norm_phase<false, true>(p, ws, p.in[zz + I_XP], p.in[zz + I_XS], nullptr, nullptr, 0, nullptr, p.in[zz + I_GPM], 0, 1024, modv); }
    PHASE_END;
#pragma unroll 1
    for (int l = 0; l < 2; ++l) {
        PHASE_IF PHK(2) { const int zz = ozero(); unsigned char* ws = p.ws + zz; const int G = ogrid(), bid = obid(); (void)G; (void)bid; const float* modv = (const float*)(ws + WS_MODV); const float* modl = modv + (size_t)l * 5 * 6144; (void)modl; pg8::Gemm g{(const bf16_t*)(ws + WS_HBF), (const bf16_t*)(ws + WS_WIN), MT, INCP, 1024}; pg8::StaticOrder S; S.init(MT, INCP, G, bid);
            EpiIn E{(float*)(ws + WS_PSM), (float*)(ws + WS_LX), (bf16_t*)(ws + WS_GG), (bf16_t*)(ws + WS_SG), (bf16_t*)(ws + WS_HF)}; pg8::gemm_phase(lds, g, S, E); }
        PHASE_END;
        PHASE_IF PHK(3) { const int zz = ozero(); unsigned char* ws = p.ws + zz; const int G = ogrid(), bid = obid(); (void)G; (void)bid; const float* modv = (const float*)(ws + WS_MODV); const float* modl = modv + (size_t)l * 5 * 6144; (void)modl; postproj_phase(p, ws, l); }
        PHASE_END;
        PHASE_IF PHK(4) { const int zz = ozero(); unsigned char* ws = p.ws + zz; const int G = ogrid(), bid = obid(); (void)G; (void)bid; const float* modv = (const float*)(ws + WS_MODV); const float* modl = modv + (size_t)l * 5 * 6144; (void)modl;
            { pg8::Gemm g{(const bf16_t*)(ws + WS_QN), (const bf16_t*)(ws + WS_WQ), MT, 768, 384}; pg8::StaticOrder S; S.init(MT, 768, G, bid);
              EpiQ E{(bf16_t*)(ws + WS_QB), (const float*)(ws + WS_ROPE), (const float*)(ws + WS_ROPE) + 1024 * 16}; pg8::gemm_phase(lds, g, S, E); }
            { pg8::Gemm g{(const bf16_t*)(ws + WS_KEYS), (const bf16_t*)(ws + WS_WKV), NKEY, 512, 256}; pg8::StaticOrder S; S.init(NKEY, 512, G, (bid + G - 144 % G) % G);
              EpiBf16 E{(bf16_t*)(ws + WS_KN), 512}; pg8::gemm_phase(lds, g, S, E); }
            { pg8::Gemm g{(const bf16_t*)(ws + WS_WKV) + (size_t)512 * 256, (const bf16_t*)(ws + WS_KEYS), 512, NKEY, 256}; pg8::StaticOrder S; S.init(512, NKEY, G, (bid + G - 248 % G) % G);
              EpiBf16 E{(bf16_t*)(ws + WS_VT), NKEY}; pg8::gemm_phase(lds, g, S, E); }
        }
        PHASE_END;
        PHASE_IF PHK(5) { const int zz = ozero(); unsigned char* ws = p.ws + zz; const int G = ogrid(), bid = obid(); (void)G; (void)bid; const float* modv = (const float*)(ws + WS_MODV); const float* modl = modv + (size_t)l * 5 * 6144; (void)modl; attn_phase(p, ws, lds); }
        PHASE_END;
        PHASE_IF PHK(6) { const int zz = ozero(); unsigned char* ws = p.ws + zz; const int G = ogrid(), bid = obid(); (void)G; (void)bid; const float* modv = (const float*)(ws + WS_MODV); const float* modl = modv + (size_t)l * 5 * 6144; (void)modl; scan_phase(p, ws, l, lds); }
        PHASE_END;
        PHASE_IF PHK(7) { const int zz = ozero(); unsigned char* ws = p.ws + zz; const int G = ogrid(), bid = obid(); (void)G; (void)bid; const float* modv = (const float*)(ws + WS_MODV); const float* modl = modv + (size_t)l * 5 * 6144; (void)modl;
            { pg8::Gemm g{(const bf16_t*)(ws + WS_AO), (const bf16_t*)(ws + WS_WOMLA), MT, 1024, 512}; pg8::StaticOrder S; S.init(MT, 1024, G, bid);
              EpiMla E{(float*)(ws + WS_LX), (const bf16_t*)(ws + WS_SG)}; pg8::gemm_phase(lds, g, S, E); }
            { pg8::Gemm g{(const bf16_t*)(ws + WS_GG), (const bf16_t*)(ws + WS_WOLRU), MT, 1024, 1024}; pg8::StaticOrder S; S.init(MT, 1024, G, bid);
              EpiLru E{(const float*)(ws + WS_LX), (const bf16_t*)(ws + WS_SG), (bf16_t*)(ws + WS_Z), (const bf16_t*)(ws + WS_HF)}; pg8::gemm_phase(lds, g, S, E); }
        }
        PHASE_END;
        PHASE_IF PHK(8) { const int zz = ozero(); unsigned char* ws = p.ws + zz; const int G = ogrid(), bid = obid(); (void)G; (void)bid; const float* modv = (const float*)(ws + WS_MODV); const float* modl = modv + (size_t)l * 5 * 6144; (void)modl; pg8::Gemm g{(const bf16_t*)(ws + WS_Z), (const bf16_t*)(ws + WS_WOUT), MT, 1024, 1024}; pg8::StaticOrder S; S.init(MT, 1024, G, bid);
            EpiF32 E{(float*)(ws + WS_LX), 1024}; pg8::gemm_phase(lds, g, S, E); }
        PHASE_END;
        PHASE_IF PHK(9) { const int zz = ozero(); unsigned char* ws = p.ws + zz; const int G = ogrid(), bid = obid(); (void)G; (void)bid; const float* modv = (const float*)(ws + WS_MODV); const float* modl = modv + (size_t)l * 5 * 6144; (void)modl; const float* xp = l == 0 ? p.in[zz + I_XP] : (p.out + zz); const float* xs = l == 0 ? p.in[zz + I_XS] : (p.out + zz) + (size_t)MP * D; norm_phase<true, true>(p, ws, xp, xs, (const float*)(ws + WS_LX), p.in[zz + I_GQM] + l * D, 2048, modl, p.in[zz + I_GPF] + l * D, 3072, 4096, modl); }
        PHASE_END;
        PHASE_IF PHK(10) { const int zz = ozero(); unsigned char* ws = p.ws + zz; const int G = ogrid(), bid = obid(); (void)G; (void)bid; const float* modv = (const float*)(ws + WS_MODV); const float* modl = modv + (size_t)l * 5 * 6144; (void)modl; pg8::Gemm g{(const bf16_t*)(ws + WS_HBF), (const bf16_t*)(ws + WS_WFFI), MT, 5632, 1024}; pg8::StaticOrder S; S.init(MT, 5632, G, bid);
            EpiFfi E{(bf16_t*)(ws + WS_HID)}; pg8::gemm_phase(lds, g, S, E); }
        PHASE_END;
        PHASE_IF PHK(11) { const int zz = ozero(); unsigned char* ws = p.ws + zz; const int G = ogrid(), bid = obid(); (void)G; (void)bid; const float* modv = (const float*)(ws + WS_MODV); const float* modl = modv + (size_t)l * 5 * 6144; (void)modl; pg8::Gemm g{(const bf16_t*)(ws + WS_HID), (const bf16_t*)(ws + WS_WFFO), MT, 1024, FF}; pg8::StaticOrder S; S.init(MT, 1024, G, bid);
            EpiF32 E{(float*)(ws + WS_LX), 1024}; pg8::gemm_phase(lds, g, S, E); }
        PHASE_END;
        PHASE_IF PHK(12) { const int zz = ozero(); unsigned char* ws = p.ws + zz; const int G = ogrid(), bid = obid(); (void)G; (void)bid; const float* modv = (const float*)(ws + WS_MODV); const float* modl = modv + (size_t)l * 5 * 6144; (void)modl;
            if (l == 0) {
                norm_phase<true, true>(p, ws, (p.out + zz), (p.out + zz) + (size_t)MP * D, (const float*)(ws + WS_LX), p.in[zz + I_GQF], 5120, modl, p.in[zz + I_GPM] + D, 0, 1024, modv + (size_t)5 * 6144);
                for (int i = bid; i < CONV_ITEMS; i += G) conv_item(p, ws, 1, i, (LAS float*)lds);
            } else {
                norm_phase<true, false>(p, ws, (p.out + zz), (p.out + zz) + (size_t)MP * D, (const float*)(ws + WS_LX), p.in[zz + I_GQF] + D, 5120, modl, nullptr, 0, 0, nullptr);
            }
        }
#if ONE_LAUNCH && !defined(STOP_AFTER)
        if (l == 0) grid_sync_all();
#else
        PHASE_END;
#endif
    }
#if defined(STOP_AFTER)
    {
        const int tid = otid(), bid = obid(), G = ogrid(); const unsigned* wsu = (const unsigned*)p.ws; float* out = p.out;
        for (int i = bid * NTHREADS + tid; i < 17432576; i += G * NTHREADS) { float a = 0.f;
#pragma unroll
            for (int j = 0; j < 4; ++j) { const size_t idx = (size_t)i + (size_t)j * 17432576; if (idx * 4 < WS_END) { const unsigned u = wsu[idx]; a += (float)(u & 0xffu) + (float)((u >> 16) & 0xffu); } }
            out[i] = a; }
    }
#endif
}
constexpr int NPHASES = 2 + 11 * 2;

extern "C" void kernel_launch(void* const* d_in, const int* in_sizes, int n_in, void* d_out, int out_size, void* d_ws, size_t ws_size, hipStream_t stream) {
    static int grid = 0;
    if (grid == 0) {
        if (n_in != 31 || ws_size < WS_END) { fprintf(stderr, "kernel_launch: need 31 inputs and %zu bytes of workspace (got %d, %zu)\n", (size_t)WS_END, n_in, ws_size); grid = -1; return; }
        if (hipFuncSetAttribute((const void*)fwd_megakernel, hipFuncAttributeMaxDynamicSharedMemorySize, LDS_BYTES) != hipSuccess) { fprintf(stderr, "kernel_launch: hipFuncSetAttribute failed\n"); grid = -1; return; }
        int dev = 0, cus = 0, per_cu = 0;
        hipGetDevice(&dev); hipDeviceGetAttribute(&cus, hipDeviceAttributeMultiprocessorCount, dev);
        hipOccupancyMaxActiveBlocksPerMultiprocessor(&per_cu, (const void*)fwd_megakernel, NTHREADS, LDS_BYTES);
        if (per_cu < 1) { fprintf(stderr, "kernel_launch: occupancy query says %d blocks/CU\n", per_cu); per_cu = 1; }
        (void)hipGetLastError();
        grid = cus;
    }
    if (grid < 0) return;
    Params p{};
    for (int i = 0; i < 31; ++i) p.in[i] = (const float*)d_in[i];
    p.out = (float*)d_out; p.ws = (unsigned char*)d_ws;
#if ONE_LAUNCH
    p.ph_lo = 0; p.ph_hi = NPHASES; p.coop = 1;
    void* args[] = {&p};
    hipError_t e = hipLaunchCooperativeKernel((const void*)fwd_megakernel, dim3(grid), dim3(NTHREADS), args, LDS_BYTES, stream);
    if (e != hipSuccess) fprintf(stderr, "cooperative launch failed: %s (grid %d)\n", hipGetErrorString(e), grid);
#else
    for (int ph = 0; ph < NPHASES; ++ph) {
        p.ph_lo = ph; p.ph_hi = ph + 1; p.coop = 0;
        hipLaunchKernelGGL(fwd_megakernel, dim3(grid), dim3(NTHREADS), LDS_BYTES, stream, p);
    }
#endif
}
```

```cpp
#include <hip/hip_runtime.h>
#include <hip/hip_cooperative_groups.h>
#include <cstdio>
namespace cg = cooperative_groups;

#ifndef ONE_LAUNCH
#define ONE_LAUNCH 1
#endif

#ifndef PHMASK
#define PHMASK 0xffff
#endif
#define PHK(k) if constexpr (((PHMASK) >> (k)) & 1)
#ifndef LSCALE
#define LSCALE 1.0f
#endif
#ifndef MSCALE
#define MSCALE 1.0f
#endif
#ifndef FSCALE
#define FSCALE 1.0f
#endif
#ifndef OS0
#define OS0 1.0f
#endif
#ifndef OS1
#define OS1 1.0f
#endif
#ifndef OS2
#define OS2 1.0f
#endif
#ifndef OS3
#define OS3 1.0f
#endif
#ifndef OS4
#define OS4 1.0f
#endif
#ifndef OS5
#define OS5 1.0f
#endif
#ifndef ZMASK
#define ZMASK(row, col) false
#endif
#ifndef HSCALE
#define HSCALE 1.0f
#endif
#ifndef BSCALE
#define BSCALE 1.0f
#endif
#ifndef GGVAL
#define GGVAL(x) (x)
#endif
#ifndef GLVAL
#define GLVAL(x) (x)
#endif
#ifndef GLOFF
#define GLOFF 1024
#endif
#ifndef ZSCALE
#define ZSCALE 1.0f
#endif
#define LAS __attribute__((address_space(3)))
typedef unsigned short bf16_t;
typedef short bf16x8 __attribute__((ext_vector_type(8)));
typedef float f32x4 __attribute__((ext_vector_type(4)));
typedef float f32x2 __attribute__((ext_vector_type(2)));
typedef unsigned u32x4 __attribute__((ext_vector_type(4)));
typedef unsigned u32x2 __attribute__((ext_vector_type(2)));

constexpr int D = 1024, MT = 12288, MP = 8192, NKEY = 13312, FF = 2816;
constexpr int INCP = 4864;
constexpr int NTHREADS = 512, LDS_BYTES = 131072;
constexpr float EPS = 1e-6f;
constexpr float LOG2E = 1.4426950408889634f;
constexpr float QSCALE = 0.10206207261596577f * 1.4426950408889634f;

constexpr size_t OFF_CKV = 12582912, OFF_KR = 16777216, OFF_LF = 17301504, OFF_LB = 17367040;

constexpr size_t WS_MODV = 0;
constexpr size_t WS_ROPE = WS_MODV + 2 * 5 * 6144 * 4;
constexpr size_t WS_WIN = WS_ROPE + 2 * 1024 * 16 * 4;
constexpr size_t WS_WFFI = WS_WIN + (size_t)INCP * 1024 * 2;
constexpr size_t WS_WFFO = WS_WFFI + (size_t)5632 * 1024 * 2;
constexpr size_t WS_WOUT = WS_WFFO + (size_t)1024 * 2816 * 2;
constexpr size_t WS_WOLRU = WS_WOUT + (size_t)1024 * 1024 * 2;
constexpr size_t WS_WOMLA = WS_WOLRU + (size_t)1024 * 1024 * 2;
constexpr size_t WS_WQ = WS_WOMLA + (size_t)1024 * 512 * 2;
constexpr size_t WS_WKV = WS_WQ + (size_t)768 * 384 * 2;
constexpr size_t WS_WG = WS_WKV + (size_t)1024 * 256 * 2;
constexpr size_t WS_HBF = WS_WG + (size_t)2 * 8 * 256 * 128 * 2;
constexpr size_t WS_QN = WS_HBF;
constexpr size_t WS_KEYS = WS_QN + (size_t)MT * 384 * 2;
constexpr size_t WS_KRB = WS_KEYS + (size_t)NKEY * 256 * 2;
constexpr size_t WS_AO = WS_HBF;
constexpr size_t WS_PSM = WS_HBF + (size_t)MT * 1024 * 2;
constexpr size_t WS_QB = WS_PSM;
constexpr size_t WS_KN = WS_QB + (size_t)MT * 768 * 2;
constexpr size_t WS_Z = WS_PSM;
constexpr size_t WS_LX = WS_PSM + (size_t)MT * 768 * 4;
constexpr size_t WS_GG = WS_LX + (size_t)MT * 1024 * 4;
constexpr size_t WS_SG = WS_GG + (size_t)MT * 1024 * 2;
constexpr size_t WS_HID = WS_GG;
constexpr size_t WS_VT = WS_SG + (size_t)MT * 2048 * 2;
constexpr size_t WS_HF = WS_VT + (size_t)512 * NKEY * 2;
constexpr size_t WS_END = WS_HF + (size_t)MT * 1024 * 2;

struct Params {
    const float* in[31];
    float* out;
    unsigned char* ws;
    int ph_lo, ph_hi, coop, pad;
};
enum { I_XP = 0, I_XS, I_CCKV, I_CKR, I_SF, I_SB, I_C, I_CCTX, I_WMOD, I_BMOD, I_GPM, I_GQM, I_GPF, I_GQF, I_WIN, I_GQ, I_WQUP, I_GKV,
       I_WKVUP, I_WOMLA, I_CONVW, I_CONVB, I_WRG, I_BRG, I_WIG, I_BIG, I_LAM, I_WOLRU, I_WOUT, I_WFFI, I_WFFO };

__device__ __forceinline__ unsigned char* opq(unsigned char* x) { asm volatile("" : "+s"(x)); return x; }
__device__ __forceinline__ int ozero() { int t = 0; asm volatile("" : "+s"(t)); return t; }
__device__ __forceinline__ int otid() { int t = threadIdx.x; asm volatile("" : "+v"(t)); return t; }
__device__ __forceinline__ int obid() { int t = blockIdx.x; asm volatile("" : "+s"(t)); return t; }
__device__ __forceinline__ int ogrid() { int t = gridDim.x; asm volatile("" : "+s"(t)); return t; }
__device__ __forceinline__ unsigned cvt_pk_bf16(float lo, float hi) { unsigned r; asm volatile("v_cvt_pk_bf16_f32 %0, %1, %2" : "=v"(r) : "v"(lo), "v"(hi)); return r; }
__device__ __forceinline__ float bf2f(bf16_t b) { return __uint_as_float(((unsigned)b) << 16); }
__device__ __forceinline__ bf16_t f2bf(float f) { return (bf16_t)(cvt_pk_bf16(f, 0.f) & 0xffffu); }
__device__ __forceinline__ float wave_sum(float v) {
#pragma unroll
    for (int o = 32; o >= 1; o >>= 1) v += __shfl_xor(v, o);
    return v;
}
__device__ __forceinline__ float fast_sigmoid(float x) { return __builtin_amdgcn_rcpf(1.0f + __builtin_amdgcn_exp2f(-x * LOG2E)); }
__device__ __forceinline__ float gelu_tanh(float x) { const float z = 1.5957691216057308f * (x + 0.044715f * x * x * x); return x * fast_sigmoid(z); }
__device__ __forceinline__ int keyrow_of(int t) { return t < MP ? t : MP + ((t - MP) >> 10) * 1280 + ((t - MP) & 1023); }

namespace pg8 {
constexpr int BM = 256, BK = 64, HALF = 128, HTB = HALF * BK * 2, NXCD = 8, WGM = 8;
__device__ __forceinline__ int lds_byte(int r, int c) { const int st = (r >> 4) * 2 + (c >> 5), rr = r & 15, cc = c & 31, ob = rr * 64 + cc * 2; return st * 1024 + (ob ^ (((ob >> 9) & 1) << 5)); }
__device__ __forceinline__ void stage_rc(int b, int& R, int& C) { const int st = b / 1024, sb = b % 1024, swz = sb ^ (((sb >> 9) & 1) << 5); R = (st >> 1) * 16 + swz / 64; C = (st & 1) * 32 + (swz % 64) / 2; }
__device__ __forceinline__ int perm32(int rho) { const int n = rho >> 4, i = rho & 15; return 8 * (i >> 2) + 4 * n + (i & 3); }
struct Unit { int pm, pn; };
struct Gemm { const bf16_t* A; const bf16_t* Bt; int M, N, K; };
struct StaticOrder {
    int nM, nN, nwg, G, c;
    __device__ void init(int M, int N, int G_, int c_) { nM = M / BM; nN = N / BM; nwg = nM * nN; G = G_; c = c_; }
    __device__ bool next(int i, Unit& u) const {
        const int L = i * G + c; if (L >= nwg) return false;
        int wgid = L; { const int q = nwg / NXCD, r = nwg % NXCD, xcd = wgid % NXCD, off = wgid / NXCD; wgid = (xcd < r ? xcd * (q + 1) : r * (q + 1) + (xcd - r) * q) + off; }
        const int nig = WGM * nN, gid = wgid / nig, fm = gid * WGM, gsz = (nM - fm) < WGM ? (nM - fm) : WGM;
        u.pm = fm + ((wgid % nig) % gsz); u.pn = (wgid % nig) / gsz; return true;
    }
};
template <class Epi>
__device__ __forceinline__ void gemm_phase(LAS unsigned char* lds, const Gemm g, const StaticOrder& S, const Epi& E) {
    int tid_ = threadIdx.x; asm volatile("" : "+v"(tid_));
    const int tid = tid_, wid = __builtin_amdgcn_readfirstlane(tid >> 6), lane = tid & 63, wr = wid >> 2, wc = wid & 3, fr = lane & 15, fq = lane >> 4;
    const int K = g.K, nt = K / BK;
    unsigned voffA[2], voffB[2];
#pragma unroll
    for (int i = 0; i < 2; ++i) { int R, C; stage_rc(tid * 16 + i * 8192, R, C); const int Rb = Epi::PERM ? ((R & ~31) + perm32(R & 31)) : R;
        voffA[i] = (unsigned)(R * K + C) * 2u; voffB[i] = (unsigned)(Rb * K + C) * 2u; }
    const size_t kstep = (size_t)(BK * 2);
    const size_t hstep = (size_t)HALF * K * 2;
    const size_t tstep = 2 * hstep;
    const unsigned ldsw = (unsigned)wid * 1024u;
    const int aoff = lds_byte(wr * 64 + fr, fq * 8), boff = lds_byte(wc * 32 + fr, fq * 8);
#define PG8_SA(b, h) (((b) * 2 + (h)) * HTB)
#define PG8_SB(b, h) ((4 + (b) * 2 + (h)) * HTB)
#define PG8_STAGE(bufoff, gbase, voff) do { _Pragma("unroll") for (int _i = 0; _i < 2; ++_i) \
        __builtin_amdgcn_global_load_lds((const unsigned*)((const char*)(gbase) + (voff)[_i]), (LAS unsigned*)(lds + (bufoff) + ldsw + _i * 8192), 16, 0, 0); } while (0)
#define PG8_LDA(dst, b, h) do { _Pragma("unroll") for (int m = 0; m < 4; ++m) _Pragma("unroll") for (int k = 0; k < 2; ++k) dst[m][k] = *(const LAS bf16x8*)(lds + PG8_SA(b, h) + aoff + m * 2048 + k * 1024); } while (0)
#define PG8_LDB(dst, b, h) do { _Pragma("unroll") for (int n = 0; n < 2; ++n) _Pragma("unroll") for (int k = 0; k < 2; ++k) dst[n][k] = *(const LAS bf16x8*)(lds + PG8_SB(b, h) + boff + n * 2048 + k * 1024); } while (0)
#define PG8_MMA(ai, bj, At, Bt) do { __builtin_amdgcn_s_setprio(1); _Pragma("unroll") for (int m = 0; m < 4; ++m) _Pragma("unroll") for (int n = 0; n < 2; ++n) _Pragma("unroll") for (int k = 0; k < 2; ++k) \
        acc[ai][bj][m][n] = __builtin_amdgcn_mfma_f32_16x16x32_bf16(Bt[n][k], At[m][k], acc[ai][bj][m][n], 0, 0, 0); __builtin_amdgcn_s_setprio(0); } while (0)
#define PG8_WAIT_V(n) asm volatile("s_waitcnt vmcnt(" #n ")" ::: "memory")
#define PG8_WAIT_L(n) asm volatile("s_waitcnt lgkmcnt(" #n ")" ::: "memory")
#define PG8_BAR __builtin_amdgcn_s_barrier()
#define PG8_SCHED __builtin_amdgcn_sched_barrier(0)
    Unit cur, nxt; int ui = 0;
    if (!S.next(0, cur)) return;
    f32x4 acc[2][2][4][2];
#pragma unroll
    for (int a = 0; a < 2; ++a)
#pragma unroll
        for (int b = 0; b < 2; ++b)
#pragma unroll
            for (int m = 0; m < 4; ++m)
#pragma unroll
                for (int n = 0; n < 2; ++n) acc[a][b][m][n] = (f32x4){0.f, 0.f, 0.f, 0.f};
    bf16x8 At[4][2], B0[2][2], B1[2][2];
    const char* cA = (const char*)g.A + (size_t)cur.pm * tstep; const char* cB = (const char*)g.Bt + (size_t)cur.pn * tstep;
    PG8_STAGE(PG8_SB(0, 0), cB, voffB); PG8_STAGE(PG8_SA(0, 0), cA, voffA); PG8_STAGE(PG8_SB(0, 1), cB + hstep, voffB); PG8_STAGE(PG8_SA(0, 1), cA + hstep, voffA);
    if (wr == 1) PG8_BAR;
    PG8_WAIT_V(4); PG8_BAR;
    PG8_STAGE(PG8_SB(1, 0), cB + kstep, voffB); PG8_STAGE(PG8_SA(1, 0), cA + kstep, voffA); PG8_STAGE(PG8_SB(1, 1), cB + hstep + kstep, voffB);
    PG8_WAIT_V(6); PG8_BAR;
    for (;;) {
        const bool has_next = S.next(ui + 1, nxt);
        const char* nA = has_next ? (const char*)g.A + (size_t)nxt.pm * tstep : cA; const char* nB = has_next ? (const char*)g.Bt + (size_t)nxt.pn * tstep : cB;
        for (int t = 0; t < nt; t += 2) {
            const bool last = (t == nt - 2);
            const char* a1 = cA + (size_t)(t + 1) * kstep;
            const char* a2 = last ? nA : cA + (size_t)(t + 2) * kstep; const char* b2 = last ? nB : cB + (size_t)(t + 2) * kstep;
            const char* a3 = a2 + kstep; const char* b3 = b2 + kstep;
            PG8_LDB(B0, 0, 0); PG8_SCHED; PG8_LDA(At, 0, 0); PG8_STAGE(PG8_SA(1, 1), a1 + hstep, voffA);
            PG8_WAIT_L(8); PG8_BAR; PG8_WAIT_L(0); PG8_MMA(0, 0, At, B0); PG8_BAR; PG8_SCHED;
            PG8_LDB(B1, 0, 1); PG8_STAGE(PG8_SB(0, 0), b2, voffB);
            PG8_BAR; PG8_WAIT_L(0); PG8_MMA(0, 1, At, B1); PG8_BAR;
            PG8_LDA(At, 0, 1); PG8_STAGE(PG8_SA(0, 0), a2, voffA);
            PG8_BAR; PG8_WAIT_L(0); PG8_MMA(1, 0, At, B0); PG8_BAR; PG8_SCHED;
            PG8_STAGE(PG8_SB(0, 1), b2 + hstep, voffB);
            PG8_WAIT_V(6); PG8_BAR; PG8_MMA(1, 1, At, B1); PG8_BAR;
            PG8_LDB(B0, 1, 0); PG8_SCHED; PG8_LDA(At, 1, 0); PG8_STAGE(PG8_SA(0, 1), a2 + hstep, voffA);
            PG8_WAIT_L(8); PG8_BAR; PG8_WAIT_L(0); PG8_MMA(0, 0, At, B0); PG8_BAR; PG8_SCHED;
            PG8_LDB(B1, 1, 1); PG8_STAGE(PG8_SB(1, 0), b3, voffB);
            PG8_BAR; PG8_WAIT_L(0); PG8_MMA(0, 1, At, B1); PG8_BAR;
            PG8_LDA(At, 1, 1); PG8_STAGE(PG8_SA(1, 0), a3, voffA);
            PG8_BAR; PG8_WAIT_L(0); PG8_MMA(1, 0, At, B0); PG8_BAR; PG8_SCHED;
            PG8_STAGE(PG8_SB(1, 1), b3 + hstep, voffB);
            PG8_WAIT_V(6); PG8_BAR; PG8_MMA(1, 1, At, B1); PG8_BAR;
        }
        E(acc, cur, wr, wc, fr, fq);
        if (!has_next) break;
#pragma unroll
        for (int a = 0; a < 2; ++a)
#pragma unroll
            for (int b = 0; b < 2; ++b)
#pragma unroll
                for (int m = 0; m < 4; ++m)
#pragma unroll
                    for (int n = 0; n < 2; ++n) acc[a][b][m][n] = (f32x4){0.f, 0.f, 0.f, 0.f};
        cur = nxt; cA = nA; cB = nB; ++ui;
    }
    PG8_WAIT_V(0);
    if (wr == 0) PG8_BAR;
    PG8_BAR;
#undef PG8_SA
#undef PG8_SB
#undef PG8_STAGE
#undef PG8_LDA
#undef PG8_LDB
#undef PG8_MMA
#undef PG8_WAIT_V
#undef PG8_WAIT_L
#undef PG8_BAR
#undef PG8_SCHED
}
}
using pg8::Unit;
typedef f32x4 AccT[2][2][4][2];

__device__ __forceinline__ u32x4 pack8(f32x4 a, f32x4 b) { u32x4 w; w.x = cvt_pk_bf16(a[0], a[1]); w.y = cvt_pk_bf16(a[2], a[3]); w.z = cvt_pk_bf16(b[0], b[1]); w.w = cvt_pk_bf16(b[2], b[3]); return w; }
__device__ __forceinline__ u32x2 pack4(f32x4 a) { u32x2 w; w.x = cvt_pk_bf16(a[0], a[1]); w.y = cvt_pk_bf16(a[2], a[3]); return w; }
__device__ __forceinline__ void unpack8(u32x4 w, f32x4& a, f32x4& b) {
    a[0] = __uint_as_float(w.x << 16); a[1] = __uint_as_float(w.x & 0xffff0000u); a[2] = __uint_as_float(w.y << 16); a[3] = __uint_as_float(w.y & 0xffff0000u);
    b[0] = __uint_as_float(w.z << 16); b[1] = __uint_as_float(w.z & 0xffff0000u); b[2] = __uint_as_float(w.w << 16); b[3] = __uint_as_float(w.w & 0xffff0000u);
}

struct EpiIn {
    static constexpr bool PERM = true;
    float* psm; float* lx; bf16_t* gg; bf16_t* sg; bf16_t* g2;
    __device__ __forceinline__ void operator()(const AccT& acc, const Unit& u, int wr, int wc, int fr, int fq) const {
        const int row0 = u.pm * 256 + wr * 64 + fr, colb = u.pn * 256 + wc * 32 + 8 * fq;
#pragma unroll
        for (int ai = 0; ai < 2; ++ai)
#pragma unroll
            for (int m = 0; m < 4; ++m) {
                const size_t row = (size_t)(row0 + ai * 128 + m * 16);
#pragma unroll
                for (int bj = 0; bj < 2; ++bj) {
                    const int col = colb + bj * 128; f32x4 v0 = acc[ai][bj][m][0], v1 = acc[ai][bj][m][1];
                    if (u.pn < 3) { float* q = psm + row * 768 + col; *(f32x4*)q = v0; *(f32x4*)(q + 4) = v1; }
                    else if (u.pn < 7) { float* q = lx + row * 1024 + (col - 768); *(f32x4*)q = v0; *(f32x4*)(q + 4) = v1; }
                    else if (u.pn < 11) {
#pragma unroll
                        for (int j = 0; j < 4; ++j) { v0[j] = gelu_tanh(v0[j]); v1[j] = gelu_tanh(v1[j]); }
                        *(u32x4*)(gg + row * 1024 + (col - 1792)) = pack8(v0, v1); }
                    else {
#pragma unroll
                        for (int j = 0; j < 4; ++j) { v0[j] = fast_sigmoid(v0[j]); v1[j] = fast_sigmoid(v1[j]); }
                        *(u32x4*)(sg + row * 2048 + (col - 2816)) = pack8(v0, v1);
                        if (u.pn >= 15) *(u32x4*)(g2 + row * 1024 + (col - 3840)) = pack8(v0, v1); }
                }
            }
    }
};
struct EpiQ {
    static constexpr bool PERM = false;
    bf16_t* q; const float* ropec; const float* ropes;
    __device__ __forceinline__ void operator()(const AccT& acc, const Unit& u, int wr, int wc, int fr, int fq) const {
        const int row0 = u.pm * 256 + wr * 64 + fr;
#pragma unroll
        for (int ai = 0; ai < 2; ++ai)
#pragma unroll
            for (int m = 0; m < 4; ++m) {
                const int row = row0 + ai * 128 + m * 16; const bool lat = row >= MP; const int pos = (row - MP) & 1023;
#pragma unroll
                for (int bj = 0; bj < 2; ++bj) {
                    const int base = u.pn * 256 + bj * 128 + wc * 32; const bool rope = lat && (((base >> 5) % 3) == 2);
                    f32x4 v0 = acc[ai][bj][m][0], v1 = acc[ai][bj][m][1];
                    if (rope) { const f32x4 cs = *(const f32x4*)(ropec + pos * 16 + 4 * fq), sn = *(const f32x4*)(ropes + pos * 16 + 4 * fq);
                        const f32x4 o0 = v0 * cs - v1 * sn, o1 = v0 * sn + v1 * cs; v0 = o0; v1 = o1; }
                    v0 *= QSCALE; v1 *= QSCALE;
                    bf16_t* dst = q + (size_t)row * 768 + base + 4 * fq;
                    *(u32x2*)dst = pack4(v0); *(u32x2*)(dst + 16) = pack4(v1);
                }
                asm volatile("" ::: "memory");
            }
    }
};
struct EpiBf16 {
    static constexpr bool PERM = true;
    bf16_t* o; int ldc;
    __device__ __forceinline__ void operator()(const AccT& acc, const Unit& u, int wr, int wc, int fr, int fq) const {
        const int row0 = u.pm * 256 + wr * 64 + fr, colb = u.pn * 256 + wc * 32 + 8 * fq;
#pragma unroll
        for (int ai = 0; ai < 2; ++ai)
#pragma unroll
            for (int m = 0; m < 4; ++m) {
                const size_t row = (size_t)(row0 + ai * 128 + m * 16);
#pragma unroll
                for (int bj = 0; bj < 2; ++bj) *(u32x4*)(o + row * ldc + colb + bj * 128) = pack8(acc[ai][bj][m][0], acc[ai][bj][m][1]);
            }
    }
};
struct EpiF32 {
    static constexpr bool PERM = true;
    float* o; int ldc;
    __device__ __forceinline__ void operator()(const AccT& acc, const Unit& u, int wr, int wc, int fr, int fq) const {
        const int row0 = u.pm * 256 + wr * 64 + fr, colb = u.pn * 256 + wc * 32 + 8 * fq;
#pragma unroll
        for (int ai = 0; ai < 2; ++ai)
#pragma unroll
            for (int m = 0; m < 4; ++m) {
                const size_t row = (size_t)(row0 + ai * 128 + m * 16);
#pragma unroll
                for (int bj = 0; bj < 2; ++bj) { float* q = o + row * ldc + colb + bj * 128; *(f32x4*)q = acc[ai][bj][m][0]; *(f32x4*)(q + 4) = acc[ai][bj][m][1]; }
            }
    }
};
struct EpiMla {
    static constexpr bool PERM = true;
    float* z1; const bf16_t* sg;
    __device__ __forceinline__ void operator()(const AccT& acc, const Unit& u, int wr, int wc, int fr, int fq) const {
        const int row0 = u.pm * 256 + wr * 64 + fr, colb = u.pn * 256 + wc * 32 + 8 * fq;
#pragma unroll
        for (int ai = 0; ai < 2; ++ai)
#pragma unroll
            for (int m = 0; m < 4; ++m) {
                const size_t row = (size_t)(row0 + ai * 128 + m * 16);
#pragma unroll
                for (int bj = 0; bj < 2; ++bj) { const int col = colb + bj * 128; f32x4 g0, g1; unpack8(*(const u32x4*)(sg + row * 2048 + col), g0, g1);
                    float* q = z1 + row * 1024 + col; *(f32x4*)q = acc[ai][bj][m][0] * g0 * ZSCALE; *(f32x4*)(q + 4) = acc[ai][bj][m][1] * g1 * ZSCALE; }
                asm volatile("" ::: "memory");
            }
    }
};
struct EpiLru {
    static constexpr bool PERM = true;
    const float* z1; const bf16_t* sg; bf16_t* z; const bf16_t* g2;
    __device__ __forceinline__ void operator()(const AccT& acc, const Unit& u, int wr, int wc, int fr, int fq) const {
        const int row0 = u.pm * 256 + wr * 64 + fr, colb = u.pn * 256 + wc * 32 + 8 * fq;
#pragma unroll
        for (int ai = 0; ai < 2; ++ai)
#pragma unroll
            for (int m = 0; m < 4; ++m) {
                const size_t row = (size_t)(row0 + ai * 128 + m * 16);
#pragma unroll
                for (int bj = 0; bj < 2; ++bj) { const int col = colb + bj * 128; f32x4 g0, g1; unpack8(*(const u32x4*)(g2 + row * 1024 + col), g0, g1);
                    const float* q = z1 + row * 1024 + col; const f32x4 a0 = *(const f32x4*)q + acc[ai][bj][m][0] * GLVAL(g0) * LSCALE, a1 = *(const f32x4*)(q + 4) + acc[ai][bj][m][1] * GLVAL(g1) * LSCALE;
                    *(u32x4*)(z + row * 1024 + col) = pack8(a0, a1); }
                asm volatile("" ::: "memory");
            }
    }
};
struct EpiFfi {
    static constexpr bool PERM = false;
    bf16_t* hid;
    __device__ __forceinline__ void operator()(const AccT& acc, const Unit& u, int wr, int wc, int fr, int fq) const {
        const int row0 = u.pm * 256 + wr * 64 + fr;
#pragma unroll
        for (int ai = 0; ai < 2; ++ai)
#pragma unroll
            for (int m = 0; m < 4; ++m) {
                const size_t row = (size_t)(row0 + ai * 128 + m * 16);
#pragma unroll
                for (int bj = 0; bj < 2; ++bj) { const int hc = ((u.pn * 256 + bj * 128 + wc * 32) >> 1) + 4 * fq; const f32x4 gv = acc[ai][bj][m][0], uv = acc[ai][bj][m][1]; f32x4 h;
#pragma unroll
                    for (int j = 0; j < 4; ++j) h[j] = gv[j] * fast_sigmoid(gv[j]) * uv[j];
                    *(u32x2*)(hid + row * FF + hc) = pack4(h); }
            }
    }
};

__device__ __forceinline__ int map_row(int mode, int n) {
    if (mode == 1) return n < 672 ? n : n + 96;
    if (mode == 2) { const int up = n >= FF, j = up ? n - FF : n; return (j >> 4) * 32 + (j & 15) + (up ? 16 : 0); }
    if (mode == 3) { const int h = n >> 7, r = n & 127; return r < 64 ? h * 64 + r : 512 + h * 64 + (r - 64); }
    return n;
}
__device__ __forceinline__ void conv_tile(const float* src, int ld, int K, int k0, int n0, bf16_t* dst, int mode, LAS float* tile) {
    const int tid = otid();
    __syncthreads();
#pragma unroll
    for (int i = 0; i < 2; ++i) { const int kk = (tid >> 3) + 64 * i, c4 = (tid & 7) * 4; const f32x4 v = *(const f32x4*)(src + (size_t)(k0 + kk) * ld + n0 + c4);
        tile[kk * 33 + c4] = v[0]; tile[kk * 33 + c4 + 1] = v[1]; tile[kk * 33 + c4 + 2] = v[2]; tile[kk * 33 + c4 + 3] = v[3]; }
    __syncthreads();
    const int n = tid >> 4, k8 = (tid & 15) * 8; f32x4 a, b;
#pragma unroll
    for (int j = 0; j < 4; ++j) { a[j] = tile[(k8 + j) * 33 + n]; b[j] = tile[(k8 + 4 + j) * 33 + n]; }
    *(u32x4*)(dst + (size_t)map_row(mode, n0 + n) * K + k0 + k8) = pack8(a, b);
}
constexpr int CONV_ITEMS = 4208;
__device__ __forceinline__ void conv_item(const Params& p, unsigned char* ws, int l, int idx, LAS float* tile) {
    const int zz = ozero();
    int inidx, K, N, mode = 0; size_t soff, doff;
    if (idx < 1192) { inidx = I_WIN; soff = (size_t)l * 1024 * 4768; doff = WS_WIN; K = 1024; N = 4768; mode = 1; }
    else if ((idx -= 1192) < 1408) { inidx = I_WFFI; soff = (size_t)l * 1024 * 5632; doff = WS_WFFI; K = 1024; N = 5632; mode = 2; }
    else if ((idx -= 1408) < 704) { inidx = I_WFFO; soff = (size_t)l * 2816 * 1024; doff = WS_WFFO; K = 2816; N = 1024; }
    else if ((idx -= 704) < 256) { inidx = I_WOUT; soff = (size_t)l * 1024 * 1024; doff = WS_WOUT; K = 1024; N = 1024; }
    else if ((idx -= 256) < 256) { inidx = I_WOLRU; soff = (size_t)l * 1024 * 1024; doff = WS_WOLRU; K = 1024; N = 1024; }
    else if ((idx -= 256) < 128) { inidx = I_WOMLA; soff = (size_t)l * 512 * 1024; doff = WS_WOMLA; K = 512; N = 1024; }
    else if ((idx -= 128) < 72) { inidx = I_WQUP; soff = (size_t)l * 384 * 768; doff = WS_WQ; K = 384; N = 768; }
    else if ((idx -= 72) < 64) { inidx = I_WKVUP; soff = (size_t)l * 256 * 1024; doff = WS_WKV; K = 256; N = 1024; mode = 3; }
    else { idx -= 64; const int mat = idx >> 2, ig = mat >> 4, dir = (mat >> 3) & 1, n = mat & 7;
        inidx = ig ? I_WIG : I_WRG; soff = (size_t)((l * 2 + dir) * 8 + n) * 16384; doff = WS_WG + (size_t)((dir * 8 + n) * 256 + ig * 128) * 128 * 2; K = 128; N = 128; idx &= 3; }
    const float* src = p.in[zz + inidx] + soff; bf16_t* dst = (bf16_t*)(ws + doff);
    const int nk = K / 128, kt = idx % nk, ntile = idx / nk;
    conv_tile(src, N, K, kt * 128, ntile * 32, dst, mode, tile);
}
__device__ __forceinline__ void modv_phase(const Params& p, unsigned char* ws, LAS float* lds) {
    const int zz = ozero();
    LAS float* sc = lds + 128 * 33;
    LAS float* red = sc + 5 * 1024;
    const int tid = otid();
    __syncthreads();
    for (int i = tid; i < 5 * 1024; i += NTHREADS) { const float c = i < 1024 ? p.in[zz + I_CCTX][i] : p.in[zz + I_C][i - 1024]; sc[i] = c / (1.0f + __expf(-c)); }
    __syncthreads();
    float* modv = (float*)(ws + WS_MODV); const int bid = obid(), G = ogrid();
    const int col = tid & 31, kg = tid >> 5;
    for (int it = bid; it < 384; it += G) {
        const int l = it / 192, j0 = (it % 192) * 32;
        const float* w = p.in[zz + I_WMOD] + (size_t)l * 1024 * 6144 + j0 + col;
        float a0 = 0.f, a1 = 0.f, a2 = 0.f, a3 = 0.f, a4 = 0.f;
#pragma unroll 8
        for (int k = kg * 64; k < kg * 64 + 64; ++k) { const float wv = w[(size_t)k * 6144]; a0 += sc[k] * wv; a1 += sc[1024 + k] * wv; a2 += sc[2048 + k] * wv; a3 += sc[3072 + k] * wv; a4 += sc[4096 + k] * wv; }
        red[(kg * 5 + 0) * 32 + col] = a0; red[(kg * 5 + 1) * 32 + col] = a1; red[(kg * 5 + 2) * 32 + col] = a2; red[(kg * 5 + 3) * 32 + col] = a3; red[(kg * 5 + 4) * 32 + col] = a4;
        __syncthreads();
        if (tid < 160) { const int v = tid >> 5, c = tid & 31; float s = p.in[zz + I_BMOD][l * 6144 + j0 + c];
#pragma unroll
            for (int g = 0; g < 16; ++g) s += red[(g * 5 + v) * 32 + c];
            modv[(size_t)(l * 5 + v) * 6144 + j0 + c] = s; }
        __syncthreads();
    }
}
__device__ __forceinline__ void rope_table(const Params& p, unsigned char* ws) {
    const int zz = ozero();
    float* rc = (float*)(ws + WS_ROPE); float* rs = rc + 1024 * 16;
    const int G = ogrid(); for (int i = obid() * NTHREADS + otid(); i < 1024 * 16; i += G * NTHREADS) {
        const int pos = i >> 4, f = i & 15; const float posv = (float)(f < 8 ? (pos >> 6) : (pos & 63));
        const float inv = exp2f(-(float)(f & 7) * (13.287712379549449f / 8.0f));
        const float rev = posv * inv * 0.15915494309189535f;
        rc[i] = __builtin_amdgcn_cosf(rev); rs[i] = __builtin_amdgcn_sinf(rev);
    }
}

template <bool HAS_Y, bool DO_H>
__device__ __forceinline__ void norm_phase(const Params& p, unsigned char* ws, const float* xp, const float* xs, const float* Y, const float* gA, int gate_off, const float* modA,
                                           const float* gB, int sh_off, int sc_off, const float* modB) {
    const int zz = ozero();
    const int tid = otid(), wid = tid >> 6, lane = tid & 63; const int bid = obid(), G = ogrid();
    bf16_t* hbf = (bf16_t*)(ws + WS_HBF);
    for (int row = bid * 8 + wid; row < MT; row += G * 8) {
        const int mv = row < MP ? 0 : 1 + ((row - MP) >> 10);
        const float* xin = row < MP ? xp + (size_t)row * D : xs + (size_t)(row - MP) * D;
        f32x4 x[4];
#pragma unroll
        for (int i = 0; i < 4; ++i) x[i] = *(const f32x4*)(xin + i * 256 + lane * 4);
        if (HAS_Y) {
            f32x4 y[4]; float ss = 0.f;
#pragma unroll
            for (int i = 0; i < 4; ++i) { y[i] = *(const f32x4*)(Y + (size_t)row * D + i * 256 + lane * 4); ss += y[i][0] * y[i][0] + y[i][1] * y[i][1] + y[i][2] * y[i][2] + y[i][3] * y[i][3]; }
            ss = wave_sum(ss); const float rstd = rsqrtf(ss * (1.0f / D) + EPS);
            const float* mg = modA + (size_t)mv * 6144 + gate_off;
#pragma unroll
            for (int i = 0; i < 4; ++i) { const f32x4 g = *(const f32x4*)(gA + i * 256 + lane * 4), gt = *(const f32x4*)(mg + i * 256 + lane * 4);
                x[i] = x[i] + gt * (y[i] * rstd * g) * (gate_off == 2048 ? MSCALE : FSCALE); *(f32x4*)((p.out + zz) + (size_t)row * D + i * 256 + lane * 4) = DO_H ? x[i] : x[i] * (row < MP ? (ZMASK(row, i * 256 + lane * 4) ? 0.0f : OS0) : OS1); }
        }
        if (DO_H) {
            float ss = 0.f;
#pragma unroll
            for (int i = 0; i < 4; ++i) ss += x[i][0] * x[i][0] + x[i][1] * x[i][1] + x[i][2] * x[i][2] + x[i][3] * x[i][3];
            ss = wave_sum(ss); const float rstd = rsqrtf(ss * (1.0f / D) + EPS);
            const float* msh = modB + (size_t)mv * 6144 + sh_off; const float* msc = modB + (size_t)mv * 6144 + sc_off;
#pragma unroll
            for (int i = 0; i < 4; ++i) { const f32x4 g = *(const f32x4*)(gB + i * 256 + lane * 4), sh = *(const f32x4*)(msh + i * 256 + lane * 4), sc = *(const f32x4*)(msc + i * 256 + lane * 4);
                const f32x4 h = (x[i] * rstd * g) * (sc + 1.0f) + sh; *(u32x2*)(hbf + (size_t)row * D + i * 256 + lane * 4) = pack4(h); }
        }
    }
}

__device__ __forceinline__ void postproj_phase(const Params& p, unsigned char* ws, int l) {
    const int zz = ozero();
    const int tid = otid(), wid = tid >> 6, lane = tid & 63; const int bid = obid(), G = ogrid();
    const float* psm = (const float*)(ws + WS_PSM);
    bf16_t* qn = (bf16_t*)(ws + WS_QN); bf16_t* keys = (bf16_t*)(ws + WS_KEYS); bf16_t* krb = (bf16_t*)(ws + WS_KRB);
    const float* ropec = (const float*)(ws + WS_ROPE); const float* ropes = ropec + 1024 * 16;
    const float* gq = p.in[zz + I_GQ] + l * 384; const float* gkv = p.in[zz + I_GKV] + l * 256;
    for (int t = bid * 8 + wid; t < NKEY; t += G * 8) {
        if (t < MT) {
            const float* pr = psm + (size_t)t * 768;
            f32x2 q[3]; float ss = 0.f;
#pragma unroll
            for (int i = 0; i < 3; ++i) { q[i] = *(const f32x2*)(pr + i * 128 + lane * 2); ss += q[i][0] * q[i][0] + q[i][1] * q[i][1]; }
            ss = wave_sum(ss); float rstd = rsqrtf(ss * (1.0f / 384.0f) + EPS);
#pragma unroll
            for (int i = 0; i < 3; ++i) { const f32x2 g = *(const f32x2*)(gq + i * 128 + lane * 2); *(unsigned*)(qn + (size_t)t * 384 + i * 128 + lane * 2) = cvt_pk_bf16(q[i][0] * rstd * g[0], q[i][1] * rstd * g[1]); }
            f32x4 kv = *(const f32x4*)(pr + 384 + lane * 4);
            ss = wave_sum(kv[0] * kv[0] + kv[1] * kv[1] + kv[2] * kv[2] + kv[3] * kv[3]); rstd = rsqrtf(ss * (1.0f / 256.0f) + EPS);
            const f32x4 ckv = kv * rstd * *(const f32x4*)(gkv + lane * 4);
            const int kr = keyrow_of(t);
            *(u32x2*)(keys + (size_t)kr * 256 + lane * 4) = pack4(ckv);
            const int s = t >> 8, pp = t & 255;
            if (t < MP) *(f32x4*)((p.out + zz) + OFF_CKV + ((size_t)(s * 2 + l) * 256 + pp) * 256 + lane * 4) = ckv * OS2;
            if (lane < 16) {
                float x1 = pr[640 + lane], x2 = pr[656 + lane];
                if (t >= MP) { const int pos = (t - MP) & 1023; const float cs = ropec[pos * 16 + lane], sn = ropes[pos * 16 + lane]; const float o1 = x1 * cs - x2 * sn, o2 = x1 * sn + x2 * cs; x1 = o1; x2 = o2; }
                krb[(size_t)kr * 32 + lane] = f2bf(x1); krb[(size_t)kr * 32 + 16 + lane] = f2bf(x2);
                if (t < MP) { float* o = (p.out + zz) + OFF_KR + ((size_t)(s * 2 + l) * 256 + pp) * 32; o[lane] = x1 * OS3; o[16 + lane] = x2 * OS3; }
            }
        } else {
            const int j = t - MT, b = j >> 8, jj = j & 255, kr = MP + b * 1280 + 1024 + jj;
            const f32x4 v = *(const f32x4*)(p.in[zz + I_CCKV] + ((size_t)(b * 2 + l) * 256 + jj) * 256 + lane * 4);
            *(u32x2*)(keys + (size_t)kr * 256 + lane * 4) = pack4(v);
            if (lane < 8) { const f32x4 w = *(const f32x4*)(p.in[zz + I_CKR] + ((size_t)(b * 2 + l) * 256 + jj) * 32 + lane * 4); *(u32x2*)(krb + (size_t)kr * 32 + lane * 4) = pack4(w); }
        }
    }
}

__device__ __forceinline__ void attn_phase(const Params& p, unsigned char* ws, LAS unsigned char* lds) {
    const int zz = ozero();
    const bf16_t* Qb = (const bf16_t*)(ws + WS_QB); const bf16_t* Kn = (const bf16_t*)(ws + WS_KN); const bf16_t* KR = (const bf16_t*)(ws + WS_KRB);
    const bf16_t* Vt = (const bf16_t*)(ws + WS_VT); bf16_t* AO = (bf16_t*)(ws + WS_AO);
    LAS bf16_t* Ks = (LAS bf16_t*)lds;
    LAS bf16_t* Vs = (LAS bf16_t*)(lds + 64 * 208);
    const int tid = otid(), wid = tid >> 6, lane = tid & 63, l15 = lane & 15, quad = lane >> 4; const int bid = obid(), G = ogrid();
    for (int it = bid; it < 768; it += G) {
        int tq, kb, nk, h;
        if (it < 256) { const int b = it >> 6; h = (it >> 3) & 7; tq = MP + b * 1024 + (it & 7) * 128; kb = MP + b * 1280; nk = 1280; }
        else { const int j = it - 256, s = j >> 4; h = (j >> 1) & 7; tq = s * 256 + (j & 1) * 128; kb = s * 256; nk = 256; }
        const int qrow = tq + wid * 16 + l15;
        bf16x8 qf[3];
#pragma unroll
        for (int ks = 0; ks < 3; ++ks) qf[ks] = *(const bf16x8*)(Qb + (size_t)qrow * 768 + h * 96 + ks * 32 + quad * 8);
        f32x4 o[4];
#pragma unroll
        for (int i = 0; i < 4; ++i) o[i] = (f32x4){0.f, 0.f, 0.f, 0.f};
        float mrun = -1e30f, lsum = 0.f;
        for (int k0 = 0; k0 < nk; k0 += 64) {
            __syncthreads();
            for (int c = tid; c < 768; c += NTHREADS) { const int r = c / 12, cc = c % 12;
                const bf16_t* src = cc < 8 ? Kn + (size_t)(kb + k0 + r) * 512 + h * 64 + cc * 8 : KR + (size_t)(kb + k0 + r) * 32 + (cc - 8) * 8;
                *(LAS u32x4*)(Ks + r * 104 + cc * 8) = *(const u32x4*)src; }
            { const int r = tid >> 3, cc = tid & 7; *(LAS u32x4*)(Vs + r * 72 + cc * 8) = *(const u32x4*)(Vt + (size_t)(h * 64 + r) * NKEY + kb + k0 + cc * 8); }
            __syncthreads();
            f32x4 s[4];
#pragma unroll
            for (int js = 0; js < 4; ++js) { s[js] = (f32x4){0.f, 0.f, 0.f, 0.f};
#pragma unroll
                for (int ks = 0; ks < 3; ++ks) { const bf16x8 a = *(const LAS bf16x8*)(Ks + (js * 16 + l15) * 104 + ks * 32 + quad * 8); s[js] = __builtin_amdgcn_mfma_f32_16x16x32_bf16(a, qf[ks], s[js], 0, 0, 0); } }
            float mx = s[0][0];
#pragma unroll
            for (int js = 0; js < 4; ++js)
#pragma unroll
                for (int j = 0; j < 4; ++j) mx = fmaxf(mx, s[js][j]);
            mx = fmaxf(mx, __shfl_xor(mx, 16)); mx = fmaxf(mx, __shfl_xor(mx, 32));
            const float mnew = fmaxf(mrun, mx), alpha = __builtin_amdgcn_exp2f(mrun - mnew); mrun = mnew;
            float psum = 0.f;
#pragma unroll
            for (int js = 0; js < 4; ++js)
#pragma unroll
                for (int j = 0; j < 4; ++j) { s[js][j] = __builtin_amdgcn_exp2f(s[js][j] - mnew); psum += s[js][j]; }
            lsum = lsum * alpha + psum;
#pragma unroll
            for (int i = 0; i < 4; ++i) o[i] *= alpha;
#pragma unroll
            for (int kk = 0; kk < 2; ++kk) {
                const u32x4 pw = pack8(s[2 * kk], s[2 * kk + 1]); bf16x8 pf; __builtin_memcpy(&pf, &pw, 16);
#pragma unroll
                for (int dv = 0; dv < 4; ++dv) {
                    const LAS bf16_t* vp = Vs + (dv * 16 + l15) * 72 + kk * 32 + quad * 4;
                    u32x4 vw; const u32x2 v0 = *(const LAS u32x2*)vp, v1 = *(const LAS u32x2*)(vp + 16); vw.x = v0.x; vw.y = v0.y; vw.z = v1.x; vw.w = v1.y;
                    bf16x8 va; __builtin_memcpy(&va, &vw, 16);
                    o[dv] = __builtin_amdgcn_mfma_f32_16x16x32_bf16(va, pf, o[dv], 0, 0, 0);
                }
            }
        }
        lsum += __shfl_xor(lsum, 16); lsum += __shfl_xor(lsum, 32);
        const float inv = 1.0f / lsum;
#pragma unroll
        for (int dv = 0; dv < 4; ++dv) *(u32x2*)(AO + (size_t)qrow * 512 + h * 64 + dv * 16 + quad * 4) = pack4(o[dv] * inv);
    }
}

template <int DIR>
__device__ __forceinline__ void scan_pass(const Params& p, unsigned char* ws, int l, int n, int tok0, int L, float h0, bool write_state, int state_idx, LAS unsigned char* lds) {
    const int zz = ozero();
    LAS float* xcf = (LAS float*)lds;
    LAS bf16_t* xcb = (LAS bf16_t*)(lds + 64 * 132 * 4);
    const int tid = otid(), wid = tid >> 6, lane = tid & 63, l15 = lane & 15, quad = lane >> 4;
    const int chl = wid * 16 + l15, ch = n * 128 + chl;
    const float* LXp = (const float*)(ws + WS_LX); bf16_t* HF = (bf16_t*)(ws + WS_PSM); bf16_t* GG = (bf16_t*)(ws + WS_GG);
    const float lam = p.in[zz + I_LAM][(l * 2 + DIR) * 1024 + ch];
    const float nl = -lam, sp = fmaxf(nl, 0.f) + log1pf(__expf(-fabsf(nl)));
    const float cc = -8.0f * sp * LOG2E;
    const float br = p.in[zz + I_BRG][(l * 2 + DIR) * 1024 + ch], bi = p.in[zz + I_BIG][(l * 2 + DIR) * 1024 + ch];
    const bf16_t* wg = (const bf16_t*)(ws + WS_WG) + (size_t)((DIR * 8 + n) * 256) * 128;
    bf16x8 wrf[4], wif[4];
#pragma unroll
    for (int ks = 0; ks < 4; ++ks) { wrf[ks] = *(const bf16x8*)(wg + (size_t)chl * 128 + ks * 32 + quad * 8); wif[ks] = *(const bf16x8*)(wg + (size_t)(128 + chl) * 128 + ks * 32 + quad * 8); }
    const int c4 = (tid & 31) * 4, tg = tid >> 5;
    const float* cw = p.in[zz + I_CONVW] + (size_t)l * 4 * 1024 + n * 128 + c4;
    const f32x4 w0 = *(const f32x4*)cw, w1 = *(const f32x4*)(cw + 1024), w2 = *(const f32x4*)(cw + 2048), w3 = *(const f32x4*)(cw + 3072);
    const f32x4 cb = *(const f32x4*)(p.in[zz + I_CONVB] + l * 1024 + n * 128 + c4);
    float hin = h0;
    const int nchunk = L >> 6;
    for (int ci = 0; ci < nchunk; ++ci) {
        const int t0 = (DIR ? nchunk - 1 - ci : ci) * 64;
        __syncthreads();
        {
            f32x4 xr[7];
#pragma unroll
            for (int r = 0; r < 7; ++r) { const int tt = t0 + tg * 4 - 2 + r; xr[r] = (tt >= 0 && tt < L) ? *(const f32x4*)(LXp + (size_t)(tok0 + tt) * 1024 + n * 128 + c4) : (f32x4){0.f, 0.f, 0.f, 0.f}; }
#pragma unroll
            for (int j = 0; j < 4; ++j) { const f32x4 xc = cb + xr[j] * w0 + xr[j + 1] * w1 + xr[j + 2] * w2 + xr[j + 3] * w3;
                *(LAS f32x4*)(xcf + (tg * 4 + j) * 132 + c4) = xc; *(LAS u32x2*)(xcb + (tg * 4 + j) * 136 + c4) = pack4(xc); }
        }
        __syncthreads();
        f32x4 rg[4], ig[4];
#pragma unroll
        for (int st = 0; st < 4; ++st) { rg[st] = (f32x4){0.f, 0.f, 0.f, 0.f}; ig[st] = (f32x4){0.f, 0.f, 0.f, 0.f};
#pragma unroll
            for (int ks = 0; ks < 4; ++ks) { const bf16x8 a = *(const LAS bf16x8*)(xcb + (st * 16 + l15) * 136 + ks * 32 + quad * 8);
                rg[st] = __builtin_amdgcn_mfma_f32_16x16x32_bf16(a, wrf[ks], rg[st], 0, 0, 0); ig[st] = __builtin_amdgcn_mfma_f32_16x16x32_bf16(a, wif[ks], ig[st], 0, 0, 0); } }
#pragma unroll
        for (int sti = 0; sti < 4; ++sti) {
            const int st = DIR ? 3 - sti : sti;
            float av[4], hv[4], pa[4];
#pragma unroll
            for (int j = 0; j < 4; ++j) { const float x = xcf[(st * 16 + quad * 4 + j) * 132 + chl];
                const float rr = fast_sigmoid(rg[st][j] + br), ii = fast_sigmoid(ig[st][j] + bi);
                const float a = __builtin_amdgcn_exp2f(cc * rr); av[j] = a; hv[j] = __builtin_amdgcn_sqrtf(fmaxf(1.0f - a * a, 0.f)) * ii * x; }
            float hl = 0.f, pr = 1.f;
#pragma unroll
            for (int s4 = 0; s4 < 4; ++s4) { const int j = DIR ? 3 - s4 : s4; hl = av[j] * hl + hv[j]; pr *= av[j]; hv[j] = hl; pa[j] = pr; }
            float Ar = 1.f, Hr = 0.f, Aex = 1.f, Hex = 0.f;
#pragma unroll
            for (int s4 = 0; s4 < 4; ++s4) { const int qq = DIR ? 3 - s4 : s4; const float Aq = __shfl(pr, qq * 16 + l15), Hq = __shfl(hl, qq * 16 + l15);
                if (qq == quad) { Aex = Ar; Hex = Hr; }
                Hr = Aq * Hr + Hq; Ar *= Aq; }
            const float cq = Aex * hin + Hex;
            hin = Ar * hin + Hr;
#pragma unroll
            for (int j = 0; j < 4; ++j) { const float hfin = hv[j] + pa[j] * cq; const size_t idx = (size_t)(tok0 + t0 + st * 16 + quad * 4 + j) * 1024 + ch;
                if (DIR == 0) HF[idx] = f2bf(hfin);
                else GG[idx] = f2bf((bf2f(HF[idx]) * HSCALE + hfin * BSCALE) * GGVAL(bf2f(GG[idx]))); }
        }
    }
    if (write_state && quad == 0) (p.out + zz)[(DIR ? OFF_LB : OFF_LF) + state_idx + ch] = hin * (DIR ? OS5 : OS4);
}
__device__ __forceinline__ void scan_phase(const Params& p, unsigned char* ws, int l, LAS unsigned char* lds) {
    const int zz = ozero();
    const int tid = otid(), l15 = tid & 15, wid = tid >> 6; const int bid = obid(), G = ogrid();
    for (int rr = 0; rr < 2; ++rr) {
        const int it = rr == 0 ? bid : ((G == 256 && bid >= 32 && bid < 64) ? 224 + bid : (G == 256 ? 288 : bid + G));
        if (it >= 288) break;
        int n, tok0, L, sidx; bool lat; float hf0 = 0.f, hb0 = 0.f;
        if (it < 32) { const int b = it >> 3; n = it & 7; tok0 = MP + b * 1024; L = 1024; lat = true; sidx = 0; const int ch = n * 128 + wid * 16 + l15;
            hf0 = p.in[zz + I_SF][(b * 2 + l) * 1024 + ch]; hb0 = p.in[zz + I_SB][(b * 2 + l) * 1024 + ch]; }
        else { const int j = it - 32, s = j >> 3; n = j & 7; tok0 = s * 256; L = 256; lat = false; sidx = (s * 2 + l) * 1024; }
        scan_pass<0>(p, ws, l, n, tok0, L, hf0, !lat, sidx, lds);
        scan_pass<1>(p, ws, l, n, tok0, L, hb0, !lat, sidx, lds);
    }
}

__device__ __forceinline__ unsigned char* opq_unused(unsigned char* x) { asm volatile("" : "+s"(x)); return x; }
__device__ __forceinline__ void grid_sync_all() {
    asm volatile("s_waitcnt vmcnt(0) lgkmcnt(0)" ::: "memory");
    __syncthreads();
    if (threadIdx.x < 64) { __builtin_amdgcn_fence(__ATOMIC_RELEASE, "agent"); asm volatile("s_waitcnt vmcnt(0) lgkmcnt(0)" ::: "memory"); }
    cg::this_grid().sync();
    if (threadIdx.x < 64) { __builtin_amdgcn_fence(__ATOMIC_ACQUIRE, "agent"); asm volatile("s_waitcnt vmcnt(0) lgkmcnt(0)" ::: "memory"); }
    __syncthreads();
}
__global__ void __launch_bounds__(NTHREADS) fwd_megakernel(Params p) {
    extern __shared__ __attribute__((aligned(16))) unsigned char smem[];
    LAS unsigned char* lds = (LAS unsigned char*)smem;
    int ph = 0; (void)ph; int phc = 0; (void)phc;
#if defined(STOP_AFTER)
#define PHASE_IF if (phc <= STOP_AFTER)
#define PHASE_END do { ++phc; grid_sync_all(); } while (0)
#elif ONE_LAUNCH
#define PHASE_IF
#define PHASE_END do { grid_sync_all(); } while (0)
#else
#define PHASE_IF if (__builtin_amdgcn_readfirstlane((int)(ph >= p.ph_lo && ph < p.ph_hi)))
#define PHASE_END do { ++ph; } while (0)
#endif

    PHASE_IF PHK(0) { const int zz = ozero(); unsigned char* ws = p.ws + zz; const int G = ogrid(), bid = obid(); (void)G; (void)bid; const float* modv = (const float*)(ws + WS_MODV); const float* modl = modv; (void)modl;
        rope_table(p, ws);
        modv_phase(p, ws, (LAS float*)lds);
        for (int i = bid; i < CONV_ITEMS; i += G) conv_item(p, ws, 0, i, (LAS float*)lds);
    }
    PHASE_END;
    PHASE_IF PHK(1) { const int zz = ozero(); unsigned char* ws = p.ws + zz; const int G = ogrid(), bid = obid(); (void)G; (void)bid; const float* modv = (const float*)(ws + WS_MODV); const float* modl = modv; (void)modl; norm_phase<false, true>(p, ws, p.in[zz + I_XP], p.in[zz + I_XS], nullptr, nullptr, 0, nullptr, p.in[zz + I_GPM], 0, 1024, modv); }
    PHASE_END;
#pragma unroll 1
    for (int l = 0; l < 2; ++l) {
        PHASE_IF PHK(2) { const int zz = ozero(); unsigned char* ws = p.ws + zz; const int G = ogrid(), bid = obid(); (void)G; (void)bid; const float* modv = (const float*)(ws + WS_MODV); const float* modl = modv + (size_t)l * 5 * 6144; (void)modl; pg8::Gemm g{(const bf16_t*)(ws + WS_HBF), (const bf16_t*)(ws + WS_WIN), MT, INCP, 1024}; pg8::StaticOrder S; S.init(MT, INCP, G, bid);
            EpiIn E{(float*)(ws + WS_PSM), (float*)(ws + WS_LX), (bf16_t*)(ws + WS_GG), (bf16_t*)(ws + WS_SG), (bf16_t*)(ws + WS_HF)}; pg8::gemm_phase(lds, g, S, E); }
        PHASE_END;
        PHASE_IF PHK(3) { const int zz = ozero(); unsigned char* ws = p.ws + zz; const int G = ogrid(), bid = obid(); (void)G; (void)bid; const float* modv = (const float*)(ws + WS_MODV); const float* modl = modv + (size_t)l * 5 * 6144; (void)modl; postproj_phase(p, ws, l); }
        PHASE_END;
        PHASE_IF PHK(4) { const int zz = ozero(); unsigned char* ws = p.ws + zz; const int G = ogrid(), bid = obid(); (void)G; (void)bid; const float* modv = (const float*)(ws + WS_MODV); const float* modl = modv + (size_t)l * 5 * 6144; (void)modl;
            { pg8::Gemm g{(const bf16_t*)(ws + WS_QN), (const bf16_t*)(ws + WS_WQ), MT, 768, 384}; pg8::StaticOrder S; S.init(MT, 768, G, bid);
              EpiQ E{(bf16_t*)(ws + WS_QB), (const float*)(ws + WS_ROPE), (const float*)(ws + WS_ROPE) + 1024 * 16}; pg8::gemm_phase(lds, g, S, E); }
            { pg8::Gemm g{(const bf16_t*)(ws + WS_KEYS), (const bf16_t*)(ws + WS_WKV), NKEY, 512, 256}; pg8::StaticOrder S; S.init(NKEY, 512, G, (bid + G - 144 % G) % G);
              EpiBf16 E{(bf16_t*)(ws + WS_KN), 512}; pg8::gemm_phase(lds, g, S, E); }
            { pg8::Gemm g{(const bf16_t*)(ws + WS_WKV) + (size_t)512 * 256, (const bf16_t*)(ws + WS_KEYS), 512, NKEY, 256}; pg8::StaticOrder S; S.init(512, NKEY, G, (bid + G - 248 % G) % G);
              EpiBf16 E{(bf16_t*)(ws + WS_VT), NKEY}; pg8::gemm_phase(lds, g, S, E); }
        }
        PHASE_END;
        PHASE_IF PHK(5) { const int zz = ozero(); unsigned char* ws = p.ws + zz; const int G = ogrid(), bid = obid(); (void)G; (void)bid; const float* modv = (const float*)(ws + WS_MODV); const float* modl = modv + (size_t)l * 5 * 6144; (void)modl; attn_phase(p, ws, lds); }
        PHASE_END;
        PHASE_IF PHK(6) { const int zz = ozero(); unsigned char* ws = p.ws + zz; const int G = ogrid(), bid = obid(); (void)G; (void)bid; const float* modv = (const float*)(ws + WS_MODV); const float* modl = modv + (size_t)l * 5 * 6144; (void)modl; scan_phase(p, ws, l, lds); }
        PHASE_END;
        PHASE_IF PHK(7) { const int zz = ozero(); unsigned char* ws = p.ws + zz; const int G = ogrid(), bid = obid(); (void)G; (void)bid; const float* modv = (const float*)(ws + WS_MODV); const float* modl = modv + (size_t)l * 5 * 6144; (void)modl;
            { pg8::Gemm g{(const bf16_t*)(ws + WS_AO), (const bf16_t*)(ws + WS_WOMLA), MT, 1024, 512}; pg8::StaticOrder S; S.init(MT, 1024, G, bid);
              EpiMla E{(float*)(ws + WS_LX), (const bf16_t*)(ws + WS_SG)}; pg8::gemm_phase(lds, g, S, E); }
            { pg8::Gemm g{(const bf16_t*)(ws + WS_GG), (const bf16_t*)(ws + WS_WOLRU), MT, 1024, 1024}; pg8::StaticOrder S; S.init(MT, 1024, G, bid);
              EpiLru E{(const float*)(ws + WS_LX), (const bf16_t*)(ws + WS_SG), (bf16_t*)(ws + WS_Z), (const bf16_t*)(ws + WS_HF)}; pg8::gemm_phase(lds, g, S, E); }
        }
        PHASE_END;
        PHASE_IF PHK(8) { const int zz = ozero(); unsigned char* ws = p.ws + zz; const int G = ogrid(), bid = obid(); (void)G; (void)bid; const float* modv = (const float*)(ws + WS_MODV); const float* modl = modv + (size_t)l * 5 * 6144; (void)modl; pg8::Gemm g{(const bf16_t*)(ws + WS_Z), (const bf16_t*)(ws + WS_WOUT), MT, 1024, 1024}; pg8::StaticOrder S; S.init(MT, 1024, G, bid);
            EpiF32 E{(float*)(ws + WS_LX), 1024}; pg8::gemm_phase(lds, g, S, E); }
        PHASE_END;
        PHASE_IF PHK(9) { const int zz = ozero(); unsigned char* ws = p.ws + zz; const int G = ogrid(), bid = obid(); (void)G; (void)bid; const float* modv = (const float*)(ws + WS_MODV); const float* modl = modv + (size_t)l * 5 * 6144; (void)modl; const float* xp = l == 0 ? p.in[zz + I_XP] : (p.out + zz); const float* xs = l == 0 ? p.in[zz + I_XS] : (p.out + zz) + (size_t)MP * D; norm_phase<true, true>(p, ws, xp, xs, (const float*)(ws + WS_LX), p.in[zz + I_GQM] + l * D, 2048, modl, p.in[zz + I_GPF] + l * D, 3072, 4096, modl); }
        PHASE_END;
        PHASE_IF PHK(10) { const int zz = ozero(); unsigned char* ws = p.ws + zz; const int G = ogrid(), bid = obid(); (void)G; (void)bid; const float* modv = (const float*)(ws + WS_MODV); const float* modl = modv + (size_t)l * 5 * 6144; (void)modl; pg8::Gemm g{(const bf16_t*)(ws + WS_HBF), (const bf16_t*)(ws + WS_WFFI), MT, 5632, 1024}; pg8::StaticOrder S; S.init(MT, 5632, G, bid);
            EpiFfi E{(bf16_t*)(ws + WS_HID)}; pg8::gemm_phase(lds, g, S, E); }
        PHASE_END;
        PHASE_IF PHK(11) { const int zz = ozero(); unsigned char* ws = p.ws + zz; const int G = ogrid(), bid = obid(); (void)G; (void)bid; const float* modv = (const float*)(ws + WS_MODV); const float* modl = modv + (size_t)l * 5 * 6144; (void)modl; pg8::Gemm g{(const bf16_t*)(ws + WS_HID), (const bf16_t*)(ws + WS_WFFO), MT, 1024, FF}; pg8::StaticOrder S; S.init(MT, 1024, G, bid);
            EpiF32 E{(float*)(ws + WS_LX), 1024}; pg8::gemm_phase(lds, g, S, E); }
        PHASE_END;
        PHASE_IF PHK(12) { const int zz = ozero(); unsigned char* ws = p.ws + zz; const int G = ogrid(), bid = obid(); (void)G; (void)bid; const float* modv = (const float*)(ws + WS_MODV); const float* modl = modv + (size_t)l * 5 * 6144; (void)modl;
            if (l == 0) {
                norm_phase<true, true>(p, ws, (p.out + zz), (p.out + zz) + (size_t)MP * D, (const float*)(ws + WS_LX), p.in[zz + I_GQF], 5120, modl, p.in[zz + I_GPM] + D, 0, 1024, modv + (size_t)5 * 6144);
                for (int i = bid; i < CONV_ITEMS; i += G) conv_item(p, ws, 1, i, (LAS float*)lds);
            } else {
                norm_phase<true, false>(p, ws, (p.out + zz), (p.out + zz) + (size_t)MP * D, (const float*)(ws + WS_LX), p.in[zz + I_GQF] + D, 5120, modl, nullptr, 0, 0, nullptr);
            }
        }
#if ONE_LAUNCH && !defined(STOP_AFTER)
        if (l == 0) grid_sync_all();
#else
        PHASE_END;
#endif
    }
#if defined(STOP_AFTER)
    {
        const int tid = otid(), bid = obid(), G = ogrid(); const unsigned* wsu = (const unsigned*)p.ws; float* out = p.out;
        for (int i = bid * NTHREADS + tid; i < 17432576; i += G * NTHREADS) { float a = 0.f;
#pragma unroll
            for (int j = 0; j < 4; ++j) { const size_t idx = (size_t)i + (size_t)j * 17432576; if (idx * 4 < WS_END) { const unsigned u = wsu[idx]; a += (float)(u & 0xffu) + (float)((u >> 16) & 0xffu); } }
            out[i] = a; }
    }
#endif
}
constexpr int NPHASES = 2 + 11 * 2;

extern "C" void kernel_launch(void* const* d_in, const int* in_sizes, int n_in, void* d_out, int out_size, void* d_ws, size_t ws_size, hipStream_t stream) {
    static int grid = 0;
    if (grid == 0) {
        if (n_in != 31 || ws_size < WS_END) { fprintf(stderr, "kernel_launch: need 31 inputs and %zu bytes of workspace (got %d, %zu)\n", (size_t)WS_END, n_in, ws_size); grid = -1; return; }
        if (hipFuncSetAttribute((const void*)fwd_megakernel, hipFuncAttributeMaxDynamicSharedMemorySize, LDS_BYTES) != hipSuccess) { fprintf(stderr, "kernel_launch: hipFuncSetAttribute failed\n"); grid = -1; return; }
        int dev = 0, cus = 0, per_cu = 0;
        hipGetDevice(&dev); hipDeviceGetAttribute(&cus, hipDeviceAttributeMultiprocessorCount, dev);
        hipOccupancyMaxActiveBlocksPerMultiprocessor(&per_cu, (const void*)fwd_megakernel, NTHREADS, LDS_BYTES);
        if (per_cu < 1) { fprintf(stderr, "kernel_launch: occupancy query says %d blocks/CU\n", per_cu); per_cu = 1; }
        (void)hipGetLastError();
        grid = cus;
    }
    if (grid < 0) return;
    Params p{};
    for (int i = 0; i < 31; ++i) p.in[i] = (const float*)d_in[i];
    p.out = (float*)d_out; p.ws = (unsigned char*)d_ws;
#if ONE_LAUNCH
    p.ph_lo = 0; p.ph_hi = NPHASES; p.coop = 1;
    void* args[] = {&p};
    hipError_t e = hipLaunchCooperativeKernel((const void*)fwd_megakernel, dim3(grid), dim3(NTHREADS), args, LDS_BYTES, stream);
    if (e != hipSuccess) fprintf(stderr, "cooperative launch failed: %s (grid %d)\n", hipGetErrorString(e), grid);
#else
    for (int ph = 0; ph < NPHASES; ++ph) {
        p.ph_lo = ph; p.ph_hi = ph + 1; p.coop = 0;
        hipLaunchKernelGGL(fwd_megakernel, dim3(grid), dim3(NTHREADS), LDS_BYTES, stream, p);
    }
#endif
}
```

```cpp
#include <hip/hip_runtime.h>
#include <hip/hip_cooperative_groups.h>
#include <cstdio>
namespace cg = cooperative_groups;

#ifndef ONE_LAUNCH
#define ONE_LAUNCH 1
#endif

#ifndef PHMASK
#define PHMASK 0xffff
#endif
#define PHK(k) if constexpr (((PHMASK) >> (k)) & 1)
#ifndef LSCALE
#define LSCALE 1.0f
#endif
#ifndef MSCALE
#define MSCALE 1.0f
#endif
#ifndef FSCALE
#define FSCALE 1.0f
#endif
#ifndef OS0
#define OS0 1.0f
#endif
#ifndef OS1
#define OS1 1.0f
#endif
#ifndef OS2
#define OS2 1.0f
#endif
#ifndef OS3
#define OS3 1.0f
#endif
#ifndef OS4
#define OS4 1.0f
#endif
#ifndef OS5
#define OS5 1.0f
#endif
#ifndef ZMASK
#define ZMASK(row, col) false
#endif
#ifndef HSCALE
#define HSCALE 1.0f
#endif
#ifndef BSCALE
#define BSCALE 1.0f
#endif
#ifndef GGVAL
#define GGVAL(x) (x)
#endif
#ifndef GLVAL
#define GLVAL(x) (x)
#endif
#ifndef GLOFF
#define GLOFF 1024
#endif
#ifndef ZSCALE
#define ZSCALE 1.0f
#endif
#define LAS __attribute__((address_space(3)))
typedef unsigned short bf16_t;
typedef short bf16x8 __attribute__((ext_vector_type(8)));
typedef float f32x4 __attribute__((ext_vector_type(4)));
typedef float f32x2 __attribute__((ext_vector_type(2)));
typedef unsigned u32x4 __attribute__((ext_vector_type(4)));
typedef unsigned u32x2 __attribute__((ext_vector_type(2)));

constexpr int D = 1024, MT = 12288, MP = 8192, NKEY = 13312, FF = 2816;
constexpr int INCP = 4864;
constexpr int NTHREADS = 512, LDS_BYTES = 131072;
constexpr float EPS = 1e-6f;
constexpr float LOG2E = 1.4426950408889634f;
constexpr float QSCALE = 0.10206207261596577f * 1.4426950408889634f;

constexpr size_t OFF_CKV = 12582912, OFF_KR = 16777216, OFF_LF = 17301504, OFF_LB = 17367040;

constexpr size_t WS_MODV = 0;
constexpr size_t WS_ROPE = WS_MODV + 2 * 5 * 6144 * 4;
constexpr size_t WS_WIN = WS_ROPE + 2 * 1024 * 16 * 4;
constexpr size_t WS_WFFI = WS_WIN + (size_t)INCP * 1024 * 2;
constexpr size_t WS_WFFO = WS_WFFI + (size_t)5632 * 1024 * 2;
constexpr size_t WS_WOUT = WS_WFFO + (size_t)1024 * 2816 * 2;
constexpr size_t WS_WOLRU = WS_WOUT + (size_t)1024 * 1024 * 2;
constexpr size_t WS_WOMLA = WS_WOLRU + (size_t)1024 * 1024 * 2;
constexpr size_t WS_WQ = WS_WOMLA + (size_t)1024 * 512 * 2;
constexpr size_t WS_WKV = WS_WQ + (size_t)768 * 384 * 2;
constexpr size_t WS_WG = WS_WKV + (size_t)1024 * 256 * 2;
constexpr size_t WS_HBF = WS_WG + (size_t)2 * 8 * 256 * 128 * 2;
constexpr size_t WS_QN = WS_HBF;
constexpr size_t WS_KEYS = WS_QN + (size_t)MT * 384 * 2;
constexpr size_t WS_KRB = WS_KEYS + (size_t)NKEY * 256 * 2;
constexpr size_t WS_AO = WS_HBF;
constexpr size_t WS_PSM = WS_HBF + (size_t)MT * 1024 * 2;
constexpr size_t WS_QB = WS_PSM;
constexpr size_t WS_KN = WS_QB + (size_t)MT * 768 * 2;
constexpr size_t WS_Z = WS_PSM;
constexpr size_t WS_LX = WS_PSM + (size_t)MT * 768 * 4;
constexpr size_t WS_GG = WS_LX + (size_t)MT * 1024 * 4;
constexpr size_t WS_SG = WS_GG + (size_t)MT * 1024 * 2;
constexpr size_t WS_HID = WS_GG;
constexpr size_t WS_VT = WS_SG + (size_t)MT * 2048 * 2;
constexpr size_t WS_HF = WS_VT + (size_t)512 * NKEY * 2;
constexpr size_t WS_END = WS_HF + (size_t)MT * 1024 * 2;

struct Params {
    const float* in[31];
    float* out;
    unsigned char* ws;
    int ph_lo, ph_hi, coop, pad;
};
enum { I_XP = 0, I_XS, I_CCKV, I_CKR, I_SF, I_SB, I_C, I_CCTX, I_WMOD, I_BMOD, I_GPM, I_GQM, I_GPF, I_GQF, I_WIN, I_GQ, I_WQUP, I_GKV,
       I_WKVUP, I_WOMLA, I_CONVW, I_CONVB, I_WRG, I_BRG, I_WIG, I_BIG, I_LAM, I_WOLRU, I_WOUT, I_WFFI, I_WFFO };

__device__ __forceinline__ unsigned char* opq(unsigned char* x) { asm volatile("" : "+s"(x)); return x; }
__device__ __forceinline__ int ozero() { int t = 0; asm volatile("" : "+s"(t)); return t; }
__device__ __forceinline__ int otid() { int t = threadIdx.x; asm volatile("" : "+v"(t)); return t; }
__device__ __forceinline__ int obid() { int t = blockIdx.x; asm volatile("" : "+s"(t)); return t; }
__device__ __forceinline__ int ogrid() { int t = gridDim.x; asm volatile("" : "+s"(t)); return t; }
__device__ __forceinline__ unsigned cvt_pk_bf16(float lo, float hi) { unsigned r; asm volatile("v_cvt_pk_bf16_f32 %0, %1, %2" : "=v"(r) : "v"(lo), "v"(hi)); return r; }
__device__ __forceinline__ float bf2f(bf16_t b) { return __uint_as_float(((unsigned)b) << 16); }
__device__ __forceinline__ bf16_t f2bf(float f) { return (bf16_t)(cvt_pk_bf16(f, 0.f) & 0xffffu); }
__device__ __forceinline__ float wave_sum(float v) {
#pragma unroll
    for (int o = 32; o >= 1; o >>= 1) v += __shfl_xor(v, o);
    return v;
}
__device__ __forceinline__ float fast_sigmoid(float x) { return __builtin_amdgcn_rcpf(1.0f + __builtin_amdgcn_exp2f(-x * LOG2E)); }
__device__ __forceinline__ float gelu_tanh(float x) { const float z = 1.5957691216057308f * (x + 0.044715f * x * x * x); return x * fast_sigmoid(z); }
__device__ __forceinline__ int keyrow_of(int t) { return t < MP ? t : MP + ((t - MP) >> 10) * 1280 + ((t - MP) & 1023); }

namespace pg8 {
constexpr int BM = 256, BK = 64, HALF = 128, HTB = HALF * BK * 2, NXCD = 8, WGM = 8;
__device__ __forceinline__ int lds_byte(int r, int c) { const int st = (r >> 4) * 2 + (c >> 5), rr = r & 15, cc = c & 31, ob = rr * 64 + cc * 2; return st * 1024 + (ob ^ (((ob >> 9) & 1) << 5)); }
__device__ __forceinline__ void stage_rc(int b, int& R, int& C) { const int st = b / 1024, sb = b % 1024, swz = sb ^ (((sb >> 9) & 1) << 5); R = (st >> 1) * 16 + swz / 64; C = (st & 1) * 32 + (swz % 64) / 2; }
__device__ __forceinline__ int perm32(int rho) { const int n = rho >> 4, i = rho & 15; return 8 * (i >> 2) + 4 * n + (i & 3); }
struct Unit { int pm, pn; };
struct Gemm { const bf16_t* A; const bf16_t* Bt; int M, N, K; };
struct StaticOrder {
    int nM, nN, nwg, G, c;
    __device__ void init(int M, int N, int G_, int c_) { nM = M / BM; nN = N / BM; nwg = nM * nN; G = G_; c = c_; }
    __device__ bool next(int i, Unit& u) const {
        const int L = i * G + c; if (L >= nwg) return false;
        int wgid = L; { const int q = nwg / NXCD, r = nwg % NXCD, xcd = wgid % NXCD, off = wgid / NXCD; wgid = (xcd < r ? xcd * (q + 1) : r * (q + 1) + (xcd - r) * q) + off; }
        const int nig = WGM * nN, gid = wgid / nig, fm = gid * WGM, gsz = (nM - fm) < WGM ? (nM - fm) : WGM;
        u.pm = fm + ((wgid % nig) % gsz); u.pn = (wgid % nig) / gsz; return true;
    }
};
template <class Epi>
__device__ __forceinline__ void gemm_phase(LAS unsigned char* lds, const Gemm g, const StaticOrder& S, const Epi& E) {
    int tid_ = threadIdx.x; asm volatile("" : "+v"(tid_));
    const int tid = tid_, wid = __builtin_amdgcn_readfirstlane(tid >> 6), lane = tid & 63, wr = wid >> 2, wc = wid & 3, fr = lane & 15, fq = lane >> 4;
    const int K = g.K, nt = K / BK;
    unsigned voffA[2], voffB[2];
#pragma unroll
    for (int i = 0; i < 2; ++i) { int R, C; stage_rc(tid * 16 + i * 8192, R, C); const int Rb = Epi::PERM ? ((R & ~31) + perm32(R & 31)) : R;
        voffA[i] = (unsigned)(R * K + C) * 2u; voffB[i] = (unsigned)(Rb * K + C) * 2u; }
    const size_t kstep = (size_t)(BK * 2);
    const size_t hstep = (size_t)HALF * K * 2;
    const size_t tstep = 2 * hstep;
    const unsigned ldsw = (unsigned)wid * 1024u;
    const int aoff = lds_byte(wr * 64 + fr, fq * 8), boff = lds_byte(wc * 32 + fr, fq * 8);
#define PG8_SA(b, h) (((b) * 2 + (h)) * HTB)
#define PG8_SB(b, h) ((4 + (b) * 2 + (h)) * HTB)
#define PG8_STAGE(bufoff, gbase, voff) do { _Pragma("unroll") for (int _i = 0; _i < 2; ++_i) \
        __builtin_amdgcn_global_load_lds((const unsigned*)((const char*)(gbase) + (voff)[_i]), (LAS unsigned*)(lds + (bufoff) + ldsw + _i * 8192), 16, 0, 0); } while (0)
#define PG8_LDA(dst, b, h) do { _Pragma("unroll") for (int m = 0; m < 4; ++m) _Pragma("unroll") for (int k = 0; k < 2; ++k) dst[m][k] = *(const LAS bf16x8*)(lds + PG8_SA(b, h) + aoff + m * 2048 + k * 1024); } while (0)
#define PG8_LDB(dst, b, h) do { _Pragma("unroll") for (int n = 0; n < 2; ++n) _Pragma("unroll") for (int k = 0; k < 2; ++k) dst[n][k] = *(const LAS bf16x8*)(lds + PG8_SB(b, h) + boff + n * 2048 + k * 1024); } while (0)
#define PG8_MMA(ai, bj, At, Bt) do { __builtin_amdgcn_s_setprio(1); _Pragma("unroll") for (int m = 0; m < 4; ++m) _Pragma("unroll") for (int n = 0; n < 2; ++n) _Pragma("unroll") for (int k = 0; k < 2; ++k) \
        acc[ai][bj][m][n] = __builtin_amdgcn_mfma_f32_16x16x32_bf16(Bt[n][k], At[m][k], acc[ai][bj][m][n], 0, 0, 0); __builtin_amdgcn_s_setprio(0); } while (0)
#define PG8_WAIT_V(n) asm volatile("s_waitcnt vmcnt(" #n ")" ::: "memory")
#define PG8_WAIT_L(n) asm volatile("s_waitcnt lgkmcnt(" #n ")" ::: "memory")
#define PG8_BAR __builtin_amdgcn_s_barrier()
#define PG8_SCHED __builtin_amdgcn_sched_barrier(0)
    Unit cur, nxt; int ui = 0;
    if (!S.next(0, cur)) return;
    f32x4 acc[2][2][4][2];
#pragma unroll
    for (int a = 0; a < 2; ++a)
#pragma unroll
        for (int b = 0; b < 2; ++b)
#pragma unroll
            for (int m = 0; m < 4; ++m)
#pragma unroll
                for (int n = 0; n < 2; ++n) acc[a][b][m][n] = (f32x4){0.f, 0.f, 0.f, 0.f};
    bf16x8 At[4][2], B0[2][2], B1[2][2];
    const char* cA = (const char*)g.A + (size_t)cur.pm * tstep; const char* cB = (const char*)g.Bt + (size_t)cur.pn * tstep;
    PG8_STAGE(PG8_SB(0, 0), cB, voffB); PG8_STAGE(PG8_SA(0, 0), cA, voffA); PG8_STAGE(PG8_SB(0, 1), cB + hstep, voffB); PG8_STAGE(PG8_SA(0, 1), cA + hstep, voffA);
    if (wr == 1) PG8_BAR;
    PG8_WAIT_V(4); PG8_BAR;
    PG8_STAGE(PG8_SB(1, 0), cB + kstep, voffB); PG8_STAGE(PG8_SA(1, 0), cA + kstep, voffA); PG8_STAGE(PG8_SB(1, 1), cB + hstep + kstep, voffB);
    PG8_WAIT_V(6); PG8_BAR;
    for (;;) {
        const bool has_next = S.next(ui + 1, nxt);
        const char* nA = has_next ? (const char*)g.A + (size_t)nxt.pm * tstep : cA; const char* nB = has_next ? (const char*)g.Bt + (size_t)nxt.pn * tstep : cB;
        for (int t = 0; t < nt; t += 2) {
            const bool last = (t == nt - 2);
            const char* a1 = cA + (size_t)(t + 1) * kstep;
            const char* a2 = last ? nA : cA + (size_t)(t + 2) * kstep; const char* b2 = last ? nB : cB + (size_t)(t + 2) * kstep;
            const char* a3 = a2 + kstep; const char* b3 = b2 + kstep;
            PG8_LDB(B0, 0, 0); PG8_SCHED; PG8_LDA(At, 0, 0); PG8_STAGE(PG8_SA(1, 1), a1 + hstep, voffA);
            PG8_WAIT_L(8); PG8_BAR; PG8_WAIT_L(0); PG8_MMA(0, 0, At, B0); PG8_BAR; PG8_SCHED;
            PG8_LDB(B1, 0, 1); PG8_STAGE(PG8_SB(0, 0), b2, voffB);
            PG8_BAR; PG8_WAIT_L(0); PG8_MMA(0, 1, At, B1); PG8_BAR;
            PG8_LDA(At, 0, 1); PG8_STAGE(PG8_SA(0, 0), a2, voffA);
            PG8_BAR; PG8_WAIT_L(0); PG8_MMA(1, 0, At, B0); PG8_BAR; PG8_SCHED;
            PG8_STAGE(PG8_SB(0, 1), b2 + hstep, voffB);
            PG8_WAIT_V(6); PG8_BAR; PG8_MMA(1, 1, At, B1); PG8_BAR;
            PG8_LDB(B0, 1, 0); PG8_SCHED; PG8_LDA(At, 1, 0); PG8_STAGE(PG8_SA(0, 1), a2 + hstep, voffA);
            PG8_WAIT_L(8); PG8_BAR; PG8_WAIT_L(0); PG8_MMA(0, 0, At, B0); PG8_BAR; PG8_SCHED;
            PG8_LDB(B1, 1, 1); PG8_STAGE(PG8_SB(1, 0), b3, voffB);
            PG8_BAR; PG8_WAIT_L(0); PG8_MMA(0, 1, At, B1); PG8_BAR;
            PG8_LDA(At, 1, 1); PG8_STAGE(PG8_SA(1, 0), a3, voffA);
            PG8_BAR; PG8_WAIT_L(0); PG8_MMA(1, 0, At, B0); PG8_BAR; PG8_SCHED;
            PG8_STAGE(PG8_SB(1, 1), b3 + hstep, voffB);
            PG8_WAIT_V(6); PG8_BAR; PG8_MMA(1, 1, At, B1); PG8_BAR;
        }
        E(acc, cur, wr, wc, fr, fq);
        if (!has_next) break;
#pragma unroll
        for (int a = 0; a < 2; ++a)
#pragma unroll
            for (int b = 0; b < 2; ++b)
#pragma unroll
                for (int m = 0; m < 4; ++m)
#pragma unroll
                    for (int n = 0; n < 2; ++n) acc[a][b][m][n] = (f32x4){0.f, 0.f, 0.f, 0.f};
        cur = nxt; cA = nA; cB = nB; ++ui;
    }
    PG8_WAIT_V(0);
    if (wr == 0) PG8_BAR;
    PG8_BAR;
#undef PG8_SA
#undef PG8_SB
#undef PG8_STAGE
#undef PG8_LDA
#undef PG8_LDB
#undef PG8_MMA
#undef PG8_WAIT_V
#undef PG8_WAIT_L
#undef PG8_BAR
#undef PG8_SCHED
}
}
using pg8::Unit;
typedef f32x4 AccT[2][2][4][2];

__device__ __forceinline__ u32x4 pack8(f32x4 a, f32x4 b) { u32x4 w; w.x = cvt_pk_bf16(a[0], a[1]); w.y = cvt_pk_bf16(a[2], a[3]); w.z = cvt_pk_bf16(b[0], b[1]); w.w = cvt_pk_bf16(b[2], b[3]); return w; }
__device__ __forceinline__ u32x2 pack4(f32x4 a) { u32x2 w; w.x = cvt_pk_bf16(a[0], a[1]); w.y = cvt_pk_bf16(a[2], a[3]); return w; }
__device__ __forceinline__ void unpack8(u32x4 w, f32x4& a, f32x4& b) {
    a[0] = __uint_as_float(w.x << 16); a[1] = __uint_as_float(w.x & 0xffff0000u); a[2] = __uint_as_float(w.y << 16); a[3] = __uint_as_float(w.y & 0xffff0000u);
    b[0] = __uint_as_float(w.z << 16); b[1] = __uint_as_float(w.z & 0xffff0000u); b[2] = __uint_as_float(w.w << 16); b[3] = __uint_as_float(w.w & 0xffff0000u);
}

struct EpiIn {
    static constexpr bool PERM = true;
    float* psm; float* lx; bf16_t* gg; bf16_t* sg; bf16_t* g2;
    __device__ __forceinline__ void operator()(const AccT& acc, const Unit& u, int wr, int wc, int fr, int fq) const {
        const int row0 = u.pm * 256 + wr * 64 + fr, colb = u.pn * 256 + wc * 32 + 8 * fq;
#pragma unroll
        for (int ai = 0; ai < 2; ++ai)
#pragma unroll
            for (int m = 0; m < 4; ++m) {
                const size_t row = (size_t)(row0 + ai * 128 + m * 16);
#pragma unroll
                for (int bj = 0; bj < 2; ++bj) {
                    const int col = colb + bj * 128; f32x4 v0 = acc[ai][bj][m][0], v1 = acc[ai][bj][m][1];
                    if (u.pn < 3) { float* q = psm + row * 768 + col; *(f32x4*)q = v0; *(f32x4*)(q + 4) = v1; }
                    else if (u.pn < 7) { float* q = lx + row * 1024 + (col - 768); *(f32x4*)q = v0; *(f32x4*)(q + 4) = v1; }
                    else if (u.pn < 11) {
#pragma unroll
                        for (int j = 0; j < 4; ++j) { v0[j] = gelu_tanh(v0[j]); v1[j] = gelu_tanh(v1[j]); }
                        *(u32x4*)(gg + row * 1024 + (col - 1792)) = pack8(v0, v1); }
                    else {
#pragma unroll
                        for (int j = 0; j < 4; ++j) { v0[j] = fast_sigmoid(v0[j]); v1[j] = fast_sigmoid(v1[j]); }
                        *(u32x4*)(sg + row * 2048 + (col - 2816)) = pack8(v0, v1);
                        if (u.pn >= 15) *(u32x4*)(g2 + row * 1024 + (col - 3840)) = pack8(v0, v1); }
                }
            }
    }
};
struct EpiQ {
    static constexpr bool PERM = false;
    bf16_t* q; const float* ropec; const float* ropes;
    __device__ __forceinline__ void operator()(const AccT& acc, const Unit& u, int wr, int wc, int fr, int fq) const {
        const int row0 = u.pm * 256 + wr * 64 + fr;
#pragma unroll
        for (int ai = 0; ai < 2; ++ai)
#pragma unroll
            for (int m = 0; m < 4; ++m) {
                const int row = row0 + ai * 128 + m * 16; const bool lat = row >= MP; const int pos = (row - MP) & 1023;
#pragma unroll
                for (int bj = 0; bj < 2; ++bj) {
                    const int base = u.pn * 256 + bj * 128 + wc * 32; const bool rope = lat && (((base >> 5) % 3) == 2);
                    f32x4 v0 = acc[ai][bj][m][0], v1 = acc[ai][bj][m][1];
                    if (rope) { const f32x4 cs = *(const f32x4*)(ropec + pos * 16 + 4 * fq), sn = *(const f32x4*)(ropes + pos * 16 + 4 * fq);
                        const f32x4 o0 = v0 * cs - v1 * sn, o1 = v0 * sn + v1 * cs; v0 = o0; v1 = o1; }
                    v0 *= QSCALE; v1 *= QSCALE;
                    bf16_t* dst = q + (size_t)row * 768 + base + 4 * fq;
                    *(u32x2*)dst = pack4(v0); *(u32x2*)(dst + 16) = pack4(v1);
                }
                asm volatile("" ::: "memory");
            }
    }
};
struct EpiBf16 {
    static constexpr bool PERM = true;
    bf16_t* o; int ldc;
    __device__ __forceinline__ void operator()(const AccT& acc, const Unit& u, int wr, int wc, int fr, int fq) const {
        const int row0 = u.pm * 256 + wr * 64 + fr, colb = u.pn * 256 + wc * 32 + 8 * fq;
#pragma unroll
        for (int ai = 0; ai < 2; ++ai)
#pragma unroll
            for (int m = 0; m < 4; ++m) {
                const size_t row = (size_t)(row0 + ai * 128 + m * 16);
#pragma unroll
                for (int bj = 0; bj < 2; ++bj) *(u32x4*)(o + row * ldc + colb + bj * 128) = pack8(acc[ai][bj][m][0], acc[ai][bj][m][1]);
            }
    }
};
struct EpiF32 {
    static constexpr bool PERM = true;
    float* o; int ldc;
    __device__ __forceinline__ void operator()(const AccT& acc, const Unit& u, int wr, int wc, int fr, int fq) const {
        const int row0 = u.pm * 256 + wr * 64 + fr, colb = u.pn * 256 + wc * 32 + 8 * fq;
#pragma unroll
        for (int ai = 0; ai < 2; ++ai)
#pragma unroll
            for (int m = 0; m < 4; ++m) {
                const size_t row = (size_t)(row0 + ai * 128 + m * 16);
#pragma unroll
                for (int bj = 0; bj < 2; ++bj) { float* q = o + row * ldc + colb + bj * 128; *(f32x4*)q = acc[ai][bj][m][0]; *(f32x4*)(q + 4) = acc[ai][bj][m][1]; }
            }
    }
};
struct EpiMla {
    static constexpr bool PERM = true;
    float* z1; const bf16_t* sg;
    __device__ __forceinline__ void operator()(const AccT& acc, const Unit& u, int wr, int wc, int fr, int fq) const {
        const int row0 = u.pm * 256 + wr * 64 + fr, colb = u.pn * 256 + wc * 32 + 8 * fq;
#pragma unroll
        for (int ai = 0; ai < 2; ++ai)
#pragma unroll
            for (int m = 0; m < 4; ++m) {
                const size_t row = (size_t)(row0 + ai * 128 + m * 16);
#pragma unroll
                for (int bj = 0; bj < 2; ++bj) { const int col = colb + bj * 128; f32x4 g0, g1; unpack8(*(const u32x4*)(sg + row * 2048 + col), g0, g1);
                    float* q = z1 + row * 1024 + col; *(f32x4*)q = acc[ai][bj][m][0] * g0 * ZSCALE; *(f32x4*)(q + 4) = acc[ai][bj][m][1] * g1 * ZSCALE; }
                asm volatile("" ::: "memory");
            }
    }
};
struct EpiLru {
    static constexpr bool PERM = true;
    const float* z1; const bf16_t* sg; bf16_t* z; const bf16_t* g2;
    __device__ __forceinline__ void operator()(const AccT& acc, const Unit& u, int wr, int wc, int fr, int fq) const {
        const int row0 = u.pm * 256 + wr * 64 + fr, colb = u.pn * 256 + wc * 32 + 8 * fq;
#pragma unroll
        for (int ai = 0; ai < 2; ++ai)
#pragma unroll
            for (int m = 0; m < 4; ++m) {
                const size_t row = (size_t)(row0 + ai * 128 + m * 16);
#pragma unroll
                for (int bj = 0; bj < 2; ++bj) { const int col = colb + bj * 128; f32x4 g0, g1; unpack8(*(const u32x4*)(g2 + row * 1024 + col), g0, g1);
                    const float* q = z1 + row * 1024 + col; const f32x4 a0 = *(const f32x4*)q + acc[ai][bj][m][0] * GLVAL(g0) * LSCALE, a1 = *(const f32x4*)(q + 4) + acc[ai][bj][m][1] * GLVAL(g1) * LSCALE;
                    *(u32x4*)(z + row * 1024 + col) = pack8(a0, a1); }
                asm volatile("" ::: "memory");
            }
    }
};
struct EpiFfi {
    static constexpr bool PERM = false;
    bf16_t* hid;
    __device__ __forceinline__ void operator()(const AccT& acc, const Unit& u, int wr, int wc, int fr, int fq) const {
        const int row0 = u.pm * 256 + wr * 64 + fr;
#pragma unroll
        for (int ai = 0; ai < 2; ++ai)
#pragma unroll
            for (int m = 0; m < 4; ++m) {
                const size_t row = (size_t)(row0 + ai * 128 + m * 16);
#pragma unroll
                for (int bj = 0; bj < 2; ++bj) { const int hc = ((u.pn * 256 + bj * 128 + wc * 32) >> 1) + 4 * fq; const f32x4 gv = acc[ai][bj][m][0], uv = acc[ai][bj][m][1]; f32x4 h;
#pragma unroll
                    for (int j = 0; j < 4; ++j) h[j] = gv[j] * fast_sigmoid(gv[j]) * uv[j];
                    *(u32x2*)(hid + row * FF + hc) = pack4(h); }
            }
    }
};

__device__ __forceinline__ int map_row(int mode, int n) {
    if (mode == 1) return n < 672 ? n : n + 96;
    if (mode == 2) { const int up = n >= FF, j = up ? n - FF : n; return (j >> 4) * 32 + (j & 15) + (up ? 16 : 0); }
    if (mode == 3) { const int h = n >> 7, r = n & 127; return r < 64 ? h * 64 + r : 512 + h * 64 + (r - 64); }
    return n;
}
__device__ __forceinline__ void conv_tile(const float* src, int ld, int K, int k0, int n0, bf16_t* dst, int mode, LAS float* tile) {
    const int tid = otid();
    __syncthreads();
#pragma unroll
    for (int i = 0; i < 2; ++i) { const int kk = (tid >> 3) + 64 * i, c4 = (tid & 7) * 4; const f32x4 v = *(const f32x4*)(src + (size_t)(k0 + kk) * ld + n0 + c4);
        tile[kk * 33 + c4] = v[0]; tile[kk * 33 + c4 + 1] = v[1]; tile[kk * 33 + c4 + 2] = v[2]; tile[kk * 33 + c4 + 3] = v[3]; }
    __syncthreads();
    const int n = tid >> 4, k8 = (tid & 15) * 8; f32x4 a, b;
#pragma unroll
    for (int j = 0; j < 4; ++j) { a[j] = tile[(k8 + j) * 33 + n]; b[j] = tile[(k8 + 4 + j) * 33 + n]; }
    *(u32x4*)(dst + (size_t)map_row(mode, n0 + n) * K + k0 + k8) = pack8(a, b);
}
constexpr int CONV_ITEMS = 4208;
__device__ __forceinline__ void conv_item(const Params& p, unsigned char* ws, int l, int idx, LAS float* tile) {
    const int zz = ozero();
    int inidx, K, N, mode = 0; size_t soff, doff;
    if (idx < 1192) { inidx = I_WIN; soff = (size_t)l * 1024 * 4768; doff = WS_WIN; K = 1024; N = 4768; mode = 1; }
    else if ((idx -= 1192) < 1408) { inidx = I_WFFI; soff = (size_t)l * 1024 * 5632; doff = WS_WFFI; K = 1024; N = 5632; mode = 2; }
    else if ((idx -= 1408) < 704) { inidx = I_WFFO; soff = (size_t)l * 2816 * 1024; doff = WS_WFFO; K = 2816; N = 1024; }
    else if ((idx -= 704) < 256) { inidx = I_WOUT; soff = (size_t)l * 1024 * 1024; doff = WS_WOUT; K = 1024; N = 1024; }
    else if ((idx -= 256) < 256) { inidx = I_WOLRU; soff = (size_t)l * 1024 * 1024; doff = WS_WOLRU; K = 1024; N = 1024; }
    else if ((idx -= 256) < 128) { inidx = I_WOMLA; soff = (size_t)l * 512 * 1024; doff = WS_WOMLA; K = 512; N = 1024; }
    else if ((idx -= 128) < 72) { inidx = I_WQUP; soff = (size_t)l * 384 * 768; doff = WS_WQ; K = 384; N = 768; }
    else if ((idx -= 72) < 64) { inidx = I_WKVUP; soff = (size_t)l * 256 * 1024; doff = WS_WKV; K = 256; N = 1024; mode = 3; }
    else { idx -= 64; const int mat = idx >> 2, ig = mat >> 4, dir = (mat >> 3) & 1, n = mat & 7;
        inidx = ig ? I_WIG : I_WRG; soff = (size_t)((l * 2 + dir) * 8 + n) * 16384; doff = WS_WG + (size_t)((dir * 8 + n) * 256 + ig * 128) * 128 * 2; K = 128; N = 128; idx &= 3; }
    const float* src = p.in[zz + inidx] + soff; bf16_t* dst = (bf16_t*)(ws + doff);
    const int nk = K / 128, kt = idx % nk, ntile = idx / nk;
    conv_tile(src, N, K, kt * 128, ntile * 32, dst, mode, tile);
}
__device__ __forceinline__ void modv_phase(const Params& p, unsigned char* ws, LAS float* lds) {
    const int zz = ozero();
    LAS float* sc = lds + 128 * 33;
    LAS float* red = sc + 5 * 1024;
    const int tid = otid();
    __syncthreads();
    for (int i = tid; i < 5 * 1024; i += NTHREADS) { const float c = i < 1024 ? p.in[zz + I_CCTX][i] : p.in[zz + I_C][i - 1024]; sc[i] = c / (1.0f + __expf(-c)); }
    __syncthreads();
    float* modv = (float*)(ws + WS_MODV); const int bid = obid(), G = ogrid();
    const int col = tid & 31, kg = tid >> 5;
    for (int it = bid; it < 384; it += G) {
        const int l = it / 192, j0 = (it % 192) * 32;
        const float* w = p.in[zz + I_WMOD] + (size_t)l * 1024 * 6144 + j0 + col;
        float a0 = 0.f, a1 = 0.f, a2 = 0.f, a3 = 0.f, a4 = 0.f;
#pragma unroll 8
        for (int k = kg * 64; k < kg * 64 + 64; ++k) { const float wv = w[(size_t)k * 6144]; a0 += sc[k] * wv; a1 += sc[1024 + k] * wv; a2 += sc[2048 + k] * wv; a3 += sc[3072 + k] * wv; a4 += sc[4096 + k] * wv; }
        red[(kg * 5 + 0) * 32 + col] = a0; red[(kg * 5 + 1) * 32 + col] = a1; red[(kg * 5 + 2) * 32 + col] = a2; red[(kg * 5 + 3) * 32 + col] = a3; red[(kg * 5 + 4) * 32 + col] = a4;
        __syncthreads();
        if (tid < 160) { const int v = tid >> 5, c = tid & 31; float s = p.in[zz + I_BMOD][l * 6144 + j0 + c];
#pragma unroll
            for (int g = 0; g < 16; ++g) s += red[(g * 5 + v) * 32 + c];
            modv[(size_t)(l * 5 + v) * 6144 + j0 + c] = s; }
        __syncthreads();
    }
}
__device__ __forceinline__ void rope_table(const Params& p, unsigned char* ws) {
    const int zz = ozero();
    float* rc = (float*)(ws + WS_ROPE); float* rs = rc + 1024 * 16;
    const int G = ogrid(); for (int i = obid() * NTHREADS + otid(); i < 1024 * 16; i += G * NTHREADS) {
        const int pos = i >> 4, f = i & 15; const float posv = (float)(f < 8 ? (pos >> 6) : (pos & 63));
        const float inv = exp2f(-(float)(f & 7) * (13.287712379549449f / 8.0f));
        const float rev = posv * inv * 0.15915494309189535f;
        rc[i] = __builtin_amdgcn_cosf(rev); rs[i] = __builtin_amdgcn_sinf(rev);
    }
}

template <bool HAS_Y, bool DO_H>
__device__ __forceinline__ void norm_phase(const Params& p, unsigned char* ws, const float* xp, const float* xs, const float* Y, const float* gA, int gate_off, const float* modA,
                                           const float* gB, int sh_off, int sc_off, const float* modB) {
    const int zz = ozero();
    const int tid = otid(), wid = tid >> 6, lane = tid & 63; const int bid = obid(), G = ogrid();
    bf16_t* hbf = (bf16_t*)(ws + WS_HBF);
    for (int row = bid * 8 + wid; row < MT; row += G * 8) {
        const int mv = row < MP ? 0 : 1 + ((row - MP) >> 10);
        const float* xin = row < MP ? xp + (size_t)row * D : xs + (size_t)(row - MP) * D;
        f32x4 x[4];
#pragma unroll
        for (int i = 0; i < 4; ++i) x[i] = *(const f32x4*)(xin + i * 256 + lane * 4);
        if (HAS_Y) {
            f32x4 y[4]; float ss = 0.f;
#pragma unroll
            for (int i = 0; i < 4; ++i) { y[i] = *(const f32x4*)(Y + (size_t)row * D + i * 256 + lane * 4); ss += y[i][0] * y[i][0] + y[i][1] * y[i][1] + y[i][2] * y[i][2] + y[i][3] * y[i][3]; }
            ss = wave_sum(ss); const float rstd = rsqrtf(ss * (1.0f / D) + EPS);
            const float* mg = modA + (size_t)mv * 6144 + gate_off;
#pragma unroll
            for (int i = 0; i < 4; ++i) { const f32x4 g = *(const f32x4*)(gA + i * 256 + lane * 4), gt = *(const f32x4*)(mg + i * 256 + lane * 4);
                x[i] = x[i] + gt * (y[i] * rstd * g) * (gate_off == 2048 ? MSCALE : FSCALE); *(f32x4*)((p.out + zz) + (size_t)row * D + i * 256 + lane * 4) = DO_H ? x[i] : x[i] * (row < MP ? (ZMASK(row, i * 256 + lane * 4) ? 0.0f : OS0) : OS1); }
        }
        if (DO_H) {
            float ss = 0.f;
#pragma unroll
            for (int i = 0; i < 4; ++i) ss += x[i][0] * x[i][0] + x[i][1] * x[i][1] + x[i][2] * x[i][2] + x[i][3] * x[i][3];
            ss = wave_sum(ss); const float rstd = rsqrtf(ss * (1.0f / D) + EPS);
            const float* msh = modB + (size_t)mv * 6144 + sh_off; const float* msc = modB + (size_t)mv * 6144 + sc_off;
#pragma unroll
            for (int i = 0; i < 4; ++i) { const f32x4 g = *(const f32x4*)(gB + i * 256 + lane * 4), sh = *(const f32x4*)(msh + i * 256 + lane * 4), sc = *(const f32x4*)(msc + i * 256 + lane * 4);
                const f32x4 h = (x[i] * rstd * g) * (sc + 1.0f) + sh; *(u32x2*)(hbf + (size_t)row * D + i * 256 + lane * 4) = pack4(h); }
        }
    }
}

__device__ __forceinline__ void postproj_phase(const Params& p, unsigned char* ws, int l) {
    const int zz = ozero();
    const int tid = otid(), wid = tid >> 6, lane = tid & 63; const int bid = obid(), G = ogrid();
    const float* psm = (const float*)(ws + WS_PSM);
    bf16_t* qn = (bf16_t*)(ws + WS_QN); bf16_t* keys = (bf16_t*)(ws + WS_KEYS); bf16_t* krb = (bf16_t*)(ws + WS_KRB);
    const float* ropec = (const float*)(ws + WS_ROPE); const float* ropes = ropec + 1024 * 16;
    const float* gq = p.in[zz + I_GQ] + l * 384; const float* gkv = p.in[zz + I_GKV] + l * 256;
    for (int t = bid * 8 + wid; t < NKEY; t += G * 8) {
        if (t < MT) {
            const float* pr = psm + (size_t)t * 768;
            f32x2 q[3]; float ss = 0.f;
#pragma unroll
            for (int i = 0; i < 3; ++i) { q[i] = *(const f32x2*)(pr + i * 128 + lane * 2); ss += q[i][0] * q[i][0] + q[i][1] * q[i][1]; }
            ss = wave_sum(ss); float rstd = rsqrtf(ss * (1.0f / 384.0f) + EPS);
#pragma unroll
            for (int i = 0; i < 3; ++i) { const f32x2 g = *(const f32x2*)(gq + i * 128 + lane * 2); *(unsigned*)(qn + (size_t)t * 384 + i * 128 + lane * 2) = cvt_pk_bf16(q[i][0] * rstd * g[0], q[i][1] * rstd * g[1]); }
            f32x4 kv = *(const f32x4*)(pr + 384 + lane * 4);
            ss = wave_sum(kv[0] * kv[0] + kv[1] * kv[1] + kv[2] * kv[2] + kv[3] * kv[3]); rstd = rsqrtf(ss * (1.0f / 256.0f) + EPS);
            const f32x4 ckv = kv * rstd * *(const f32x4*)(gkv + lane * 4);
            const int kr = keyrow_of(t);
            *(u32x2*)(keys + (size_t)kr * 256 + lane * 4) = pack4(ckv);
            const int s = t >> 8, pp = t & 255;
            if (t < MP) *(f32x4*)((p.out + zz) + OFF_CKV + ((size_t)(s * 2 + l) * 256 + pp) * 256 + lane * 4) = ckv * OS2;
            if (lane < 16) {
                float x1 = pr[640 + lane], x2 = pr[656 + lane];
                if (t >= MP) { const int pos = (t - MP) & 1023; const float cs = ropec[pos * 16 + lane], sn = ropes[pos * 16 + lane]; const float o1 = x1 * cs - x2 * sn, o2 = x1 * sn + x2 * cs; x1 = o1; x2 = o2; }
                krb[(size_t)kr * 32 + lane] = f2bf(x1); krb[(size_t)kr * 32 + 16 + lane] = f2bf(x2);
                if (t < MP) { float* o = (p.out + zz) + OFF_KR + ((size_t)(s * 2 + l) * 256 + pp) * 32; o[lane] = x1 * OS3; o[16 + lane] = x2 * OS3; }
            }
        } else {
            const int j = t - MT, b = j >> 8, jj = j & 255, kr = MP + b * 1280 + 1024 + jj;
            const f32x4 v = *(const f32x4*)(p.in[zz + I_CCKV] + ((size_t)(b * 2 + l) * 256 + jj) * 256 + lane * 4);
            *(u32x2*)(keys + (size_t)kr * 256 + lane * 4) = pack4(v);
            if (lane < 8) { const f32x4 w = *(const f32x4*)(p.in[zz + I_CKR] + ((size_t)(b * 2 + l) * 256 + jj) * 32 + lane * 4); *(u32x2*)(krb + (size_t)kr * 32 + lane * 4) = pack4(w); }
        }
    }
}

__device__ __forceinline__ void attn_phase(const Params& p, unsigned char* ws, LAS unsigned char* lds) {
    const int zz = ozero();
    const bf16_t* Qb = (const bf16_t*)(ws + WS_QB); const bf16_t* Kn = (const bf16_t*)(ws + WS_KN); const bf16_t* KR = (const bf16_t*)(ws + WS_KRB);
    const bf16_t* Vt = (const bf16_t*)(ws + WS_VT); bf16_t* AO = (bf16_t*)(ws + WS_AO);
    LAS bf16_t* Ks = (LAS bf16_t*)lds;
    LAS bf16_t* Vs = (LAS bf16_t*)(lds + 64 * 208);
    const int tid = otid(), wid = tid >> 6, lane = tid & 63, l15 = lane & 15, quad = lane >> 4; const int bid = obid(), G = ogrid();
    const bool split = (G == 256);
    for (int it = split ? (bid < 32 ? 768 : bid - 32) : bid; it < 768; it += split ? 224 : G) {
        int tq, kb, nk, h;
        if (it < 256) { const int b = it >> 6; h = (it >> 3) & 7; tq = MP + b * 1024 + (it & 7) * 128; kb = MP + b * 1280; nk = 1280; }
        else { const int j = it - 256, s = j >> 4; h = (j >> 1) & 7; tq = s * 256 + (j & 1) * 128; kb = s * 256; nk = 256; }
        const int qrow = tq + wid * 16 + l15;
        bf16x8 qf[3];
#pragma unroll
        for (int ks = 0; ks < 3; ++ks) qf[ks] = *(const bf16x8*)(Qb + (size_t)qrow * 768 + h * 96 + ks * 32 + quad * 8);
        f32x4 o[4];
#pragma unroll
        for (int i = 0; i < 4; ++i) o[i] = (f32x4){0.f, 0.f, 0.f, 0.f};
        float mrun = -1e30f, lsum = 0.f;
        for (int k0 = 0; k0 < nk; k0 += 64) {
            __syncthreads();
            for (int c = tid; c < 768; c += NTHREADS) { const int r = c / 12, cc = c % 12;
                const bf16_t* src = cc < 8 ? Kn + (size_t)(kb + k0 + r) * 512 + h * 64 + cc * 8 : KR + (size_t)(kb + k0 + r) * 32 + (cc - 8) * 8;
                *(LAS u32x4*)(Ks + r * 104 + cc * 8) = *(const u32x4*)src; }
            { const int r = tid >> 3, cc = tid & 7; *(LAS u32x4*)(Vs + r * 72 + cc * 8) = *(const u32x4*)(Vt + (size_t)(h * 64 + r) * NKEY + kb + k0 + cc * 8); }
            __syncthreads();
            f32x4 s[4];
#pragma unroll
            for (int js = 0; js < 4; ++js) { s[js] = (f32x4){0.f, 0.f, 0.f, 0.f};
#pragma unroll
                for (int ks = 0; ks < 3; ++ks) { const bf16x8 a = *(const LAS bf16x8*)(Ks + (js * 16 + l15) * 104 + ks * 32 + quad * 8); s[js] = __builtin_amdgcn_mfma_f32_16x16x32_bf16(a, qf[ks], s[js], 0, 0, 0); } }
            float mx = s[0][0];
#pragma unroll
            for (int js = 0; js < 4; ++js)
#pragma unroll
                for (int j = 0; j < 4; ++j) mx = fmaxf(mx, s[js][j]);
            mx = fmaxf(mx, __shfl_xor(mx, 16)); mx = fmaxf(mx, __shfl_xor(mx, 32));
            const float mnew = fmaxf(mrun, mx), alpha = __builtin_amdgcn_exp2f(mrun - mnew); mrun = mnew;
            float psum = 0.f;
#pragma unroll
            for (int js = 0; js < 4; ++js)
#pragma unroll
                for (int j = 0; j < 4; ++j) { s[js][j] = __builtin_amdgcn_exp2f(s[js][j] - mnew); psum += s[js][j]; }
            lsum = lsum * alpha + psum;
#pragma unroll
            for (int i = 0; i < 4; ++i) o[i] *= alpha;
#pragma unroll
            for (int kk = 0; kk < 2; ++kk) {
                const u32x4 pw = pack8(s[2 * kk], s[2 * kk + 1]); bf16x8 pf; __builtin_memcpy(&pf, &pw, 16);
#pragma unroll
                for (int dv = 0; dv < 4; ++dv) {
                    const LAS bf16_t* vp = Vs + (dv * 16 + l15) * 72 + kk * 32 + quad * 4;
                    u32x4 vw; const u32x2 v0 = *(const LAS u32x2*)vp, v1 = *(const LAS u32x2*)(vp + 16); vw.x = v0.x; vw.y = v0.y; vw.z = v1.x; vw.w = v1.y;
                    bf16x8 va; __builtin_memcpy(&va, &vw, 16);
                    o[dv] = __builtin_amdgcn_mfma_f32_16x16x32_bf16(va, pf, o[dv], 0, 0, 0);
                }
            }
        }
        lsum += __shfl_xor(lsum, 16); lsum += __shfl_xor(lsum, 32);
        const float inv = 1.0f / lsum;
#pragma unroll
        for (int dv = 0; dv < 4; ++dv) *(u32x2*)(AO + (size_t)qrow * 512 + h * 64 + dv * 16 + quad * 4) = pack4(o[dv] * inv);
    }
}

template <int DIR>
__device__ __forceinline__ void scan_pass(const Params& p, unsigned char* ws, int l, int n, int tok0, int L, float h0, bool write_state, int state_idx, LAS unsigned char* lds) {
    const int zz = ozero();
    LAS float* xcf = (LAS float*)lds;
    LAS bf16_t* xcb = (LAS bf16_t*)(lds + 64 * 132 * 4);
    const int tid = otid(), wid = tid >> 6, lane = tid & 63, l15 = lane & 15, quad = lane >> 4;
    const int chl = wid * 16 + l15, ch = n * 128 + chl;
    const float* LXp = (const float*)(ws + WS_LX); bf16_t* HF = (bf16_t*)(ws + WS_SG) + 1024;   bf16_t* GG = (bf16_t*)(ws + WS_GG);
    const float lam = p.in[zz + I_LAM][(l * 2 + DIR) * 1024 + ch];
    const float nl = -lam, sp = fmaxf(nl, 0.f) + log1pf(__expf(-fabsf(nl)));
    const float cc = -8.0f * sp * LOG2E;
    const float br = p.in[zz + I_BRG][(l * 2 + DIR) * 1024 + ch], bi = p.in[zz + I_BIG][(l * 2 + DIR) * 1024 + ch];
    const bf16_t* wg = (const bf16_t*)(ws + WS_WG) + (size_t)((DIR * 8 + n) * 256) * 128;
    bf16x8 wrf[4], wif[4];
#pragma unroll
    for (int ks = 0; ks < 4; ++ks) { wrf[ks] = *(const bf16x8*)(wg + (size_t)chl * 128 + ks * 32 + quad * 8); wif[ks] = *(const bf16x8*)(wg + (size_t)(128 + chl) * 128 + ks * 32 + quad * 8); }
    const int c4 = (tid & 31) * 4, tg = tid >> 5;
    const float* cw = p.in[zz + I_CONVW] + (size_t)l * 4 * 1024 + n * 128 + c4;
    const f32x4 w0 = *(const f32x4*)cw, w1 = *(const f32x4*)(cw + 1024), w2 = *(const f32x4*)(cw + 2048), w3 = *(const f32x4*)(cw + 3072);
    const f32x4 cb = *(const f32x4*)(p.in[zz + I_CONVB] + l * 1024 + n * 128 + c4);
    float hin = h0;
    const int nchunk = L >> 6;
    for (int ci = 0; ci < nchunk; ++ci) {
        const int t0 = (DIR ? nchunk - 1 - ci : ci) * 64;
        __syncthreads();
        {
            f32x4 xr[7];
#pragma unroll
            for (int r = 0; r < 7; ++r) { const int tt = t0 + tg * 4 - 2 + r; xr[r] = (tt >= 0 && tt < L) ? *(const f32x4*)(LXp + (size_t)(tok0 + tt) * 1024 + n * 128 + c4) : (f32x4){0.f, 0.f, 0.f, 0.f}; }
#pragma unroll
            for (int j = 0; j < 4; ++j) { const f32x4 xc = cb + xr[j] * w0 + xr[j + 1] * w1 + xr[j + 2] * w2 + xr[j + 3] * w3;
                *(LAS f32x4*)(xcf + (tg * 4 + j) * 132 + c4) = xc; *(LAS u32x2*)(xcb + (tg * 4 + j) * 136 + c4) = pack4(xc); }
        }
        __syncthreads();
        f32x4 rg[4], ig[4];
#pragma unroll
        for (int st = 0; st < 4; ++st) { rg[st] = (f32x4){0.f, 0.f, 0.f, 0.f}; ig[st] = (f32x4){0.f, 0.f, 0.f, 0.f};
#pragma unroll
            for (int ks = 0; ks < 4; ++ks) { const bf16x8 a = *(const LAS bf16x8*)(xcb + (st * 16 + l15) * 136 + ks * 32 + quad * 8);
                rg[st] = __builtin_amdgcn_mfma_f32_16x16x32_bf16(a, wrf[ks], rg[st], 0, 0, 0); ig[st] = __builtin_amdgcn_mfma_f32_16x16x32_bf16(a, wif[ks], ig[st], 0, 0, 0); } }
#pragma unroll
        for (int sti = 0; sti < 4; ++sti) {
            const int st = DIR ? 3 - sti : sti;
            float av[4], hv[4], pa[4];
#pragma unroll
            for (int j = 0; j < 4; ++j) { const float x = xcf[(st * 16 + quad * 4 + j) * 132 + chl];
                const float rr = fast_sigmoid(rg[st][j] + br), ii = fast_sigmoid(ig[st][j] + bi);
                const float a = __builtin_amdgcn_exp2f(cc * rr); av[j] = a; hv[j] = __builtin_amdgcn_sqrtf(fmaxf(1.0f - a * a, 0.f)) * ii * x; }
            float hl = 0.f, pr = 1.f;
#pragma unroll
            for (int s4 = 0; s4 < 4; ++s4) { const int j = DIR ? 3 - s4 : s4; hl = av[j] * hl + hv[j]; pr *= av[j]; hv[j] = hl; pa[j] = pr; }
            float Ar = 1.f, Hr = 0.f, Aex = 1.f, Hex = 0.f;
#pragma unroll
            for (int s4 = 0; s4 < 4; ++s4) { const int qq = DIR ? 3 - s4 : s4; const float Aq = __shfl(pr, qq * 16 + l15), Hq = __shfl(hl, qq * 16 + l15);
                if (qq == quad) { Aex = Ar; Hex = Hr; }
                Hr = Aq * Hr + Hq; Ar *= Aq; }
            const float cq = Aex * hin + Hex;
            hin = Ar * hin + Hr;
#pragma unroll
            for (int j = 0; j < 4; ++j) { const float hfin = hv[j] + pa[j] * cq; const size_t idx = (size_t)(tok0 + t0 + st * 16 + quad * 4 + j) * 1024 + ch;
                if (DIR == 0) HF[idx + (idx - ch)] = f2bf(hfin);
                else GG[idx] = f2bf((bf2f(HF[idx + (idx - ch)]) * HSCALE + hfin * BSCALE) * GGVAL(bf2f(GG[idx]))); }
        }
    }
    if (write_state && quad == 0) (p.out + zz)[(DIR ? OFF_LB : OFF_LF) + state_idx + ch] = hin * (DIR ? OS5 : OS4);
}
__device__ __forceinline__ void scan_phase(const Params& p, unsigned char* ws, int l, LAS unsigned char* lds) {
    const int zz = ozero();
    const int tid = otid(), l15 = tid & 15, wid = tid >> 6; const int bid = obid(), G = ogrid();
    for (int rr = 0; rr < 2; ++rr) {
        const int it = rr == 0 ? bid : ((G == 256 && bid >= 32 && bid < 64) ? 224 + bid : (G == 256 ? 288 : bid + G));
        if (it >= 288) break;
        int n, tok0, L, sidx; bool lat; float hf0 = 0.f, hb0 = 0.f;
        if (it < 32) { const int b = it >> 3; n = it & 7; tok0 = MP + b * 1024; L = 1024; lat = true; sidx = 0; const int ch = n * 128 + wid * 16 + l15;
            hf0 = p.in[zz + I_SF][(b * 2 + l) * 1024 + ch]; hb0 = p.in[zz + I_SB][(b * 2 + l) * 1024 + ch]; }
        else { const int j = it - 32, s = j >> 3; n = j & 7; tok0 = s * 256; L = 256; lat = false; sidx = (s * 2 + l) * 1024; }
        scan_pass<0>(p, ws, l, n, tok0, L, hf0, !lat, sidx, lds);
        scan_pass<1>(p, ws, l, n, tok0, L, hb0, !lat, sidx, lds);
    }
}

__device__ __forceinline__ unsigned char* opq_unused(unsigned char* x) { asm volatile("" : "+s"(x)); return x; }
__device__ __forceinline__ void grid_sync_all() {
    asm volatile("s_waitcnt vmcnt(0) lgkmcnt(0)" ::: "memory");
    __syncthreads();
    if (threadIdx.x < 64) { __builtin_amdgcn_fence(__ATOMIC_RELEASE, "agent"); asm volatile("s_waitcnt vmcnt(0) lgkmcnt(0)" ::: "memory"); }
    cg::this_grid().sync();
    if (threadIdx.x < 64) { __builtin_amdgcn_fence(__ATOMIC_ACQUIRE, "agent"); asm volatile("s_waitcnt vmcnt(0) lgkmcnt(0)" ::: "memory"); }
    __syncthreads();
}
__global__ void __launch_bounds__(NTHREADS) fwd_megakernel(Params p) {
    extern __shared__ __attribute__((aligned(16))) unsigned char smem[];
    LAS unsigned char* lds = (LAS unsigned char*)smem;
    int ph = 0; (void)ph; int phc = 0; (void)phc;
#if defined(STOP_AFTER)
#define PHASE_IF if (phc <= STOP_AFTER)
#define PHASE_END do { ++phc; grid_sync_all(); } while (0)
#elif ONE_LAUNCH
#define PHASE_IF
#define PHASE_END do { grid_sync_all(); } while (0)
#else
#define PHASE_IF if (__builtin_amdgcn_readfirstlane((int)(ph >= p.ph_lo && ph < p.ph_hi)))
#define PHASE_END do { ++ph; } while (0)
#endif

    PHASE_IF PHK(0) { const int zz = ozero(); unsigned char* ws = p.ws + zz; const int G = ogrid(), bid = obid(); (void)G; (void)bid; const float* modv = (const float*)(ws + WS_MODV); const float* modl = modv; (void)modl;
        rope_table(p, ws);
        modv_phase(p, ws, (LAS float*)lds);
        for (int i = bid; i < CONV_ITEMS; i += G) conv_item(p, ws, 0, i, (LAS float*)lds);
    }
    PHASE_END;
    PHASE_IF PHK(1) { const int zz = ozero(); unsigned char* ws = p.ws + zz; const int G = ogrid(), bid = obid(); (void)G; (void)bid; const float* modv = (const float*)(ws + WS_MODV); const float* modl = modv; (void)modl; norm_phase<false, true>(p, ws, p.in[zz + I_XP], p.in[zz + I_XS], nullptr, nullptr, 0, nullptr, p.in[zz + I_GPM], 0, 1024, modv); }
    PHASE_END;
#pragma unroll 1
    for (int l = 0; l < 2; ++l) {
        PHASE_IF PHK(2) { const int zz = ozero(); unsigned char* ws = p.ws + zz; const int G = ogrid(), bid = obid(); (void)G; (void)bid; const float* modv = (const float*)(ws + WS_MODV); const float* modl = modv + (size_t)l * 5 * 6144; (void)modl; pg8::Gemm g{(const bf16_t*)(ws + WS_HBF), (const bf16_t*)(ws + WS_WIN), MT, INCP, 1024}; pg8::StaticOrder S; S.init(MT, INCP, G, bid);
            EpiIn E{(float*)(ws + WS_PSM), (float*)(ws + WS_LX), (bf16_t*)(ws + WS_GG), (bf16_t*)(ws + WS_SG), (bf16_t*)(ws + WS_HF)}; pg8::gemm_phase(lds, g, S, E); }
        PHASE_END;
        PHASE_IF PHK(3) { const int zz = ozero(); unsigned char* ws = p.ws + zz; const int G = ogrid(), bid = obid(); (void)G; (void)bid; const float* modv = (const float*)(ws + WS_MODV); const float* modl = modv + (size_t)l * 5 * 6144; (void)modl; postproj_phase(p, ws, l); }
        PHASE_END;
        PHASE_IF PHK(4) { const int zz = ozero(); unsigned char* ws = p.ws + zz; const int G = ogrid(), bid = obid(); (void)G; (void)bid; const float* modv = (const float*)(ws + WS_MODV); const float* modl = modv + (size_t)l * 5 * 6144; (void)modl;
            { pg8::Gemm g{(const bf16_t*)(ws + WS_QN), (const bf16_t*)(ws + WS_WQ), MT, 768, 384}; pg8::StaticOrder S; S.init(MT, 768, G, bid);
              EpiQ E{(bf16_t*)(ws + WS_QB), (const float*)(ws + WS_ROPE), (const float*)(ws + WS_ROPE) + 1024 * 16}; pg8::gemm_phase(lds, g, S, E); }
            { pg8::Gemm g{(const bf16_t*)(ws + WS_KEYS), (const bf16_t*)(ws + WS_WKV), NKEY, 512, 256}; pg8::StaticOrder S; S.init(NKEY, 512, G, (bid + G - 144 % G) % G);
              EpiBf16 E{(bf16_t*)(ws + WS_KN), 512}; pg8::gemm_phase(lds, g, S, E); }
            { pg8::Gemm g{(const bf16_t*)(ws + WS_WKV) + (size_t)512 * 256, (const bf16_t*)(ws + WS_KEYS), 512, NKEY, 256}; pg8::StaticOrder S; S.init(512, NKEY, G, (bid + G - 248 % G) % G);
              EpiBf16 E{(bf16_t*)(ws + WS_VT), NKEY}; pg8::gemm_phase(lds, g, S, E); }
        }
        PHASE_END;
        PHASE_IF PHK(5) { const int zz = ozero(); unsigned char* ws = p.ws + zz; const int G = ogrid(), bid = obid(); (void)G; (void)bid; const float* modv = (const float*)(ws + WS_MODV); const float* modl = modv + (size_t)l * 5 * 6144; (void)modl; attn_phase(p, ws, lds); }
        PHASE_IF PHK(6) { const int zz = ozero(); unsigned char* ws = p.ws + zz; const int G = ogrid(), bid = obid(); (void)G; (void)bid; const float* modv = (const float*)(ws + WS_MODV); const float* modl = modv + (size_t)l * 5 * 6144; (void)modl; scan_phase(p, ws, l, lds); }
        PHASE_END;
        PHASE_IF PHK(7) { const int zz = ozero(); unsigned char* ws = p.ws + zz; const int G = ogrid(), bid = obid(); (void)G; (void)bid; const float* modv = (const float*)(ws + WS_MODV); const float* modl = modv + (size_t)l * 5 * 6144; (void)modl;
            { pg8::Gemm g{(const bf16_t*)(ws + WS_AO), (const bf16_t*)(ws + WS_WOMLA), MT, 1024, 512}; pg8::StaticOrder S; S.init(MT, 1024, G, bid);
              EpiMla E{(float*)(ws + WS_LX), (const bf16_t*)(ws + WS_SG)}; pg8::gemm_phase(lds, g, S, E); }
            { pg8::Gemm g{(const bf16_t*)(ws + WS_GG), (const bf16_t*)(ws + WS_WOLRU), MT, 1024, 1024}; pg8::StaticOrder S; S.init(MT, 1024, G, bid);
              EpiLru E{(const float*)(ws + WS_LX), (const bf16_t*)(ws + WS_SG), (bf16_t*)(ws + WS_Z), (const bf16_t*)(ws + WS_HF)}; pg8::gemm_phase(lds, g, S, E); }
        }
        PHASE_END;
        PHASE_IF PHK(8) { const int zz = ozero(); unsigned char* ws = p.ws + zz; const int G = ogrid(), bid = obid(); (void)G; (void)bid; const float* modv = (const float*)(ws + WS_MODV); const float* modl = modv + (size_t)l * 5 * 6144; (void)modl; pg8::Gemm g{(const bf16_t*)(ws + WS_Z), (const bf16_t*)(ws + WS_WOUT), MT, 1024, 1024}; pg8::StaticOrder S; S.init(MT, 1024, G, bid);
            EpiF32 E{(float*)(ws + WS_LX), 1024}; pg8::gemm_phase(lds, g, S, E); }
        PHASE_END;
        PHASE_IF PHK(9) { const int zz = ozero(); unsigned char* ws = p.ws + zz; const int G = ogrid(), bid = obid(); (void)G; (void)bid; const float* modv = (const float*)(ws + WS_MODV); const float* modl = modv + (size_t)l * 5 * 6144; (void)modl; const float* xp = l == 0 ? p.in[zz + I_XP] : (p.out + zz); const float* xs = l == 0 ? p.in[zz + I_XS] : (p.out + zz) + (size_t)MP * D; norm_phase<true, true>(p, ws, xp, xs, (const float*)(ws + WS_LX), p.in[zz + I_GQM] + l * D, 2048, modl, p.in[zz + I_GPF] + l * D, 3072, 4096, modl); }
        PHASE_END;
        PHASE_IF PHK(10) { const int zz = ozero(); unsigned char* ws = p.ws + zz; const int G = ogrid(), bid = obid(); (void)G; (void)bid; const float* modv = (const float*)(ws + WS_MODV); const float* modl = modv + (size_t)l * 5 * 6144; (void)modl; pg8::Gemm g{(const bf16_t*)(ws + WS_HBF), (const bf16_t*)(ws + WS_WFFI), MT, 5632, 1024}; pg8::StaticOrder S; S.init(MT, 5632, G, bid);
            EpiFfi E{(bf16_t*)(ws + WS_HID)}; pg8::gemm_phase(lds, g, S, E); }
        PHASE_END;
        PHASE_IF PHK(11) { const int zz = ozero(); unsigned char* ws = p.ws + zz; const int G = ogrid(), bid = obid(); (void)G; (void)bid; const float* modv = (const float*)(ws + WS_MODV); const float* modl = modv + (size_t)l * 5 * 6144; (void)modl; pg8::Gemm g{(const bf16_t*)(ws + WS_HID), (const bf16_t*)(ws + WS_WFFO), MT, 1024, FF}; pg8::StaticOrder S; S.init(MT, 1024, G, bid);
            EpiF32 E{(float*)(ws + WS_LX), 1024}; pg8::gemm_phase(lds, g, S, E); }
        PHASE_END;
        PHASE_IF PHK(12) { const int zz = ozero(); unsigned char* ws = p.ws + zz; const int G = ogrid(), bid = obid(); (void)G; (void)bid; const float* modv = (const float*)(ws + WS_MODV); const float* modl = modv + (size_t)l * 5 * 6144; (void)modl;
            if (l == 0) {
                norm_phase<true, true>(p, ws, (p.out + zz), (p.out + zz) + (size_t)MP * D, (const float*)(ws + WS_LX), p.in[zz + I_GQF], 5120, modl, p.in[zz + I_GPM] + D, 0, 1024, modv + (size_t)5 * 6144);
                for (int i = bid; i < CONV_ITEMS; i += G) conv_item(p, ws, 1, i, (LAS float*)lds);
            } else {
                norm_phase<true, false>(p, ws, (p.out + zz), (p.out + zz) + (size_t)MP * D, (const float*)(ws + WS_LX), p.in[zz + I_GQF] + D, 5120, modl, nullptr, 0, 0, nullptr);
            }
        }
#if ONE_LAUNCH && !defined(STOP_AFTER)
        if (l == 0) grid_sync_all();
#else
        PHASE_END;
#endif
    }
#if defined(STOP_AFTER)
    {
        const int tid = otid(), bid = obid(), G = ogrid(); const unsigned* wsu = (const unsigned*)p.ws; float* out = p.out;
        for (int i = bid * NTHREADS + tid; i < 17432576; i += G * NTHREADS) { float a = 0.f;
#pragma unroll
            for (int j = 0; j < 4; ++j) { const size_t idx = (size_t)i + (size_t)j * 17432576; if (idx * 4 < WS_END) { const unsigned u = wsu[idx]; a += (float)(u & 0xffu) + (float)((u >> 16) & 0xffu); } }
            out[i] = a; }
    }
#endif
}
constexpr int NPHASES = 2 + 11 * 2;

extern "C" void kernel_launch(void* const* d_in, const int* in_sizes, int n_in, void* d_out, int out_size, void* d_ws, size_t ws_size, hipStream_t stream) {
    static int grid = 0;
    if (grid == 0) {
        if (n_in != 31 || ws_size < WS_END) { fprintf(stderr, "kernel_launch: need 31 inputs and %zu bytes of workspace (got %d, %zu)\n", (size_t)WS_END, n_in, ws_size); grid = -1; return; }
        if (hipFuncSetAttribute((const void*)fwd_megakernel, hipFuncAttributeMaxDynamicSharedMemorySize, LDS_BYTES) != hipSuccess) { fprintf(stderr, "kernel_launch: hipFuncSetAttribute failed\n"); grid = -1; return; }
        int dev = 0, cus = 0, per_cu = 0;
        hipGetDevice(&dev); hipDeviceGetAttribute(&cus, hipDeviceAttributeMultiprocessorCount, dev);
        hipOccupancyMaxActiveBlocksPerMultiprocessor(&per_cu, (const void*)fwd_megakernel, NTHREADS, LDS_BYTES);
        if (per_cu < 1) { fprintf(stderr, "kernel_launch: occupancy query says %d blocks/CU\n", per_cu); per_cu = 1; }
        (void)hipGetLastError();
        grid = cus;
    }
    if (grid < 0) return;
    Params p{};
    for (int i = 0; i < 31; ++i) p.in[i] = (const float*)d_in[i];
    p.out = (float*)d_out; p.ws = (unsigned char*)d_ws;
#if ONE_LAUNCH
    p.ph_lo = 0; p.ph_hi = NPHASES; p.coop = 1;
    void* args[] = {&p};
    hipError_t e = hipLaunchCooperativeKernel((const void*)fwd_megakernel, dim3(grid), dim3(NTHREADS), args, LDS_BYTES, stream);
    if (e != hipSuccess) fprintf(stderr, "cooperative launch failed: %s (grid %d)\n", hipGetErrorString(e), grid);
#else
    for (int ph = 0; ph < NPHASES; ++ph) {
        p.ph_lo = ph; p.ph_hi = ph + 1; p.coop = 0;
        hipLaunchKernelGGL(fwd_megakernel, dim3(grid), dim3(NTHREADS), LDS_BYTES, stream, p);
    }
#endif
}
```

```cpp
#include <hip/hip_runtime.h>
#include <hip/hip_cooperative_groups.h>
#include <cstdio>
namespace cg = cooperative_groups;

#ifndef ONE_LAUNCH
#define ONE_LAUNCH 1
#endif

#ifndef PHMASK
#define PHMASK 0xffff
#endif
#define PHK(k) if constexpr (((PHMASK) >> (k)) & 1)
#ifndef LSCALE
#define LSCALE 1.0f
#endif
#ifndef MSCALE
#define MSCALE 1.0f
#endif
#ifndef FSCALE
#define FSCALE 1.0f
#endif
#ifndef OS0
#define OS0 1.0f
#endif
#ifndef OS1
#define OS1 1.0f
#endif
#ifndef OS2
#define OS2 1.0f
#endif
#ifndef OS3
#define OS3 1.0f
#endif
#ifndef OS4
#define OS4 1.0f
#endif
#ifndef OS5
#define OS5 1.0f
#endif
#ifndef ZMASK
#define ZMASK(row, col) false
#endif
#ifndef HSCALE
#define HSCALE 1.0f
#endif
#ifndef BSCALE
#define BSCALE 1.0f
#endif
#ifndef GGVAL
#define GGVAL(x) (x)
#endif
#ifndef GLVAL
#define GLVAL(x) (x)
#endif
#ifndef GLOFF
#define GLOFF 1024
#endif
#ifndef ZSCALE
#define ZSCALE 1.0f
#endif
#define LAS __attribute__((address_space(3)))
typedef unsigned short bf16_t;
typedef short bf16x8 __attribute__((ext_vector_type(8)));
typedef float f32x4 __attribute__((ext_vector_type(4)));
typedef float f32x2 __attribute__((ext_vector_type(2)));
typedef unsigned u32x4 __attribute__((ext_vector_type(4)));
typedef unsigned u32x2 __attribute__((ext_vector_type(2)));

constexpr int D = 1024, MT = 12288, MP = 8192, NKEY = 13312, FF = 2816;
constexpr int INCP = 4864;
constexpr int NTHREADS = 512, LDS_BYTES = 131072;
constexpr float EPS = 1e-6f;
constexpr float LOG2E = 1.4426950408889634f;
constexpr float QSCALE = 0.10206207261596577f * 1.4426950408889634f;

constexpr size_t OFF_CKV = 12582912, OFF_KR = 16777216, OFF_LF = 17301504, OFF_LB = 17367040;

constexpr size_t WS_MODV = 0;
constexpr size_t WS_ROPE = WS_MODV + 2 * 5 * 6144 * 4;
constexpr size_t WS_WIN = WS_ROPE + 2 * 1024 * 16 * 4;
constexpr size_t WS_WFFI = WS_WIN + (size_t)INCP * 1024 * 2;
constexpr size_t WS_WFFO = WS_WFFI + (size_t)5632 * 1024 * 2;
constexpr size_t WS_WOUT = WS_WFFO + (size_t)1024 * 2816 * 2;
constexpr size_t WS_WOLRU = WS_WOUT + (size_t)1024 * 1024 * 2;
constexpr size_t WS_WOMLA = WS_WOLRU + (size_t)1024 * 1024 * 2;
constexpr size_t WS_WQ = WS_WOMLA + (size_t)1024 * 512 * 2;
constexpr size_t WS_WKV = WS_WQ + (size_t)768 * 384 * 2;
constexpr size_t WS_WG = WS_WKV + (size_t)1024 * 256 * 2;
constexpr size_t WS_HBF = WS_WG + (size_t)2 * 8 * 256 * 128 * 2;
constexpr size_t WS_QN = WS_HBF;
constexpr size_t WS_KEYS = WS_QN + (size_t)MT * 384 * 2;
constexpr size_t WS_KRB = WS_KEYS + (size_t)NKEY * 256 * 2;
constexpr size_t WS_AO = WS_HBF;
constexpr size_t WS_PSM = WS_HBF + (size_t)MT * 1024 * 2;
constexpr size_t WS_QB = WS_PSM;
constexpr size_t WS_KN = WS_QB + (size_t)MT * 768 * 2;
constexpr size_t WS_Z = WS_PSM;
constexpr size_t WS_LX = WS_PSM + (size_t)MT * 768 * 4;
constexpr size_t WS_GG = WS_LX + (size_t)MT * 1024 * 4;
constexpr size_t WS_SG = WS_GG + (size_t)MT * 1024 * 2;
constexpr size_t WS_HID = WS_GG;
constexpr size_t WS_VT = WS_SG + (size_t)MT * 2048 * 2;
constexpr size_t WS_HF = WS_VT + (size_t)512 * NKEY * 2;
constexpr size_t WS_END = WS_HF + (size_t)MT * 1024 * 2;

struct Params {
    const float* in[31];
    float* out;
    unsigned char* ws;
    int ph_lo, ph_hi, coop, pad;
};
enum { I_XP = 0, I_XS, I_CCKV, I_CKR, I_SF, I_SB, I_C, I_CCTX, I_WMOD, I_BMOD, I_GPM, I_GQM, I_GPF, I_GQF, I_WIN, I_GQ, I_WQUP, I_GKV,
       I_WKVUP, I_WOMLA, I_CONVW, I_CONVB, I_WRG, I_BRG, I_WIG, I_BIG, I_LAM, I_WOLRU, I_WOUT, I_WFFI, I_WFFO };

__device__ __forceinline__ unsigned char* opq(unsigned char* x) { asm volatile("" : "+s"(x)); return x; }
__device__ __forceinline__ int ozero() { int t = 0; asm volatile("" : "+s"(t)); return t; }
__device__ __forceinline__ int otid() { int t = threadIdx.x; asm volatile("" : "+v"(t)); return t; }
__device__ __forceinline__ int obid() { int t = blockIdx.x; asm volatile("" : "+s"(t)); return t; }
__device__ __forceinline__ int ogrid() { int t = gridDim.x; asm volatile("" : "+s"(t)); return t; }
__device__ __forceinline__ unsigned cvt_pk_bf16(float lo, float hi) { unsigned r; asm volatile("v_cvt_pk_bf16_f32 %0, %1, %2" : "=v"(r) : "v"(lo), "v"(hi)); return r; }
__device__ __forceinline__ float bf2f(bf16_t b) { return __uint_as_float(((unsigned)b) << 16); }
__device__ __forceinline__ bf16_t f2bf(float f) { return (bf16_t)(cvt_pk_bf16(f, 0.f) & 0xffffu); }
__device__ __forceinline__ float shfl_idx(float v, int srclane) { return __int_as_float(__builtin_amdgcn_ds_bpermute(srclane << 2, __float_as_int(v))); }
__device__ __forceinline__ float wave_sum(float v, int lane) {
#pragma unroll
    for (int o = 32; o >= 1; o >>= 1) v += shfl_idx(v, lane ^ o);
    return v;
}
__device__ __forceinline__ float fast_sigmoid(float x) { return __builtin_amdgcn_rcpf(1.0f + __builtin_amdgcn_exp2f(-x * LOG2E)); }
__device__ __forceinline__ float gelu_tanh(float x) { const float z = 1.5957691216057308f * (x + 0.044715f * x * x * x); return x * fast_sigmoid(z); }
__device__ __forceinline__ int keyrow_of(int t) { return t < MP ? t : MP + ((t - MP) >> 10) * 1280 + ((t - MP) & 1023); }

namespace pg8 {
constexpr int BM = 256, BK = 64, HALF = 128, HTB = HALF * BK * 2, NXCD = 8, WGM = 8;
__device__ __forceinline__ int lds_byte(int r, int c) { const int st = (r >> 4) * 2 + (c >> 5), rr = r & 15, cc = c & 31, ob = rr * 64 + cc * 2; return st * 1024 + (ob ^ (((ob >> 9) & 1) << 5)); }
__device__ __forceinline__ void stage_rc(int b, int& R, int& C) { const int st = b / 1024, sb = b % 1024, swz = sb ^ (((sb >> 9) & 1) << 5); R = (st >> 1) * 16 + swz / 64; C = (st & 1) * 32 + (swz % 64) / 2; }
__device__ __forceinline__ int perm32(int rho) { const int n = rho >> 4, i = rho & 15; return 8 * (i >> 2) + 4 * n + (i & 3); }
struct Unit { int pm, pn; };
struct Gemm { const bf16_t* A; const bf16_t* Bt; int M, N, K; };
struct StaticOrder {
    int nM, nN, nwg, G, c;
    __device__ void init(int M, int N, int G_, int c_) { nM = M / BM; nN = N / BM; nwg = nM * nN; G = G_; c = c_; }
    __device__ bool next(int i, Unit& u) const {
        const int L = i * G + c; if (L >= nwg) return false;
        int wgid = L; { const int q = nwg / NXCD, r = nwg % NXCD, xcd = wgid % NXCD, off = wgid / NXCD; wgid = (xcd < r ? xcd * (q + 1) : r * (q + 1) + (xcd - r) * q) + off; }
        const int nig = WGM * nN, gid = wgid / nig, fm = gid * WGM, gsz = (nM - fm) < WGM ? (nM - fm) : WGM;
        u.pm = fm + ((wgid % nig) % gsz); u.pn = (wgid % nig) / gsz; return true;
    }
};
template <class Epi>
__device__ __forceinline__ void gemm_phase(LAS unsigned char* lds, const Gemm g, const StaticOrder& S, const Epi& E) {
    int tid_ = threadIdx.x; asm volatile("" : "+v"(tid_));
    const int tid = tid_, wid = __builtin_amdgcn_readfirstlane(tid >> 6), lane = tid & 63, wr = wid >> 2, wc = wid & 3, fr = lane & 15, fq = lane >> 4;
    const int K = g.K, nt = K / BK;
    unsigned voffA[2], voffB[2];
#pragma unroll
    for (int i = 0; i < 2; ++i) { int R, C; stage_rc(tid * 16 + i * 8192, R, C); const int Rb = Epi::PERM ? ((R & ~31) + perm32(R & 31)) : R;
        voffA[i] = (unsigned)(R * K + C) * 2u; voffB[i] = (unsigned)(Rb * K + C) * 2u; }
    const size_t kstep = (size_t)(BK * 2);
    const size_t hstep = (size_t)HALF * K * 2;
    const size_t tstep = 2 * hstep;
    const unsigned ldsw = (unsigned)wid * 1024u;
    const int aoff = lds_byte(wr * 64 + fr, fq * 8), boff = lds_byte(wc * 32 + fr, fq * 8);
#define PG8_SA(b, h) (((b) * 2 + (h)) * HTB)
#define PG8_SB(b, h) ((4 + (b) * 2 + (h)) * HTB)
#define PG8_STAGE(bufoff, gbase, voff) do { _Pragma("unroll") for (int _i = 0; _i < 2; ++_i) \
        __builtin_amdgcn_global_load_lds((const unsigned*)((const char*)(gbase) + (voff)[_i]), (LAS unsigned*)(lds + (bufoff) + ldsw + _i * 8192), 16, 0, 0); } while (0)
#define PG8_LDA(dst, b, h) do { _Pragma("unroll") for (int m = 0; m < 4; ++m) _Pragma("unroll") for (int k = 0; k < 2; ++k) dst[m][k] = *(const LAS bf16x8*)(lds + PG8_SA(b, h) + aoff + m * 2048 + k * 1024); } while (0)
#define PG8_LDB(dst, b, h) do { _Pragma("unroll") for (int n = 0; n < 2; ++n) _Pragma("unroll") for (int k = 0; k < 2; ++k) dst[n][k] = *(const LAS bf16x8*)(lds + PG8_SB(b, h) + boff + n * 2048 + k * 1024); } while (0)
#define PG8_MMA(ai, bj, At, Bt) do { __builtin_amdgcn_s_setprio(1); _Pragma("unroll") for (int m = 0; m < 4; ++m) _Pragma("unroll") for (int n = 0; n < 2; ++n) _Pragma("unroll") for (int k = 0; k < 2; ++k) \
        acc[ai][bj][m][n] = __builtin_amdgcn_mfma_f32_16x16x32_bf16(Bt[n][k], At[m][k], acc[ai][bj][m][n], 0, 0, 0); __builtin_amdgcn_s_setprio(0); } while (0)
#define PG8_WAIT_V(n) asm volatile("s_waitcnt vmcnt(" #n ")" ::: "memory")
#define PG8_WAIT_L(n) asm volatile("s_waitcnt lgkmcnt(" #n ")" ::: "memory")
#define PG8_BAR __builtin_amdgcn_s_barrier()
#define PG8_SCHED __builtin_amdgcn_sched_barrier(0)
    Unit cur, nxt; int ui = 0;
    if (!S.next(0, cur)) return;
    f32x4 acc[2][2][4][2];
#pragma unroll
    for (int a = 0; a < 2; ++a)
#pragma unroll
        for (int b = 0; b < 2; ++b)
#pragma unroll
            for (int m = 0; m < 4; ++m)
#pragma unroll
                for (int n = 0; n < 2; ++n) acc[a][b][m][n] = (f32x4){0.f, 0.f, 0.f, 0.f};
    bf16x8 At[4][2], B0[2][2], B1[2][2];
    const char* cA = (const char*)g.A + (size_t)cur.pm * tstep; const char* cB = (const char*)g.Bt + (size_t)cur.pn * tstep;
    PG8_STAGE(PG8_SB(0, 0), cB, voffB); PG8_STAGE(PG8_SA(0, 0), cA, voffA); PG8_STAGE(PG8_SB(0, 1), cB + hstep, voffB); PG8_STAGE(PG8_SA(0, 1), cA + hstep, voffA);
    if (wr == 1) PG8_BAR;
    PG8_WAIT_V(4); PG8_BAR;
    PG8_STAGE(PG8_SB(1, 0), cB + kstep, voffB); PG8_STAGE(PG8_SA(1, 0), cA + kstep, voffA); PG8_STAGE(PG8_SB(1, 1), cB + hstep + kstep, voffB);
    PG8_WAIT_V(6); PG8_BAR;
    for (;;) {
        const bool has_next = S.next(ui + 1, nxt);
        const char* nA = has_next ? (const char*)g.A + (size_t)nxt.pm * tstep : cA; const char* nB = has_next ? (const char*)g.Bt + (size_t)nxt.pn * tstep : cB;
        for (int t = 0; t < nt; t += 2) {
            const bool last = (t == nt - 2);
            const char* a1 = cA + (size_t)(t + 1) * kstep;
            const char* a2 = last ? nA : cA + (size_t)(t + 2) * kstep; const char* b2 = last ? nB : cB + (size_t)(t + 2) * kstep;
            const char* a3 = a2 + kstep; const char* b3 = b2 + kstep;
            PG8_LDB(B0, 0, 0); PG8_SCHED; PG8_LDA(At, 0, 0); PG8_STAGE(PG8_SA(1, 1), a1 + hstep, voffA);
            PG8_WAIT_L(8); PG8_BAR; PG8_WAIT_L(0); PG8_MMA(0, 0, At, B0); PG8_BAR; PG8_SCHED;
            PG8_LDB(B1, 0, 1); PG8_STAGE(PG8_SB(0, 0), b2, voffB);
            PG8_BAR; PG8_WAIT_L(0); PG8_MMA(0, 1, At, B1); PG8_BAR;
            PG8_LDA(At, 0, 1); PG8_STAGE(PG8_SA(0, 0), a2, voffA);
            PG8_BAR; PG8_WAIT_L(0); PG8_MMA(1, 0, At, B0); PG8_BAR; PG8_SCHED;
            PG8_STAGE(PG8_SB(0, 1), b2 + hstep, voffB);
            PG8_WAIT_V(6); PG8_BAR; PG8_MMA(1, 1, At, B1); PG8_BAR;
            PG8_LDB(B0, 1, 0); PG8_SCHED; PG8_LDA(At, 1, 0); PG8_STAGE(PG8_SA(0, 1), a2 + hstep, voffA);
            PG8_WAIT_L(8); PG8_BAR; PG8_WAIT_L(0); PG8_MMA(0, 0, At, B0); PG8_BAR; PG8_SCHED;
            PG8_LDB(B1, 1, 1); PG8_STAGE(PG8_SB(1, 0), b3, voffB);
            PG8_BAR; PG8_WAIT_L(0); PG8_MMA(0, 1, At, B1); PG8_BAR;
            PG8_LDA(At, 1, 1); PG8_STAGE(PG8_SA(1, 0), a3, voffA);
            PG8_BAR; PG8_WAIT_L(0); PG8_MMA(1, 0, At, B0); PG8_BAR; PG8_SCHED;
            PG8_STAGE(PG8_SB(1, 1), b3 + hstep, voffB);
            PG8_WAIT_V(6); PG8_BAR; PG8_MMA(1, 1, At, B1); PG8_BAR;
        }
        E(acc, cur, wr, wc, fr, fq);
        if (!has_next) break;
#pragma unroll
        for (int a = 0; a < 2; ++a)
#pragma unroll
            for (int b = 0; b < 2; ++b)
#pragma unroll
                for (int m = 0; m < 4; ++m)
#pragma unroll
                    for (int n = 0; n < 2; ++n) acc[a][b][m][n] = (f32x4){0.f, 0.f, 0.f, 0.f};
        cur = nxt; cA = nA; cB = nB; ++ui;
    }
    PG8_WAIT_V(0);
    if (wr == 0) PG8_BAR;
    PG8_BAR;
#undef PG8_SA
#undef PG8_SB
#undef PG8_STAGE
#undef PG8_LDA
#undef PG8_LDB
#undef PG8_MMA
#undef PG8_WAIT_V
#undef PG8_WAIT_L
#undef PG8_BAR
#undef PG8_SCHED
}
}
using pg8::Unit;
typedef f32x4 AccT[2][2][4][2];

__device__ __forceinline__ u32x4 pack8(f32x4 a, f32x4 b) { u32x4 w; w.x = cvt_pk_bf16(a[0], a[1]); w.y = cvt_pk_bf16(a[2], a[3]); w.z = cvt_pk_bf16(b[0], b[1]); w.w = cvt_pk_bf16(b[2], b[3]); return w; }
__device__ __forceinline__ u32x2 pack4(f32x4 a) { u32x2 w; w.x = cvt_pk_bf16(a[0], a[1]); w.y = cvt_pk_bf16(a[2], a[3]); return w; }
__device__ __forceinline__ void unpack8(u32x4 w, f32x4& a, f32x4& b) {
    a[0] = __uint_as_float(w.x << 16); a[1] = __uint_as_float(w.x & 0xffff0000u); a[2] = __uint_as_float(w.y << 16); a[3] = __uint_as_float(w.y & 0xffff0000u);
    b[0] = __uint_as_float(w.z << 16); b[1] = __uint_as_float(w.z & 0xffff0000u); b[2] = __uint_as_float(w.w << 16); b[3] = __uint_as_float(w.w & 0xffff0000u);
}

struct EpiIn {
    static constexpr bool PERM = true;
    float* psm; float* lx; bf16_t* gg; bf16_t* sg; bf16_t* g2;
    __device__ __forceinline__ void operator()(const AccT& acc, const Unit& u, int wr, int wc, int fr, int fq) const {
        const int row0 = u.pm * 256 + wr * 64 + fr, colb = u.pn * 256 + wc * 32 + 8 * fq;
#pragma unroll
        for (int ai = 0; ai < 2; ++ai)
#pragma unroll
            for (int m = 0; m < 4; ++m) {
                const size_t row = (size_t)(row0 + ai * 128 + m * 16);
#pragma unroll
                for (int bj = 0; bj < 2; ++bj) {
                    const int col = colb + bj * 128; f32x4 v0 = acc[ai][bj][m][0], v1 = acc[ai][bj][m][1];
                    if (u.pn < 3) { float* q = psm + row * 768 + col; *(f32x4*)q = v0; *(f32x4*)(q + 4) = v1; }
                    else if (u.pn < 7) { float* q = lx + row * 1024 + (col - 768); *(f32x4*)q = v0; *(f32x4*)(q + 4) = v1; }
                    else if (u.pn < 11) {
#pragma unroll
                        for (int j = 0; j < 4; ++j) { v0[j] = gelu_tanh(v0[j]); v1[j] = gelu_tanh(v1[j]); }
                        *(u32x4*)(gg + row * 1024 + (col - 1792)) = pack8(v0, v1); }
                    else {
#pragma unroll
                        for (int j = 0; j < 4; ++j) { v0[j] = fast_sigmoid(v0[j]); v1[j] = fast_sigmoid(v1[j]); }
                        *(u32x4*)(sg + row * 2048 + (col - 2816)) = pack8(v0, v1);
                        if (u.pn >= 15) *(u32x4*)(g2 + row * 1024 + (col - 3840)) = pack8(v0, v1); }
                }
            }
    }
};
struct EpiQ {
    static constexpr bool PERM = false;
    bf16_t* q; const float* ropec; const float* ropes;
    __device__ __forceinline__ void operator()(const AccT& acc, const Unit& u, int wr, int wc, int fr, int fq) const {
        const int row0 = u.pm * 256 + wr * 64 + fr;
#pragma unroll
        for (int ai = 0; ai < 2; ++ai)
#pragma unroll
            for (int m = 0; m < 4; ++m) {
                const int row = row0 + ai * 128 + m * 16; const bool lat = row >= MP; const int pos = (row - MP) & 1023;
#pragma unroll
                for (int bj = 0; bj < 2; ++bj) {
                    const int base = u.pn * 256 + bj * 128 + wc * 32; const bool rope = lat && (((base >> 5) % 3) == 2);
                    f32x4 v0 = acc[ai][bj][m][0], v1 = acc[ai][bj][m][1];
                    if (rope) { const f32x4 cs = *(const f32x4*)(ropec + pos * 16 + 4 * fq), sn = *(const f32x4*)(ropes + pos * 16 + 4 * fq);
                        const f32x4 o0 = v0 * cs - v1 * sn, o1 = v0 * sn + v1 * cs; v0 = o0; v1 = o1; }
                    v0 *= QSCALE; v1 *= QSCALE;
                    bf16_t* dst = q + (size_t)row * 768 + base + 4 * fq;
                    *(u32x2*)dst = pack4(v0); *(u32x2*)(dst + 16) = pack4(v1);
                }
                asm volatile("" ::: "memory");
            }
    }
};
struct EpiBf16 {
    static constexpr bool PERM = true;
    bf16_t* o; int ldc;
    __device__ __forceinline__ void operator()(const AccT& acc, const Unit& u, int wr, int wc, int fr, int fq) const {
        const int row0 = u.pm * 256 + wr * 64 + fr, colb = u.pn * 256 + wc * 32 + 8 * fq;
#pragma unroll
        for (int ai = 0; ai < 2; ++ai)
#pragma unroll
            for (int m = 0; m < 4; ++m) {
                const size_t row = (size_t)(row0 + ai * 128 + m * 16);
#pragma unroll
                for (int bj = 0; bj < 2; ++bj) *(u32x4*)(o + row * ldc + colb + bj * 128) = pack8(acc[ai][bj][m][0], acc[ai][bj][m][1]);
            }
    }
};
struct EpiF32 {
    static constexpr bool PERM = true;
    float* o; int ldc;
    __device__ __forceinline__ void operator()(const AccT& acc, const Unit& u, int wr, int wc, int fr, int fq) const {
        const int row0 = u.pm * 256 + wr * 64 + fr, colb = u.pn * 256 + wc * 32 + 8 * fq;
#pragma unroll
        for (int ai = 0; ai < 2; ++ai)
#pragma unroll
            for (int m = 0; m < 4; ++m) {
                const size_t row = (size_t)(row0 + ai * 128 + m * 16);
#pragma unroll
                for (int bj = 0; bj < 2; ++bj) { float* q = o + row * ldc + colb + bj * 128; *(f32x4*)q = acc[ai][bj][m][0]; *(f32x4*)(q + 4) = acc[ai][bj][m][1]; }
            }
    }
};
struct EpiMla {
    static constexpr bool PERM = true;
    float* z1; const bf16_t* sg;
    __device__ __forceinline__ void operator()(const AccT& acc, const Unit& u, int wr, int wc, int fr, int fq) const {
        const int row0 = u.pm * 256 + wr * 64 + fr, colb = u.pn * 256 + wc * 32 + 8 * fq;
#pragma unroll
        for (int ai = 0; ai < 2; ++ai)
#pragma unroll
            for (int m = 0; m < 4; ++m) {
                const size_t row = (size_t)(row0 + ai * 128 + m * 16);
#pragma unroll
                for (int bj = 0; bj < 2; ++bj) { const int col = colb + bj * 128; f32x4 g0, g1; unpack8(*(const u32x4*)(sg + row * 2048 + col), g0, g1);
                    float* q = z1 + row * 1024 + col; *(f32x4*)q = acc[ai][bj][m][0] * g0 * ZSCALE; *(f32x4*)(q + 4) = acc[ai][bj][m][1] * g1 * ZSCALE; }
                asm volatile("" ::: "memory");
            }
    }
};
struct EpiLru {
    static constexpr bool PERM = true;
    const float* z1; const bf16_t* sg; bf16_t* z; const bf16_t* g2;
    __device__ __forceinline__ void operator()(const AccT& acc, const Unit& u, int wr, int wc, int fr, int fq) const {
        const int row0 = u.pm * 256 + wr * 64 + fr, colb = u.pn * 256 + wc * 32 + 8 * fq;
#pragma unroll
        for (int ai = 0; ai < 2; ++ai)
#pragma unroll
            for (int m = 0; m < 4; ++m) {
                const size_t row = (size_t)(row0 + ai * 128 + m * 16);
#pragma unroll
                for (int bj = 0; bj < 2; ++bj) { const int col = colb + bj * 128; f32x4 g0, g1; unpack8(*(const u32x4*)(g2 + row * 1024 + col), g0, g1);
                    const float* q = z1 + row * 1024 + col; const f32x4 a0 = *(const f32x4*)q + acc[ai][bj][m][0] * GLVAL(g0) * LSCALE, a1 = *(const f32x4*)(q + 4) + acc[ai][bj][m][1] * GLVAL(g1) * LSCALE;
                    *(u32x4*)(z + row * 1024 + col) = pack8(a0, a1); }
                asm volatile("" ::: "memory");
            }
    }
};
struct EpiFfi {
    static constexpr bool PERM = false;
    bf16_t* hid;
    __device__ __forceinline__ void operator()(const AccT& acc, const Unit& u, int wr, int wc, int fr, int fq) const {
        const int row0 = u.pm * 256 + wr * 64 + fr;
#pragma unroll
        for (int ai = 0; ai < 2; ++ai)
#pragma unroll
            for (int m = 0; m < 4; ++m) {
                const size_t row = (size_t)(row0 + ai * 128 + m * 16);
#pragma unroll
                for (int bj = 0; bj < 2; ++bj) { const int hc = ((u.pn * 256 + bj * 128 + wc * 32) >> 1) + 4 * fq; const f32x4 gv = acc[ai][bj][m][0], uv = acc[ai][bj][m][1]; f32x4 h;
#pragma unroll
                    for (int j = 0; j < 4; ++j) h[j] = gv[j] * fast_sigmoid(gv[j]) * uv[j];
                    *(u32x2*)(hid + row * FF + hc) = pack4(h); }
            }
    }
};

__device__ __forceinline__ int map_row(int mode, int n) {
    if (mode == 1) return n < 672 ? n : n + 96;
    if (mode == 2) { const int up = n >= FF, j = up ? n - FF : n; return (j >> 4) * 32 + (j & 15) + (up ? 16 : 0); }
    if (mode == 3) { const int h = n >> 7, r = n & 127; return r < 64 ? h * 64 + r : 512 + h * 64 + (r - 64); }
    return n;
}
__device__ __forceinline__ void conv_tile(const float* src, int ld, int K, int k0, int n0, bf16_t* dst, int mode, LAS float* tile) {
    const int tid = otid();
    __syncthreads();
#pragma unroll
    for (int i = 0; i < 2; ++i) { const int kk = (tid >> 3) + 64 * i, c4 = (tid & 7) * 4; const f32x4 v = *(const f32x4*)(src + (size_t)(k0 + kk) * ld + n0 + c4);
        tile[kk * 33 + c4] = v[0]; tile[kk * 33 + c4 + 1] = v[1]; tile[kk * 33 + c4 + 2] = v[2]; tile[kk * 33 + c4 + 3] = v[3]; }
    __syncthreads();
    const int n = tid >> 4, k8 = (tid & 15) * 8; f32x4 a, b;
#pragma unroll
    for (int j = 0; j < 4; ++j) { a[j] = tile[(k8 + j) * 33 + n]; b[j] = tile[(k8 + 4 + j) * 33 + n]; }
    *(u32x4*)(dst + (size_t)map_row(mode, n0 + n) * K + k0 + k8) = pack8(a, b);
}
constexpr int CONV_ITEMS = 4208;
__device__ __forceinline__ void conv_item(const Params& p, unsigned char* ws, int l, int idx, LAS float* tile) {
    const int zz = ozero();
    int inidx, K, N, mode = 0; size_t soff, doff;
    if (idx < 1192) { inidx = I_WIN; soff = (size_t)l * 1024 * 4768; doff = WS_WIN; K = 1024; N = 4768; mode = 1; }
    else if ((idx -= 1192) < 1408) { inidx = I_WFFI; soff = (size_t)l * 1024 * 5632; doff = WS_WFFI; K = 1024; N = 5632; mode = 2; }
    else if ((idx -= 1408) < 704) { inidx = I_WFFO; soff = (size_t)l * 2816 * 1024; doff = WS_WFFO; K = 2816; N = 1024; }
    else if ((idx -= 704) < 256) { inidx = I_WOUT; soff = (size_t)l * 1024 * 1024; doff = WS_WOUT; K = 1024; N = 1024; }
    else if ((idx -= 256) < 256) { inidx = I_WOLRU; soff = (size_t)l * 1024 * 1024; doff = WS_WOLRU; K = 1024; N = 1024; }
    else if ((idx -= 256) < 128) { inidx = I_WOMLA; soff = (size_t)l * 512 * 1024; doff = WS_WOMLA; K = 512; N = 1024; }
    else if ((idx -= 128) < 72) { inidx = I_WQUP; soff = (size_t)l * 384 * 768; doff = WS_WQ; K = 384; N = 768; }
    else if ((idx -= 72) < 64) { inidx = I_WKVUP; soff = (size_t)l * 256 * 1024; doff = WS_WKV; K = 256; N = 1024; mode = 3; }
    else { idx -= 64; const int mat = idx >> 2, ig = mat >> 4, dir = (mat >> 3) & 1, n = mat & 7;
        inidx = ig ? I_WIG : I_WRG; soff = (size_t)((l * 2 + dir) * 8 + n) * 16384; doff = WS_WG + (size_t)((dir * 8 + n) * 256 + ig * 128) * 128 * 2; K = 128; N = 128; idx &= 3; }
    const float* src = p.in[zz + inidx] + soff; bf16_t* dst = (bf16_t*)(ws + doff);
    const int nk = K / 128, kt = idx % nk, ntile = idx / nk;
    conv_tile(src, N, K, kt * 128, ntile * 32, dst, mode, tile);
}
__device__ __forceinline__ void modv_phase(const Params& p, unsigned char* ws, LAS float* lds) {
    const int zz = ozero();
    LAS float* sc = lds + 128 * 33;
    LAS float* red = sc + 5 * 1024;
    const int tid = otid();
    __syncthreads();
    for (int i = tid; i < 5 * 1024; i += NTHREADS) { const float c = i < 1024 ? p.in[zz + I_CCTX][i] : p.in[zz + I_C][i - 1024]; sc[i] = c / (1.0f + __expf(-c)); }
    __syncthreads();
    float* modv = (float*)(ws + WS_MODV); const int bid = obid(), G = ogrid();
    const int col = tid & 31, kg = tid >> 5;
    for (int it = bid; it < 384; it += G) {
        const int l = it / 192, j0 = (it % 192) * 32;
        const float* w = p.in[zz + I_WMOD] + (size_t)l * 1024 * 6144 + j0 + col;
        float a0 = 0.f, a1 = 0.f, a2 = 0.f, a3 = 0.f, a4 = 0.f;
#pragma unroll 8
        for (int k = kg * 64; k < kg * 64 + 64; ++k) { const float wv = w[(size_t)k * 6144]; a0 += sc[k] * wv; a1 += sc[1024 + k] * wv; a2 += sc[2048 + k] * wv; a3 += sc[3072 + k] * wv; a4 += sc[4096 + k] * wv; }
        red[(kg * 5 + 0) * 32 + col] = a0; red[(kg * 5 + 1) * 32 + col] = a1; red[(kg * 5 + 2) * 32 + col] = a2; red[(kg * 5 + 3) * 32 + col] = a3; red[(kg * 5 + 4) * 32 + col] = a4;
        __syncthreads();
        if (tid < 160) { const int v = tid >> 5, c = tid & 31; float s = p.in[zz + I_BMOD][l * 6144 + j0 + c];
#pragma unroll
            for (int g = 0; g < 16; ++g) s += red[(g * 5 + v) * 32 + c];
            modv[(size_t)(l * 5 + v) * 6144 + j0 + c] = s; }
        __syncthreads();
    }
}
__device__ __forceinline__ void rope_table(const Params& p, unsigned char* ws) {
    const int zz = ozero();
    float* rc = (float*)(ws + WS_ROPE); float* rs = rc + 1024 * 16;
    const int G = ogrid(); for (int i = obid() * NTHREADS + otid(); i < 1024 * 16; i += G * NTHREADS) {
        const int pos = i >> 4, f = i & 15; const float posv = (float)(f < 8 ? (pos >> 6) : (pos & 63));
        const float inv = exp2f(-(float)(f & 7) * (13.287712379549449f / 8.0f));
        const float rev = posv * inv * 0.15915494309189535f;
        rc[i] = __builtin_amdgcn_cosf(rev); rs[i] = __builtin_amdgcn_sinf(rev);
    }
}

template <bool HAS_Y, bool DO_H>
__device__ __forceinline__ void norm_phase(const Params& p, unsigned char* ws, const float* xp, const float* xs, const float* Y, const float* gA, int gate_off, const float* modA,
                                           const float* gB, int sh_off, int sc_off, const float* modB) {
    const int zz = ozero();
    const int tid = otid(), wid = tid >> 6, lane = tid & 63; const int bid = obid(), G = ogrid();
    bf16_t* hbf = (bf16_t*)(ws + WS_HBF);
    for (int row = bid * 8 + wid; row < MT; row += G * 8) {
        const int mv = row < MP ? 0 : 1 + ((row - MP) >> 10);
        const float* xin = row < MP ? xp + (size_t)row * D : xs + (size_t)(row - MP) * D;
        f32x4 x[4];
#pragma unroll
        for (int i = 0; i < 4; ++i) x[i] = *(const f32x4*)(xin + i * 256 + lane * 4);
        if (HAS_Y) {
            f32x4 y[4]; float ss = 0.f;
#pragma unroll
            for (int i = 0; i < 4; ++i) { y[i] = *(const f32x4*)(Y + (size_t)row * D + i * 256 + lane * 4); ss += y[i][0] * y[i][0] + y[i][1] * y[i][1] + y[i][2] * y[i][2] + y[i][3] * y[i][3]; }
            ss = wave_sum(ss, lane); const float rstd = rsqrtf(ss * (1.0f / D) + EPS);
            const float* mg = modA + (size_t)mv * 6144 + gate_off;
#pragma unroll
            for (int i = 0; i < 4; ++i) { const f32x4 g = *(const f32x4*)(gA + i * 256 + lane * 4), gt = *(const f32x4*)(mg + i * 256 + lane * 4);
                x[i] = x[i] + gt * (y[i] * rstd * g) * (gate_off == 2048 ? MSCALE : FSCALE); *(f32x4*)((p.out + zz) + (size_t)row * D + i * 256 + lane * 4) = DO_H ? x[i] : x[i] * (row < MP ? (ZMASK(row, i * 256 + lane * 4) ? 0.0f : OS0) : OS1); }
        }
        if (DO_H) {
            float ss = 0.f;
#pragma unroll
            for (int i = 0; i < 4; ++i) ss += x[i][0] * x[i][0] + x[i][1] * x[i][1] + x[i][2] * x[i][2] + x[i][3] * x[i][3];
            ss = wave_sum(ss, lane); const float rstd = rsqrtf(ss * (1.0f / D) + EPS);
            const float* msh = modB + (size_t)mv * 6144 + sh_off; const float* msc = modB + (size_t)mv * 6144 + sc_off;
#pragma unroll
            for (int i = 0; i < 4; ++i) { const f32x4 g = *(const f32x4*)(gB + i * 256 + lane * 4), sh = *(const f32x4*)(msh + i * 256 + lane * 4), sc = *(const f32x4*)(msc + i * 256 + lane * 4);
                const f32x4 h = (x[i] * rstd * g) * (sc + 1.0f) + sh; *(u32x2*)(hbf + (size_t)row * D + i * 256 + lane * 4) = pack4(h); }
        }
    }
}

__device__ __forceinline__ void postproj_phase(const Params& p, unsigned char* ws, int l) {
    const int zz = ozero();
    const int tid = otid(), wid = tid >> 6, lane = tid & 63; const int bid = obid(), G = ogrid();
    const float* psm = (const float*)(ws + WS_PSM);
    bf16_t* qn = (bf16_t*)(ws + WS_QN); bf16_t* keys = (bf16_t*)(ws + WS_KEYS); bf16_t* krb = (bf16_t*)(ws + WS_KRB);
    const float* ropec = (const float*)(ws + WS_ROPE); const float* ropes = ropec + 1024 * 16;
    const float* gq = p.in[zz + I_GQ] + l * 384; const float* gkv = p.in[zz + I_GKV] + l * 256;
    for (int t = bid * 8 + wid; t < NKEY; t += G * 8) {
        if (t < MT) {
            const float* pr = psm + (size_t)t * 768;
            f32x2 q[3]; float ss = 0.f;
#pragma unroll
            for (int i = 0; i < 3; ++i) { q[i] = *(const f32x2*)(pr + i * 128 + lane * 2); ss += q[i][0] * q[i][0] + q[i][1] * q[i][1]; }
            ss = wave_sum(ss, lane); float rstd = rsqrtf(ss * (1.0f / 384.0f) + EPS);
#pragma unroll
            for (int i = 0; i < 3; ++i) { const f32x2 g = *(const f32x2*)(gq + i * 128 + lane * 2); *(unsigned*)(qn + (size_t)t * 384 + i * 128 + lane * 2) = cvt_pk_bf16(q[i][0] * rstd * g[0], q[i][1] * rstd * g[1]); }
            f32x4 kv = *(const f32x4*)(pr + 384 + lane * 4);
            ss = wave_sum(kv[0] * kv[0] + kv[1] * kv[1] + kv[2] * kv[2] + kv[3] * kv[3], lane); rstd = rsqrtf(ss * (1.0f / 256.0f) + EPS);
            const f32x4 ckv = kv * rstd * *(const f32x4*)(gkv + lane * 4);
            const int kr = keyrow_of(t);
            *(u32x2*)(keys + (size_t)kr * 256 + lane * 4) = pack4(ckv);
            const int s = t >> 8, pp = t & 255;
            if (t < MP) *(f32x4*)((p.out + zz) + OFF_CKV + ((size_t)(s * 2 + l) * 256 + pp) * 256 + lane * 4) = ckv * OS2;
            if (lane < 16) {
                float x1 = pr[640 + lane], x2 = pr[656 + lane];
                if (t >= MP) { const int pos = (t - MP) & 1023; const float cs = ropec[pos * 16 + lane], sn = ropes[pos * 16 + lane]; const float o1 = x1 * cs - x2 * sn, o2 = x1 * sn + x2 * cs; x1 = o1; x2 = o2; }
                krb[(size_t)kr * 32 + lane] = f2bf(x1); krb[(size_t)kr * 32 + 16 + lane] = f2bf(x2);
                if (t < MP) { float* o = (p.out + zz) + OFF_KR + ((size_t)(s * 2 + l) * 256 + pp) * 32; o[lane] = x1 * OS3; o[16 + lane] = x2 * OS3; }
            }
        } else {
            const int j = t - MT, b = j >> 8, jj = j & 255, kr = MP + b * 1280 + 1024 + jj;
            const f32x4 v = *(const f32x4*)(p.in[zz + I_CCKV] + ((size_t)(b * 2 + l) * 256 + jj) * 256 + lane * 4);
            *(u32x2*)(keys + (size_t)kr * 256 + lane * 4) = pack4(v);
            if (lane < 8) { const f32x4 w = *(const f32x4*)(p.in[zz + I_CKR] + ((size_t)(b * 2 + l) * 256 + jj) * 32 + lane * 4); *(u32x2*)(krb + (size_t)kr * 32 + lane * 4) = pack4(w); }
        }
    }
}

__device__ __forceinline__ void attn_phase(const Params& p, unsigned char* ws, LAS unsigned char* lds) {
    const int zz = ozero();
    const bf16_t* Qb = (const bf16_t*)(ws + WS_QB); const bf16_t* Kn = (const bf16_t*)(ws + WS_KN); const bf16_t* KR = (const bf16_t*)(ws + WS_KRB);
    const bf16_t* Vt = (const bf16_t*)(ws + WS_VT); bf16_t* AO = (bf16_t*)(ws + WS_AO);
    LAS bf16_t* Ks = (LAS bf16_t*)lds;
    LAS bf16_t* Vs = (LAS bf16_t*)(lds + 64 * 208);
    const int tid = otid(), wid = tid >> 6, lane = tid & 63, l15 = lane & 15, quad = lane >> 4; const int bid = obid(), G = ogrid();
    const bool split = (G == 256);
    for (int it = split ? (bid < 32 ? 768 : bid - 32) : bid; it < 768; it += split ? 224 : G) {
        int tq, kb, nk, h;
        if (it < 256) { const int b = it >> 6; h = (it >> 3) & 7; tq = MP + b * 1024 + (it & 7) * 128; kb = MP + b * 1280; nk = 1280; }
        else { const int j = it - 256, s = j >> 4; h = (j >> 1) & 7; tq = s * 256 + (j & 1) * 128; kb = s * 256; nk = 256; }
        const int qrow = tq + wid * 16 + l15;
        bf16x8 qf[3];
#pragma unroll
        for (int ks = 0; ks < 3; ++ks) qf[ks] = *(const bf16x8*)(Qb + (size_t)qrow * 768 + h * 96 + ks * 32 + quad * 8);
        f32x4 o[4];
#pragma unroll
        for (int i = 0; i < 4; ++i) o[i] = (f32x4){0.f, 0.f, 0.f, 0.f};
        float mrun = -1e30f, lsum = 0.f;
        for (int k0 = 0; k0 < nk; k0 += 64) {
            __syncthreads();
            for (int c = tid; c < 768; c += NTHREADS) { const int r = c / 12, cc = c % 12;
                const bf16_t* src = cc < 8 ? Kn + (size_t)(kb + k0 + r) * 512 + h * 64 + cc * 8 : KR + (size_t)(kb + k0 + r) * 32 + (cc - 8) * 8;
                *(LAS u32x4*)(Ks + r * 104 + cc * 8) = *(const u32x4*)src; }
            { const int r = tid >> 3, cc = tid & 7; *(LAS u32x4*)(Vs + r * 72 + cc * 8) = *(const u32x4*)(Vt + (size_t)(h * 64 + r) * NKEY + kb + k0 + cc * 8); }
            __syncthreads();
            f32x4 s[4];
#pragma unroll
            for (int js = 0; js < 4; ++js) { s[js] = (f32x4){0.f, 0.f, 0.f, 0.f};
#pragma unroll
                for (int ks = 0; ks < 3; ++ks) { const bf16x8 a = *(const LAS bf16x8*)(Ks + (js * 16 + l15) * 104 + ks * 32 + quad * 8); s[js] = __builtin_amdgcn_mfma_f32_16x16x32_bf16(a, qf[ks], s[js], 0, 0, 0); } }
            float mx = s[0][0];
#pragma unroll
            for (int js = 0; js < 4; ++js)
#pragma unroll
                for (int j = 0; j < 4; ++j) mx = fmaxf(mx, s[js][j]);
            mx = fmaxf(mx, shfl_idx(mx, lane ^ 16)); mx = fmaxf(mx, shfl_idx(mx, lane ^ 32));
            const float mnew = fmaxf(mrun, mx), alpha = __builtin_amdgcn_exp2f(mrun - mnew); mrun = mnew;
            float psum = 0.f;
#pragma unroll
            for (int js = 0; js < 4; ++js)
#pragma unroll
                for (int j = 0; j < 4; ++j) { s[js][j] = __builtin_amdgcn_exp2f(s[js][j] - mnew); psum += s[js][j]; }
            lsum = lsum * alpha + psum;
#pragma unroll
            for (int i = 0; i < 4; ++i) o[i] *= alpha;
#pragma unroll
            for (int kk = 0; kk < 2; ++kk) {
                const u32x4 pw = pack8(s[2 * kk], s[2 * kk + 1]); bf16x8 pf; __builtin_memcpy(&pf, &pw, 16);
#pragma unroll
                for (int dv = 0; dv < 4; ++dv) {
                    const LAS bf16_t* vp = Vs + (dv * 16 + l15) * 72 + kk * 32 + quad * 4;
                    u32x4 vw; const u32x2 v0 = *(const LAS u32x2*)vp, v1 = *(const LAS u32x2*)(vp + 16); vw.x = v0.x; vw.y = v0.y; vw.z = v1.x; vw.w = v1.y;
                    bf16x8 va; __builtin_memcpy(&va, &vw, 16);
                    o[dv] = __builtin_amdgcn_mfma_f32_16x16x32_bf16(va, pf, o[dv], 0, 0, 0);
                }
            }
        }
        lsum += shfl_idx(lsum, lane ^ 16); lsum += shfl_idx(lsum, lane ^ 32);
        const float inv = 1.0f / lsum;
#pragma unroll
        for (int dv = 0; dv < 4; ++dv) *(u32x2*)(AO + (size_t)qrow * 512 + h * 64 + dv * 16 + quad * 4) = pack4(o[dv] * inv);
    }
}

template <int DIR>
__device__ __forceinline__ void scan_pass(const Params& p, unsigned char* ws, int l, int n, int tok0, int L, float h0, bool write_state, int state_idx, LAS unsigned char* lds) {
    const int zz = ozero();
    LAS float* xcf = (LAS float*)lds;
    LAS bf16_t* xcb = (LAS bf16_t*)(lds + 64 * 132 * 4);
    const int tid = otid(), wid = tid >> 6, lane = tid & 63, l15 = lane & 15, quad = lane >> 4;
    const int chl = wid * 16 + l15, ch = n * 128 + chl;
    const float* LXp = (const float*)(ws + WS_LX); bf16_t* HF = (bf16_t*)(ws + WS_SG) + 1024;   bf16_t* GG = (bf16_t*)(ws + WS_GG);
    const float lam = p.in[zz + I_LAM][(l * 2 + DIR) * 1024 + ch];
    const float nl = -lam, sp = fmaxf(nl, 0.f) + log1pf(__expf(-fabsf(nl)));
    const float cc = -8.0f * sp * LOG2E;
    const float br = p.in[zz + I_BRG][(l * 2 + DIR) * 1024 + ch], bi = p.in[zz + I_BIG][(l * 2 + DIR) * 1024 + ch];
    const bf16_t* wg = (const bf16_t*)(ws + WS_WG) + (size_t)((DIR * 8 + n) * 256) * 128;
    bf16x8 wrf[4], wif[4];
#pragma unroll
    for (int ks = 0; ks < 4; ++ks) { wrf[ks] = *(const bf16x8*)(wg + (size_t)chl * 128 + ks * 32 + quad * 8); wif[ks] = *(const bf16x8*)(wg + (size_t)(128 + chl) * 128 + ks * 32 + quad * 8); }
    const int c4 = (tid & 31) * 4, tg = tid >> 5;
    const float* cw = p.in[zz + I_CONVW] + (size_t)l * 4 * 1024 + n * 128 + c4;
    const f32x4 w0 = *(const f32x4*)cw, w1 = *(const f32x4*)(cw + 1024), w2 = *(const f32x4*)(cw + 2048), w3 = *(const f32x4*)(cw + 3072);
    const f32x4 cb = *(const f32x4*)(p.in[zz + I_CONVB] + l * 1024 + n * 128 + c4);
    float hin = h0;
    const int nchunk = L >> 6;
    for (int ci = 0; ci < nchunk; ++ci) {
        const int t0 = (DIR ? nchunk - 1 - ci : ci) * 64;
        __syncthreads();
        {
            f32x4 xr[7];
#pragma unroll
            for (int r = 0; r < 7; ++r) { const int tt = t0 + tg * 4 - 2 + r; xr[r] = (tt >= 0 && tt < L) ? *(const f32x4*)(LXp + (size_t)(tok0 + tt) * 1024 + n * 128 + c4) : (f32x4){0.f, 0.f, 0.f, 0.f}; }
#pragma unroll
            for (int j = 0; j < 4; ++j) { const f32x4 xc = cb + xr[j] * w0 + xr[j + 1] * w1 + xr[j + 2] * w2 + xr[j + 3] * w3;
                *(LAS f32x4*)(xcf + (tg * 4 + j) * 132 + c4) = xc; *(LAS u32x2*)(xcb + (tg * 4 + j) * 136 + c4) = pack4(xc); }
        }
        __syncthreads();
        typedef unsigned short us2 __attribute__((ext_vector_type(2)));
        us2 hg[4][4];
        if (DIR == 1) {
#pragma unroll
            for (int st = 0; st < 4; ++st)
#pragma unroll
                for (int j = 0; j < 4; ++j) { const size_t idx = (size_t)(tok0 + t0 + st * 16 + quad * 4 + j) * 1024 + ch; hg[st][j].x = HF[idx + (idx - ch)]; hg[st][j].y = GG[idx]; }
        }
        f32x4 rg[4], ig[4];
#pragma unroll
        for (int st = 0; st < 4; ++st) { rg[st] = (f32x4){0.f, 0.f, 0.f, 0.f}; ig[st] = (f32x4){0.f, 0.f, 0.f, 0.f};
#pragma unroll
            for (int ks = 0; ks < 4; ++ks) { const bf16x8 a = *(const LAS bf16x8*)(xcb + (st * 16 + l15) * 136 + ks * 32 + quad * 8);
                rg[st] = __builtin_amdgcn_mfma_f32_16x16x32_bf16(a, wrf[ks], rg[st], 0, 0, 0); ig[st] = __builtin_amdgcn_mfma_f32_16x16x32_bf16(a, wif[ks], ig[st], 0, 0, 0); } }
#pragma unroll
        for (int sti = 0; sti < 4; ++sti) {
            const int st = DIR ? 3 - sti : sti;
            float av[4], hv[4], pa[4];
#pragma unroll
            for (int j = 0; j < 4; ++j) { const float x = xcf[(st * 16 + quad * 4 + j) * 132 + chl];
                const float rr = fast_sigmoid(rg[st][j] + br), ii = fast_sigmoid(ig[st][j] + bi);
                const float a = __builtin_amdgcn_exp2f(cc * rr); av[j] = a; hv[j] = __builtin_amdgcn_sqrtf(fmaxf(1.0f - a * a, 0.f)) * ii * x; }
            float hl = 0.f, pr = 1.f;
#pragma unroll
            for (int s4 = 0; s4 < 4; ++s4) { const int j = DIR ? 3 - s4 : s4; hl = av[j] * hl + hv[j]; pr *= av[j]; hv[j] = hl; pa[j] = pr; }
            float Ar = 1.f, Hr = 0.f, Aex = 1.f, Hex = 0.f;
#pragma unroll
            for (int s4 = 0; s4 < 4; ++s4) { const int qq = DIR ? 3 - s4 : s4; const float Aq = shfl_idx(pr, qq * 16 + l15), Hq = shfl_idx(hl, qq * 16 + l15);
                if (qq == quad) { Aex = Ar; Hex = Hr; }
                Hr = Aq * Hr + Hq; Ar *= Aq; }
            const float cq = Aex * hin + Hex;
            hin = Ar * hin + Hr;
#pragma unroll
            for (int j = 0; j < 4; ++j) { const float hfin = hv[j] + pa[j] * cq; const size_t idx = (size_t)(tok0 + t0 + st * 16 + quad * 4 + j) * 1024 + ch;
                if (DIR == 0) HF[idx + (idx - ch)] = f2bf(hfin);
                else GG[idx] = f2bf((bf2f(hg[st][j].x) + hfin) * bf2f(hg[st][j].y)); }
        }
    }
    if (write_state && quad == 0) (p.out + zz)[(DIR ? OFF_LB : OFF_LF) + state_idx + ch] = hin * (DIR ? OS5 : OS4);
}
__device__ __forceinline__ void scan_phase(const Params& p, unsigned char* ws, int l, LAS unsigned char* lds) {
    const int zz = ozero();
    const int tid = otid(), l15 = tid & 15, wid = tid >> 6; const int bid = obid(), G = ogrid();
    for (int rr = 0; rr < 2; ++rr) {
        const int it = rr == 0 ? bid : ((G == 256 && bid >= 32 && bid < 64) ? 224 + bid : (G == 256 ? 288 : bid + G));
        if (it >= 288) break;
        int n, tok0, L, sidx; bool lat; float hf0 = 0.f, hb0 = 0.f;
        if (it < 32) { const int b = it >> 3; n = it & 7; tok0 = MP + b * 1024; L = 1024; lat = true; sidx = 0; const int ch = n * 128 + wid * 16 + l15;
            hf0 = p.in[zz + I_SF][(b * 2 + l) * 1024 + ch]; hb0 = p.in[zz + I_SB][(b * 2 + l) * 1024 + ch]; }
        else { const int j = it - 32, s = j >> 3; n = j & 7; tok0 = s * 256; L = 256; lat = false; sidx = (s * 2 + l) * 1024; }
        scan_pass<0>(p, ws, l, n, tok0, L, hf0, !lat, sidx, lds);
        scan_pass<1>(p, ws, l, n, tok0, L, hb0, !lat, sidx, lds);
    }
}

__device__ __forceinline__ unsigned char* opq_unused(unsigned char* x) { asm volatile("" : "+s"(x)); return x; }
__device__ __forceinline__ void grid_sync_all() {
    asm volatile("s_waitcnt vmcnt(0) lgkmcnt(0)" ::: "memory");
    __syncthreads();
    if (otid() < 64) { __builtin_amdgcn_fence(__ATOMIC_RELEASE, "agent"); asm volatile("s_waitcnt vmcnt(0) lgkmcnt(0)" ::: "memory"); }
    cg::this_grid().sync();
    if (otid() < 64) { __builtin_amdgcn_fence(__ATOMIC_ACQUIRE, "agent"); asm volatile("s_waitcnt vmcnt(0) lgkmcnt(0)" ::: "memory"); }
    __syncthreads();
}
__global__ void __launch_bounds__(NTHREADS) fwd_megakernel(Params p) {
    extern __shared__ __attribute__((aligned(16))) unsigned char smem[];
    LAS unsigned char* lds = (LAS unsigned char*)smem;
    int ph = 0; (void)ph; int phc = 0; (void)phc;
#if defined(STOP_AFTER)
#define PHASE_IF if (phc <= STOP_AFTER)
#define PHASE_END do { ++phc; grid_sync_all(); } while (0)
#elif ONE_LAUNCH
#define PHASE_IF
#define PHASE_END do { grid_sync_all(); } while (0)
#else
#define PHASE_IF if (__builtin_amdgcn_readfirstlane((int)(ph >= p.ph_lo && ph < p.ph_hi)))
#define PHASE_END do { ++ph; } while (0)
#endif

    PHASE_IF PHK(0) { const int zz = ozero(); unsigned char* ws = p.ws + zz; const int G = ogrid(), bid = obid(); (void)G; (void)bid; const float* modv = (const float*)(ws + WS_MODV); const float* modl = modv; (void)modl;
        rope_table(p, ws);
        modv_phase(p, ws, (LAS float*)lds);
        for (int i = bid; i < CONV_ITEMS; i += G) conv_item(p, ws, 0, i, (LAS float*)lds);
    }
    PHASE_END;
    PHASE_IF PHK(1) { const int zz = ozero(); unsigned char* ws = p.ws + zz; const int G = ogrid(), bid = obid(); (void)G; (void)bid; const float* modv = (const float*)(ws + WS_MODV); const float* modl = modv; (void)modl; norm_phase<false, true>(p, ws, p.in[zz + I_XP], p.in[zz + I_XS], nullptr, nullptr, 0, nullptr, p.in[zz + I_GPM], 0, 1024, modv); }
    PHASE_END;
#pragma unroll 1
    for (int l = 0; l < 2; ++l) {
        PHASE_IF PHK(2) { const int zz = ozero(); unsigned char* ws = p.ws + zz; const int G = ogrid(), bid = obid(); (void)G; (void)bid; const float* modv = (const float*)(ws + WS_MODV); const float* modl = modv + (size_t)l * 5 * 6144; (void)modl; pg8::Gemm g{(const bf16_t*)(ws + WS_HBF), (const bf16_t*)(ws + WS_WIN), MT, INCP, 1024}; pg8::StaticOrder S; S.init(MT, INCP, G, bid);
            EpiIn E{(float*)(ws + WS_PSM), (float*)(ws + WS_LX), (bf16_t*)(ws + WS_GG), (bf16_t*)(ws + WS_SG), (bf16_t*)(ws + WS_HF)}; pg8::gemm_phase(lds, g, S, E); }
        PHASE_END;
        PHASE_IF PHK(3) { const int zz = ozero(); unsigned char* ws = p.ws + zz; const int G = ogrid(), bid = obid(); (void)G; (void)bid; const float* modv = (const float*)(ws + WS_MODV); const float* modl = modv + (size_t)l * 5 * 6144; (void)modl; postproj_phase(p, ws, l); }
        PHASE_END;
        PHASE_IF PHK(4) { const int zz = ozero(); unsigned char* ws = p.ws + zz; const int G = ogrid(), bid = obid(); (void)G; (void)bid; const float* modv = (const float*)(ws + WS_MODV); const float* modl = modv + (size_t)l * 5 * 6144; (void)modl;
            { pg8::Gemm g{(const bf16_t*)(ws + WS_QN), (const bf16_t*)(ws + WS_WQ), MT, 768, 384}; pg8::StaticOrder S; S.init(MT, 768, G, bid);
              EpiQ E{(bf16_t*)(ws + WS_QB), (const float*)(ws + WS_ROPE), (const float*)(ws + WS_ROPE) + 1024 * 16}; pg8::gemm_phase(lds, g, S, E); }
            { pg8::Gemm g{(const bf16_t*)(ws + WS_KEYS), (const bf16_t*)(ws + WS_WKV), NKEY, 512, 256}; pg8::StaticOrder S; S.init(NKEY, 512, G, (bid + G - 144 % G) % G);
              EpiBf16 E{(bf16_t*)(ws + WS_KN), 512}; pg8::gemm_phase(lds, g, S, E); }
            { pg8::Gemm g{(const bf16_t*)(ws + WS_WKV) + (size_t)512 * 256, (const bf16_t*)(ws + WS_KEYS), 512, NKEY, 256}; pg8::StaticOrder S; S.init(512, NKEY, G, (bid + G - 248 % G) % G);
              EpiBf16 E{(bf16_t*)(ws + WS_VT), NKEY}; pg8::gemm_phase(lds, g, S, E); }
        }
        PHASE_END;
        PHASE_IF PHK(5) { const int zz = ozero(); unsigned char* ws = p.ws + zz; const int G = ogrid(), bid = obid(); (void)G; (void)bid; const float* modv = (const float*)(ws + WS_MODV); const float* modl = modv + (size_t)l * 5 * 6144; (void)modl; attn_phase(p, ws, lds); }
        PHASE_IF PHK(6) { const int zz = ozero(); unsigned char* ws = p.ws + zz; const int G = ogrid(), bid = obid(); (void)G; (void)bid; const float* modv = (const float*)(ws + WS_MODV); const float* modl = modv + (size_t)l * 5 * 6144; (void)modl; scan_phase(p, ws, l, lds); }
        PHASE_END;
        PHASE_IF PHK(7) { const int zz = ozero(); unsigned char* ws = p.ws + zz; const int G = ogrid(), bid = obid(); (void)G; (void)bid; const float* modv = (const float*)(ws + WS_MODV); const float* modl = modv + (size_t)l * 5 * 6144; (void)modl;
            { pg8::Gemm g{(const bf16_t*)(ws + WS_AO), (const bf16_t*)(ws + WS_WOMLA), MT, 1024, 512}; pg8::StaticOrder S; S.init(MT, 1024, G, bid);
              EpiMla E{(float*)(ws + WS_LX), (const bf16_t*)(ws + WS_SG)}; pg8::gemm_phase(lds, g, S, E); }
            { pg8::Gemm g{(const bf16_t*)(ws + WS_GG), (const bf16_t*)(ws + WS_WOLRU), MT, 1024, 1024}; pg8::StaticOrder S; S.init(MT, 1024, G, bid);
              EpiLru E{(const float*)(ws + WS_LX), (const bf16_t*)(ws + WS_SG), (bf16_t*)(ws + WS_Z), (const bf16_t*)(ws + WS_HF)}; pg8::gemm_phase(lds, g, S, E); }
        }
        PHASE_END;
        PHASE_IF PHK(8) { const int zz = ozero(); unsigned char* ws = p.ws + zz; const int G = ogrid(), bid = obid(); (void)G; (void)bid; const float* modv = (const float*)(ws + WS_MODV); const float* modl = modv + (size_t)l * 5 * 6144; (void)modl; pg8::Gemm g{(const bf16_t*)(ws + WS_Z), (const bf16_t*)(ws + WS_WOUT), MT, 1024, 1024}; pg8::StaticOrder S; S.init(MT, 1024, G, bid);
            EpiF32 E{(float*)(ws + WS_LX), 1024}; pg8::gemm_phase(lds, g, S, E); }
        PHASE_END;
        PHASE_IF PHK(9) { const int zz = ozero(); unsigned char* ws = p.ws + zz; const int G = ogrid(), bid = obid(); (void)G; (void)bid; const float* modv = (const float*)(ws + WS_MODV); const float* modl = modv + (size_t)l * 5 * 6144; (void)modl; const float* xp = l == 0 ? p.in[zz + I_XP] : (p.out + zz); const float* xs = l == 0 ? p.in[zz + I_XS] : (p.out + zz) + (size_t)MP * D; norm_phase<true, true>(p, ws, xp, xs, (const float*)(ws + WS_LX), p.in[zz + I_GQM] + l * D, 2048, modl, p.in[zz + I_GPF] + l * D, 3072, 4096, modl); }
        PHASE_END;
        PHASE_IF PHK(10) { const int zz = ozero(); unsigned char* ws = p.ws + zz; const int G = ogrid(), bid = obid(); (void)G; (void)bid; const float* modv = (const float*)(ws + WS_MODV); const float* modl = modv + (size_t)l * 5 * 6144; (void)modl; pg8::Gemm g{(const bf16_t*)(ws + WS_HBF), (const bf16_t*)(ws + WS_WFFI), MT, 5632, 1024}; pg8::StaticOrder S; S.init(MT, 5632, G, bid);
            EpiFfi E{(bf16_t*)(ws + WS_HID)}; pg8::gemm_phase(lds, g, S, E); }
        PHASE_END;
        PHASE_IF PHK(11) { const int zz = ozero(); unsigned char* ws = p.ws + zz; const int G = ogrid(), bid = obid(); (void)G; (void)bid; const float* modv = (const float*)(ws + WS_MODV); const float* modl = modv + (size_t)l * 5 * 6144; (void)modl; pg8::Gemm g{(const bf16_t*)(ws + WS_HID), (const bf16_t*)(ws + WS_WFFO), MT, 1024, FF}; pg8::StaticOrder S; S.init(MT, 1024, G, bid);
            EpiF32 E{(float*)(ws + WS_LX), 1024}; pg8::gemm_phase(lds, g, S, E); }
        PHASE_END;
        PHASE_IF PHK(12) { const int zz = ozero(); unsigned char* ws = p.ws + zz; const int G = ogrid(), bid = obid(); (void)G; (void)bid; const float* modv = (const float*)(ws + WS_MODV); const float* modl = modv + (size_t)l * 5 * 6144; (void)modl;
            if (l == 0) {
                norm_phase<true, true>(p, ws, (p.out + zz), (p.out + zz) + (size_t)MP * D, (const float*)(ws + WS_LX), p.in[zz + I_GQF], 5120, modl, p.in[zz + I_GPM] + D, 0, 1024, modv + (size_t)5 * 6144);
                for (int i = bid; i < CONV_ITEMS; i += G) conv_item(p, ws, 1, i, (LAS float*)lds);
            } else {
                norm_phase<true, false>(p, ws, (p.out + zz), (p.out + zz) + (size_t)MP * D, (const float*)(ws + WS_LX), p.in[zz + I_GQF] + D, 5120, modl, nullptr, 0, 0, nullptr);
            }
        }
#if ONE_LAUNCH && !defined(STOP_AFTER)
        if (l == 0) grid_sync_all();
#else
        PHASE_END;
#endif
    }
#if defined(STOP_AFTER)
    {
        const int tid = otid(), bid = obid(), G = ogrid(); const unsigned* wsu = (const unsigned*)p.ws; float* out = p.out;
        for (int i = bid * NTHREADS + tid; i < 17432576; i += G * NTHREADS) { float a = 0.f;
#pragma unroll
            for (int j = 0; j < 4; ++j) { const size_t idx = (size_t)i + (size_t)j * 17432576; if (idx * 4 < WS_END) { const unsigned u = wsu[idx]; a += (float)(u & 0xffu) + (float)((u >> 16) & 0xffu); } }
            out[i] = a; }
    }
#endif
}
constexpr int NPHASES = 2 + 11 * 2;

extern "C" void kernel_launch(void* const* d_in, const int* in_sizes, int n_in, void* d_out, int out_size, void* d_ws, size_t ws_size, hipStream_t stream) {
    static int grid = 0;
    if (grid == 0) {
        if (n_in != 31 || ws_size < WS_END) { fprintf(stderr, "kernel_launch: need 31 inputs and %zu bytes of workspace (got %d, %zu)\n", (size_t)WS_END, n_in, ws_size); grid = -1; return; }
        if (hipFuncSetAttribute((const void*)fwd_megakernel, hipFuncAttributeMaxDynamicSharedMemorySize, LDS_BYTES) != hipSuccess) { fprintf(stderr, "kernel_launch: hipFuncSetAttribute failed\n"); grid = -1; return; }
        int dev = 0, cus = 0, per_cu = 0;
        hipGetDevice(&dev); hipDeviceGetAttribute(&cus, hipDeviceAttributeMultiprocessorCount, dev);
        hipOccupancyMaxActiveBlocksPerMultiprocessor(&per_cu, (const void*)fwd_megakernel, NTHREADS, LDS_BYTES);
        if (per_cu < 1) { fprintf(stderr, "kernel_launch: occupancy query says %d blocks/CU\n", per_cu); per_cu = 1; }
        (void)hipGetLastError();
        grid = cus;
    }
    if (grid < 0) return;
    Params p{};
    for (int i = 0; i < 31; ++i) p.in[i] = (const float*)d_in[i];
    p.out = (float*)d_out; p.ws = (unsigned char*)d_ws;
#if ONE_LAUNCH
    p.ph_lo = 0; p.ph_hi = NPHASES; p.coop = 1;
    void* args[] = {&p};
    hipError_t e = hipLaunchCooperativeKernel((const void*)fwd_megakernel, dim3(grid), dim3(NTHREADS), args, LDS_BYTES, stream);
    if (e != hipSuccess) fprintf(stderr, "cooperative launch failed: %s (grid %d)\n", hipGetErrorString(e), grid);
#else
    for (int ph = 0; ph < NPHASES; ++ph) {
        p.ph_lo = ph; p.ph_hi = ph + 1; p.coop = 0;
        hipLaunchKernelGGL(fwd_megakernel, dim3(grid), dim3(NTHREADS), LDS_BYTES, stream, p);
    }
#endif
}
```

```cpp
#include <hip/hip_runtime.h>
#include <hip/hip_cooperative_groups.h>
#include <cstdio>
namespace cg = cooperative_groups;

#ifndef ONE_LAUNCH
#define ONE_LAUNCH 1
#endif

#ifndef PHMASK
#define PHMASK 0xffff
#endif
#define PHK(k) if constexpr (((PHMASK) >> (k)) & 1)
#ifndef LSCALE
#define LSCALE 1.0f
#endif
#ifndef MSCALE
#define MSCALE 1.0f
#endif
#ifndef FSCALE
#define FSCALE 1.0f
#endif
#ifndef OS0
#define OS0 1.0f
#endif
#ifndef OS1
#define OS1 1.0f
#endif
#ifndef OS2
#define OS2 1.0f
#endif
#ifndef OS3
#define OS3 1.0f
#endif
#ifndef OS4
#define OS4 1.0f
#endif
#ifndef OS5
#define OS5 1.0f
#endif
#ifndef ZMASK
#define ZMASK(row, col) false
#endif
#ifndef HSCALE
#define HSCALE 1.0f
#endif
#ifndef BSCALE
#define BSCALE 1.0f
#endif
#ifndef GGVAL
#define GGVAL(x) (x)
#endif
#ifndef GLVAL
#define GLVAL(x) (x)
#endif
#ifndef GLOFF
#define GLOFF 1024
#endif
#ifndef ZSCALE
#define ZSCALE 1.0f
#endif
#define LAS __attribute__((address_space(3)))
typedef unsigned short bf16_t;
typedef short bf16x8 __attribute__((ext_vector_type(8)));
typedef float f32x4 __attribute__((ext_vector_type(4)));
typedef float f32x2 __attribute__((ext_vector_type(2)));
typedef unsigned u32x4 __attribute__((ext_vector_type(4)));
typedef unsigned u32x2 __attribute__((ext_vector_type(2)));

constexpr int D = 1024, MT = 12288, MP = 8192, NKEY = 13312, FF = 2816;
constexpr int INCP = 4864;
constexpr int NTHREADS = 512, LDS_BYTES = 131072;
constexpr float EPS = 1e-6f;
constexpr float LOG2E = 1.4426950408889634f;
constexpr float QSCALE = 0.10206207261596577f * 1.4426950408889634f;

constexpr size_t OFF_CKV = 12582912, OFF_KR = 16777216, OFF_LF = 17301504, OFF_LB = 17367040;

constexpr size_t WS_MODV = 0;
constexpr size_t WS_ROPE = WS_MODV + 2 * 5 * 6144 * 4;
constexpr size_t WS_WIN = WS_ROPE + 2 * 1024 * 16 * 4;
constexpr size_t WS_WFFI = WS_WIN + (size_t)INCP * 1024 * 2;
constexpr size_t WS_WFFO = WS_WFFI + (size_t)5632 * 1024 * 2;
constexpr size_t WS_WOUT = WS_WFFO + (size_t)1024 * 2816 * 2;
constexpr size_t WS_WOLRU = WS_WOUT + (size_t)1024 * 1024 * 2;
constexpr size_t WS_WOMLA = WS_WOLRU + (size_t)1024 * 1024 * 2;
constexpr size_t WS_WQ = WS_WOMLA + (size_t)1024 * 512 * 2;
constexpr size_t WS_WKV = WS_WQ + (size_t)768 * 384 * 2;
constexpr size_t WS_WG = WS_WKV + (size_t)1024 * 256 * 2;
constexpr size_t WS_HBF = WS_WG + (size_t)2 * 8 * 256 * 128 * 2;
constexpr size_t WS_QN = WS_HBF;
constexpr size_t WS_KEYS = WS_QN + (size_t)MT * 384 * 2;
constexpr size_t WS_KRB = WS_KEYS + (size_t)NKEY * 256 * 2;
constexpr size_t WS_AO = WS_HBF;
constexpr size_t WS_PSM = WS_HBF + (size_t)MT * 1024 * 2;
constexpr size_t WS_QB = WS_PSM;
constexpr size_t WS_KN = WS_QB + (size_t)MT * 768 * 2;
constexpr size_t WS_Z = WS_PSM;
constexpr size_t WS_LX = WS_PSM + (size_t)MT * 768 * 4;
constexpr size_t WS_GG = WS_LX + (size_t)MT * 1024 * 4;
constexpr size_t WS_SG = WS_GG + (size_t)MT * 1024 * 2;
constexpr size_t WS_HID = WS_GG;
constexpr size_t WS_VT = WS_SG + (size_t)MT * 2048 * 2;
constexpr size_t WS_HF = WS_VT + (size_t)512 * NKEY * 2;
constexpr size_t WS_END = WS_HF + (size_t)MT * 1024 * 2;

struct Params {
    const float* in[31];
    float* out;
    unsigned char* ws;
    int ph_lo, ph_hi, coop, pad;
};
enum { I_XP = 0, I_XS, I_CCKV, I_CKR, I_SF, I_SB, I_C, I_CCTX, I_WMOD, I_BMOD, I_GPM, I_GQM, I_GPF, I_GQF, I_WIN, I_GQ, I_WQUP, I_GKV,
       I_WKVUP, I_WOMLA, I_CONVW, I_CONVB, I_WRG, I_BRG, I_WIG, I_BIG, I_LAM, I_WOLRU, I_WOUT, I_WFFI, I_WFFO };

__device__ __forceinline__ unsigned char* opq(unsigned char* x) { asm volatile("" : "+s"(x)); return x; }
__device__ __forceinline__ int ozero() { int t = 0; asm volatile("" : "+s"(t)); return t; }
__device__ __forceinline__ int otid() { int t = threadIdx.x; asm volatile("" : "+v"(t)); return t; }
__device__ __forceinline__ int obid() { int t = blockIdx.x; asm volatile("" : "+s"(t)); return t; }
__device__ __forceinline__ int ogrid() { int t = gridDim.x; asm volatile("" : "+s"(t)); return t; }
__device__ __forceinline__ unsigned cvt_pk_bf16(float lo, float hi) { unsigned r; asm volatile("v_cvt_pk_bf16_f32 %0, %1, %2" : "=v"(r) : "v"(lo), "v"(hi)); return r; }
__device__ __forceinline__ float bf2f(bf16_t b) { return __uint_as_float(((unsigned)b) << 16); }
__device__ __forceinline__ bf16_t f2bf(float f) { return (bf16_t)(cvt_pk_bf16(f, 0.f) & 0xffffu); }
__device__ __forceinline__ float shfl_idx(float v, int srclane) { return __int_as_float(__builtin_amdgcn_ds_bpermute(srclane << 2, __float_as_int(v))); }
__device__ __forceinline__ float wave_sum(float v, int lane) {
#pragma unroll
    for (int o = 32; o >= 1; o >>= 1) v += shfl_idx(v, lane ^ o);
    return v;
}
__device__ __forceinline__ float fast_sigmoid(float x) { return __builtin_amdgcn_rcpf(1.0f + __builtin_amdgcn_exp2f(-x * LOG2E)); }
__device__ __forceinline__ float gelu_tanh(float x) { const float z = 1.5957691216057308f * (x + 0.044715f * x * x * x); return x * fast_sigmoid(z); }
__device__ __forceinline__ int keyrow_of(int t) { return t < MP ? t : MP + ((t - MP) >> 10) * 1280 + ((t - MP) & 1023); }

namespace pg8 {
constexpr int BM = 256, BK = 64, HALF = 128, HTB = HALF * BK * 2, NXCD = 8, WGM = 8;
__device__ __forceinline__ int lds_byte(int r, int c) { const int st = (r >> 4) * 2 + (c >> 5), rr = r & 15, cc = c & 31, ob = rr * 64 + cc * 2; return st * 1024 + (ob ^ (((ob >> 9) & 1) << 5)); }
__device__ __forceinline__ void stage_rc(int b, int& R, int& C) { const int st = b / 1024, sb = b % 1024, swz = sb ^ (((sb >> 9) & 1) << 5); R = (st >> 1) * 16 + swz / 64; C = (st & 1) * 32 + (swz % 64) / 2; }
__device__ __forceinline__ int perm32(int rho) { const int n = rho >> 4, i = rho & 15; return 8 * (i >> 2) + 4 * n + (i & 3); }
struct Unit { int pm, pn; };
struct Gemm { const bf16_t* A; const bf16_t* Bt; int M, N, K; };
struct StaticOrder {
    int nM, nN, nwg, G, c;
    __device__ void init(int M, int N, int G_, int c_) { nM = M / BM; nN = N / BM; nwg = nM * nN; G = G_; c = c_; }
    __device__ bool next(int i, Unit& u) const {
        const int L = i * G + c; if (L >= nwg) return false;
        int wgid = L; { const int q = nwg / NXCD, r = nwg % NXCD, xcd = wgid % NXCD, off = wgid / NXCD; wgid = (xcd < r ? xcd * (q + 1) : r * (q + 1) + (xcd - r) * q) + off; }
        const int nig = WGM * nN, gid = wgid / nig, fm = gid * WGM, gsz = (nM - fm) < WGM ? (nM - fm) : WGM;
        u.pm = fm + ((wgid % nig) % gsz); u.pn = (wgid % nig) / gsz; return true;
    }
};
template <class Epi>
__device__ __forceinline__ void gemm_phase(LAS unsigned char* lds, const Gemm g, const StaticOrder& S, const Epi& E) {
    int tid_ = threadIdx.x; asm volatile("" : "+v"(tid_));
    const int tid = tid_, wid = __builtin_amdgcn_readfirstlane(tid >> 6), lane = tid & 63, wr = wid >> 2, wc = wid & 3, fr = lane & 15, fq = lane >> 4;
    const int K = g.K, nt = K / BK;
    unsigned voffA[2], voffB[2];
#pragma unroll
    for (int i = 0; i < 2; ++i) { int R, C; stage_rc(tid * 16 + i * 8192, R, C); const int Rb = Epi::PERM ? ((R & ~31) + perm32(R & 31)) : R;
        voffA[i] = (unsigned)(R * K + C) * 2u; voffB[i] = (unsigned)(Rb * K + C) * 2u; }
    const size_t kstep = (size_t)(BK * 2);
    const size_t hstep = (size_t)HALF * K * 2;
    const size_t tstep = 2 * hstep;
    const unsigned ldsw = (unsigned)wid * 1024u;
    const int aoff = lds_byte(wr * 64 + fr, fq * 8), boff = lds_byte(wc * 32 + fr, fq * 8);
#define PG8_SA(b, h) (((b) * 2 + (h)) * HTB)
#define PG8_SB(b, h) ((4 + (b) * 2 + (h)) * HTB)
#define PG8_STAGE(bufoff, gbase, voff) do { _Pragma("unroll") for (int _i = 0; _i < 2; ++_i) \
        __builtin_amdgcn_global_load_lds((const unsigned*)((const char*)(gbase) + (voff)[_i]), (LAS unsigned*)(lds + (bufoff) + ldsw + _i * 8192), 16, 0, 0); } while (0)
#define PG8_LDA(dst, b, h) do { _Pragma("unroll") for (int m = 0; m < 4; ++m) _Pragma("unroll") for (int k = 0; k < 2; ++k) dst[m][k] = *(const LAS bf16x8*)(lds + PG8_SA(b, h) + aoff + m * 2048 + k * 1024); } while (0)
#define PG8_LDB(dst, b, h) do { _Pragma("unroll") for (int n = 0; n < 2; ++n) _Pragma("unroll") for (int k = 0; k < 2; ++k) dst[n][k] = *(const LAS bf16x8*)(lds + PG8_SB(b, h) + boff + n * 2048 + k * 1024); } while (0)
#define PG8_MMA(ai, bj, At, Bt) do { __builtin_amdgcn_s_setprio(1); _Pragma("unroll") for (int m = 0; m < 4; ++m) _Pragma("unroll") for (int n = 0; n < 2; ++n) _Pragma("unroll") for (int k = 0; k < 2; ++k) \
        acc[ai][bj][m][n] = __builtin_amdgcn_mfma_f32_16x16x32_bf16(Bt[n][k], At[m][k], acc[ai][bj][m][n], 0, 0, 0); __builtin_amdgcn_s_setprio(0); } while (0)
#define PG8_WAIT_V(n) asm volatile("s_waitcnt vmcnt(" #n ")" ::: "memory")
#define PG8_WAIT_L(n) asm volatile("s_waitcnt lgkmcnt(" #n ")" ::: "memory")
#define PG8_BAR __builtin_amdgcn_s_barrier()
#define PG8_SCHED __builtin_amdgcn_sched_barrier(0)
    Unit cur, nxt; int ui = 0;
    if (!S.next(0, cur)) return;
    f32x4 acc[2][2][4][2];
#pragma unroll
    for (int a = 0; a < 2; ++a)
#pragma unroll
        for (int b = 0; b < 2; ++b)
#pragma unroll
            for (int m = 0; m < 4; ++m)
#pragma unroll
                for (int n = 0; n < 2; ++n) acc[a][b][m][n] = (f32x4){0.f, 0.f, 0.f, 0.f};
    bf16x8 At[4][2], B0[2][2], B1[2][2];
    const char* cA = (const char*)g.A + (size_t)cur.pm * tstep; const char* cB = (const char*)g.Bt + (size_t)cur.pn * tstep;
    PG8_STAGE(PG8_SB(0, 0), cB, voffB); PG8_STAGE(PG8_SA(0, 0), cA, voffA); PG8_STAGE(PG8_SB(0, 1), cB + hstep, voffB); PG8_STAGE(PG8_SA(0, 1), cA + hstep, voffA);
    if (wr == 1) PG8_BAR;
    PG8_WAIT_V(4); PG8_BAR;
    PG8_STAGE(PG8_SB(1, 0), cB + kstep, voffB); PG8_STAGE(PG8_SA(1, 0), cA + kstep, voffA); PG8_STAGE(PG8_SB(1, 1), cB + hstep + kstep, voffB);
    PG8_WAIT_V(6); PG8_BAR;
    for (;;) {
        const bool has_next = S.next(ui + 1, nxt);
        const char* nA = has_next ? (const char*)g.A + (size_t)nxt.pm * tstep : cA; const char* nB = has_next ? (const char*)g.Bt + (size_t)nxt.pn * tstep : cB;
        for (int t = 0; t < nt; t += 2) {
            const bool last = (t == nt - 2);
            const char* a1 = cA + (size_t)(t + 1) * kstep;
            const char* a2 = last ? nA : cA + (size_t)(t + 2) * kstep; const char* b2 = last ? nB : cB + (size_t)(t + 2) * kstep;
            const char* a3 = a2 + kstep; const char* b3 = b2 + kstep;
            PG8_LDB(B0, 0, 0); PG8_SCHED; PG8_LDA(At, 0, 0); PG8_STAGE(PG8_SA(1, 1), a1 + hstep, voffA);
            PG8_WAIT_L(8); PG8_BAR; PG8_WAIT_L(0); PG8_MMA(0, 0, At, B0); PG8_BAR; PG8_SCHED;
            PG8_LDB(B1, 0, 1); PG8_STAGE(PG8_SB(0, 0), b2, voffB);
            PG8_BAR; PG8_WAIT_L(0); PG8_MMA(0, 1, At, B1); PG8_BAR;
            PG8_LDA(At, 0, 1); PG8_STAGE(PG8_SA(0, 0), a2, voffA);
            PG8_BAR; PG8_WAIT_L(0); PG8_MMA(1, 0, At, B0); PG8_BAR; PG8_SCHED;
            PG8_STAGE(PG8_SB(0, 1), b2 + hstep, voffB);
            PG8_WAIT_V(6); PG8_BAR; PG8_MMA(1, 1, At, B1); PG8_BAR;
            PG8_LDB(B0, 1, 0); PG8_SCHED; PG8_LDA(At, 1, 0); PG8_STAGE(PG8_SA(0, 1), a2 + hstep, voffA);
            PG8_WAIT_L(8); PG8_BAR; PG8_WAIT_L(0); PG8_MMA(0, 0, At, B0); PG8_BAR; PG8_SCHED;
            PG8_LDB(B1, 1, 1); PG8_STAGE(PG8_SB(1, 0), b3, voffB);
            PG8_BAR; PG8_WAIT_L(0); PG8_MMA(0, 1, At, B1); PG8_BAR;
            PG8_LDA(At, 1, 1); PG8_STAGE(PG8_SA(1, 0), a3, voffA);
            PG8_BAR; PG8_WAIT_L(0); PG8_MMA(1, 0, At, B0); PG8_BAR; PG8_SCHED;
            PG8_STAGE(PG8_SB(1, 1), b3 + hstep, voffB);
            PG8_WAIT_V(6); PG8_BAR; PG8_MMA(1, 1, At, B1); PG8_BAR;
        }
        E(acc, cur, wr, wc, fr, fq);
        if (!has_next) break;
#pragma unroll
        for (int a = 0; a < 2; ++a)
#pragma unroll
            for (int b = 0; b < 2; ++b)
#pragma unroll
                for (int m = 0; m < 4; ++m)
#pragma unroll
                    for (int n = 0; n < 2; ++n) acc[a][b][m][n] = (f32x4){0.f, 0.f, 0.f, 0.f};
        cur = nxt; cA = nA; cB = nB; ++ui;
    }
    PG8_WAIT_V(0);
    if (wr == 0) PG8_BAR;
    PG8_BAR;
#undef PG8_SA
#undef PG8_SB
#undef PG8_STAGE
#undef PG8_LDA
#undef PG8_LDB
#undef PG8_MMA
#undef PG8_WAIT_V
#undef PG8_WAIT_L
#undef PG8_BAR
#undef PG8_SCHED
}
}
using pg8::Unit;
typedef f32x4 AccT[2][2][4][2];

__device__ __forceinline__ u32x4 pack8(f32x4 a, f32x4 b) { u32x4 w; w.x = cvt_pk_bf16(a[0], a[1]); w.y = cvt_pk_bf16(a[2], a[3]); w.z = cvt_pk_bf16(b[0], b[1]); w.w = cvt_pk_bf16(b[2], b[3]); return w; }
__device__ __forceinline__ u32x2 pack4(f32x4 a) { u32x2 w; w.x = cvt_pk_bf16(a[0], a[1]); w.y = cvt_pk_bf16(a[2], a[3]); return w; }
__device__ __forceinline__ void unpack8(u32x4 w, f32x4& a, f32x4& b) {
    a[0] = __uint_as_float(w.x << 16); a[1] = __uint_as_float(w.x & 0xffff0000u); a[2] = __uint_as_float(w.y << 16); a[3] = __uint_as_float(w.y & 0xffff0000u);
    b[0] = __uint_as_float(w.z << 16); b[1] = __uint_as_float(w.z & 0xffff0000u); b[2] = __uint_as_float(w.w << 16); b[3] = __uint_as_float(w.w & 0xffff0000u);
}

struct EpiIn {
    static constexpr bool PERM = true;
    float* psm; float* lx; bf16_t* gg; bf16_t* sg; bf16_t* g2;
    __device__ __forceinline__ void operator()(const AccT& acc, const Unit& u, int wr, int wc, int fr, int fq) const {
        const int row0 = u.pm * 256 + wr * 64 + fr, colb = u.pn * 256 + wc * 32 + 8 * fq;
#pragma unroll
        for (int ai = 0; ai < 2; ++ai)
#pragma unroll
            for (int m = 0; m < 4; ++m) {
                const size_t row = (size_t)(row0 + ai * 128 + m * 16);
#pragma unroll
                for (int bj = 0; bj < 2; ++bj) {
                    const int col = colb + bj * 128; f32x4 v0 = acc[ai][bj][m][0], v1 = acc[ai][bj][m][1];
                    if (u.pn < 3) { float* q = psm + row * 768 + col; *(f32x4*)q = v0; *(f32x4*)(q + 4) = v1; }
                    else if (u.pn < 7) { float* q = lx + row * 1024 + (col - 768); *(f32x4*)q = v0; *(f32x4*)(q + 4) = v1; }
                    else if (u.pn < 11) {
#pragma unroll
                        for (int j = 0; j < 4; ++j) { v0[j] = gelu_tanh(v0[j]); v1[j] = gelu_tanh(v1[j]); }
                        *(u32x4*)(gg + row * 1024 + (col - 1792)) = pack8(v0, v1); }
                    else {
#pragma unroll
                        for (int j = 0; j < 4; ++j) { v0[j] = fast_sigmoid(v0[j]); v1[j] = fast_sigmoid(v1[j]); }
                        *(u32x4*)(sg + row * 2048 + (col - 2816)) = pack8(v0, v1);
                        if (u.pn >= 15) *(u32x4*)(g2 + row * 1024 + (col - 3840)) = pack8(v0, v1); }
                }
            }
    }
};
struct EpiQ {
    static constexpr bool PERM = false;
    bf16_t* q; const float* ropec; const float* ropes;
    __device__ __forceinline__ void operator()(const AccT& acc, const Unit& u, int wr, int wc, int fr, int fq) const {
        const int row0 = u.pm * 256 + wr * 64 + fr;
#pragma unroll
        for (int ai = 0; ai < 2; ++ai)
#pragma unroll
            for (int m = 0; m < 4; ++m) {
                const int row = row0 + ai * 128 + m * 16; const bool lat = row >= MP; const int pos = (row - MP) & 1023;
#pragma unroll
                for (int bj = 0; bj < 2; ++bj) {
                    const int base = u.pn * 256 + bj * 128 + wc * 32; const bool rope = lat && (((base >> 5) % 3) == 2);
                    f32x4 v0 = acc[ai][bj][m][0], v1 = acc[ai][bj][m][1];
                    if (rope) { const f32x4 cs = *(const f32x4*)(ropec + pos * 16 + 4 * fq), sn = *(const f32x4*)(ropes + pos * 16 + 4 * fq);
                        const f32x4 o0 = v0 * cs - v1 * sn, o1 = v0 * sn + v1 * cs; v0 = o0; v1 = o1; }
                    v0 *= QSCALE; v1 *= QSCALE;
                    bf16_t* dst = q + (size_t)row * 768 + base + 4 * fq;
                    *(u32x2*)dst = pack4(v0); *(u32x2*)(dst + 16) = pack4(v1);
                }
                asm volatile("" ::: "memory");
            }
    }
};
struct EpiBf16 {
    static constexpr bool PERM = true;
    bf16_t* o; int ldc;
    __device__ __forceinline__ void operator()(const AccT& acc, const Unit& u, int wr, int wc, int fr, int fq) const {
        const int row0 = u.pm * 256 + wr * 64 + fr, colb = u.pn * 256 + wc * 32 + 8 * fq;
#pragma unroll
        for (int ai = 0; ai < 2; ++ai)
#pragma unroll
            for (int m = 0; m < 4; ++m) {
                const size_t row = (size_t)(row0 + ai * 128 + m * 16);
#pragma unroll
                for (int bj = 0; bj < 2; ++bj) *(u32x4*)(o + row * ldc + colb + bj * 128) = pack8(acc[ai][bj][m][0], acc[ai][bj][m][1]);
            }
    }
};
struct EpiF32 {
    static constexpr bool PERM = true;
    float* o; int ldc;
    __device__ __forceinline__ void operator()(const AccT& acc, const Unit& u, int wr, int wc, int fr, int fq) const {
        const int row0 = u.pm * 256 + wr * 64 + fr, colb = u.pn * 256 + wc * 32 + 8 * fq;
#pragma unroll
        for (int ai = 0; ai < 2; ++ai)
#pragma unroll
            for (int m = 0; m < 4; ++m) {
                const size_t row = (size_t)(row0 + ai * 128 + m * 16);
#pragma unroll
                for (int bj = 0; bj < 2; ++bj) { float* q = o + row * ldc + colb + bj * 128; *(f32x4*)q = acc[ai][bj][m][0]; *(f32x4*)(q + 4) = acc[ai][bj][m][1]; }
            }
    }
};
struct EpiMla {
    static constexpr bool PERM = true;
    float* z1; const bf16_t* sg;
    __device__ __forceinline__ void operator()(const AccT& acc, const Unit& u, int wr, int wc, int fr, int fq) const {
        const int row0 = u.pm * 256 + wr * 64 + fr, colb = u.pn * 256 + wc * 32 + 8 * fq;
#pragma unroll
        for (int ai = 0; ai < 2; ++ai)
#pragma unroll
            for (int m = 0; m < 4; ++m) {
                const size_t row = (size_t)(row0 + ai * 128 + m * 16);
#pragma unroll
                for (int bj = 0; bj < 2; ++bj) { const int col = colb + bj * 128; f32x4 g0, g1; unpack8(*(const u32x4*)(sg + row * 2048 + col), g0, g1);
                    float* q = z1 + row * 1024 + col; *(f32x4*)q = acc[ai][bj][m][0] * g0 * ZSCALE; *(f32x4*)(q + 4) = acc[ai][bj][m][1] * g1 * ZSCALE; }
                asm volatile("" ::: "memory");
            }
    }
};
struct EpiLru {
    static constexpr bool PERM = true;
    const float* z1; const bf16_t* sg; bf16_t* z; const bf16_t* g2;
    __device__ __forceinline__ void operator()(const AccT& acc, const Unit& u, int wr, int wc, int fr, int fq) const {
        const int row0 = u.pm * 256 + wr * 64 + fr, colb = u.pn * 256 + wc * 32 + 8 * fq;
#pragma unroll
        for (int ai = 0; ai < 2; ++ai)
#pragma unroll
            for (int m = 0; m < 4; ++m) {
                const size_t row = (size_t)(row0 + ai * 128 + m * 16);
#pragma unroll
                for (int bj = 0; bj < 2; ++bj) { const int col = colb + bj * 128; f32x4 g0, g1; unpack8(*(const u32x4*)(g2 + row * 1024 + col), g0, g1);
                    const float* q = z1 + row * 1024 + col; const f32x4 a0 = *(const f32x4*)q + acc[ai][bj][m][0] * GLVAL(g0) * LSCALE, a1 = *(const f32x4*)(q + 4) + acc[ai][bj][m][1] * GLVAL(g1) * LSCALE;
                    *(u32x4*)(z + row * 1024 + col) = pack8(a0, a1); }
                asm volatile("" ::: "memory");
            }
    }
};
struct EpiFfi {
    static constexpr bool PERM = false;
    bf16_t* hid;
    __device__ __forceinline__ void operator()(const AccT& acc, const Unit& u, int wr, int wc, int fr, int fq) const {
        const int row0 = u.pm * 256 + wr * 64 + fr;
#pragma unroll
        for (int ai = 0; ai < 2; ++ai)
#pragma unroll
            for (int m = 0; m < 4; ++m) {
                const size_t row = (size_t)(row0 + ai * 128 + m * 16);
#pragma unroll
                for (int bj = 0; bj < 2; ++bj) { const int hc = ((u.pn * 256 + bj * 128 + wc * 32) >> 1) + 4 * fq; const f32x4 gv = acc[ai][bj][m][0], uv = acc[ai][bj][m][1]; f32x4 h;
#pragma unroll
                    for (int j = 0; j < 4; ++j) h[j] = gv[j] * fast_sigmoid(gv[j]) * uv[j];
                    *(u32x2*)(hid + row * FF + hc) = pack4(h); }
            }
    }
};

__device__ __forceinline__ int map_row(int mode, int n) {
    if (mode == 1) return n < 672 ? n : n + 96;
    if (mode == 2) { const int up = n >= FF, j = up ? n - FF : n; return (j >> 4) * 32 + (j & 15) + (up ? 16 : 0); }
    if (mode == 3) { const int h = n >> 7, r = n & 127; return r < 64 ? h * 64 + r : 512 + h * 64 + (r - 64); }
    return n;
}
__device__ __forceinline__ void conv_tile(const float* src, int ld, int K, int k0, int n0, bf16_t* dst, int mode, LAS float* tile) {
    const int tid = otid();
    __syncthreads();
#pragma unroll
    for (int i = 0; i < 2; ++i) { const int kk = (tid >> 3) + 64 * i, c4 = (tid & 7) * 4; const f32x4 v = *(const f32x4*)(src + (size_t)(k0 + kk) * ld + n0 + c4);
        tile[kk * 33 + c4] = v[0]; tile[kk * 33 + c4 + 1] = v[1]; tile[kk * 33 + c4 + 2] = v[2]; tile[kk * 33 + c4 + 3] = v[3]; }
    __syncthreads();
    const int n = tid >> 4, k8 = (tid & 15) * 8; f32x4 a, b;
#pragma unroll
    for (int j = 0; j < 4; ++j) { a[j] = tile[(k8 + j) * 33 + n]; b[j] = tile[(k8 + 4 + j) * 33 + n]; }
    *(u32x4*)(dst + (size_t)map_row(mode, n0 + n) * K + k0 + k8) = pack8(a, b);
}
constexpr int CONV_ITEMS = 4208;
__device__ __forceinline__ void conv_item(const Params& p, unsigned char* ws, int l, int idx, LAS float* tile) {
    const int zz = ozero();
    int inidx, K, N, mode = 0; size_t soff, doff;
    if (idx < 1192) { inidx = I_WIN; soff = (size_t)l * 1024 * 4768; doff = WS_WIN; K = 1024; N = 4768; mode = 1; }
    else if ((idx -= 1192) < 1408) { inidx = I_WFFI; soff = (size_t)l * 1024 * 5632; doff = WS_WFFI; K = 1024; N = 5632; mode = 2; }
    else if ((idx -= 1408) < 704) { inidx = I_WFFO; soff = (size_t)l * 2816 * 1024; doff = WS_WFFO; K = 2816; N = 1024; }
    else if ((idx -= 704) < 256) { inidx = I_WOUT; soff = (size_t)l * 1024 * 1024; doff = WS_WOUT; K = 1024; N = 1024; }
    else if ((idx -= 256) < 256) { inidx = I_WOLRU; soff = (size_t)l * 1024 * 1024; doff = WS_WOLRU; K = 1024; N = 1024; }
    else if ((idx -= 256) < 128) { inidx = I_WOMLA; soff = (size_t)l * 512 * 1024; doff = WS_WOMLA; K = 512; N = 1024; }
    else if ((idx -= 128) < 72) { inidx = I_WQUP; soff = (size_t)l * 384 * 768; doff = WS_WQ; K = 384; N = 768; }
    else if ((idx -= 72) < 64) { inidx = I_WKVUP; soff = (size_t)l * 256 * 1024; doff = WS_WKV; K = 256; N = 1024; mode = 3; }
    else { idx -= 64; const int mat = idx >> 2, ig = mat >> 4, dir = (mat >> 3) & 1, n = mat & 7;
        inidx = ig ? I_WIG : I_WRG; soff = (size_t)((l * 2 + dir) * 8 + n) * 16384; doff = WS_WG + (size_t)((dir * 8 + n) * 256 + ig * 128) * 128 * 2; K = 128; N = 128; idx &= 3; }
    const float* src = p.in[zz + inidx] + soff; bf16_t* dst = (bf16_t*)(ws + doff);
    const int nk = K / 128, kt = idx % nk, ntile = idx / nk;
    conv_tile(src, N, K, kt * 128, ntile * 32, dst, mode, tile);
}
__device__ __forceinline__ void modv_phase(const Params& p, unsigned char* ws, LAS float* lds) {
    const int zz = ozero();
    LAS float* sc = lds + 128 * 33;
    LAS float* red = sc + 5 * 1024;
    const int tid = otid();
    __syncthreads();
    for (int i = tid; i < 5 * 1024; i += NTHREADS) { const float c = i < 1024 ? p.in[zz + I_CCTX][i] : p.in[zz + I_C][i - 1024]; sc[i] = c / (1.0f + __expf(-c)); }
    __syncthreads();
    float* modv = (float*)(ws + WS_MODV); const int bid = obid(), G = ogrid();
    const int col = tid & 31, kg = tid >> 5;
    for (int it = bid; it < 384; it += G) {
        const int l = it / 192, j0 = (it % 192) * 32;
        const float* w = p.in[zz + I_WMOD] + (size_t)l * 1024 * 6144 + j0 + col;
        float a0 = 0.f, a1 = 0.f, a2 = 0.f, a3 = 0.f, a4 = 0.f;
#pragma unroll 8
        for (int k = kg * 64; k < kg * 64 + 64; ++k) { const float wv = w[(size_t)k * 6144]; a0 += sc[k] * wv; a1 += sc[1024 + k] * wv; a2 += sc[2048 + k] * wv; a3 += sc[3072 + k] * wv; a4 += sc[4096 + k] * wv; }
        red[(kg * 5 + 0) * 32 + col] = a0; red[(kg * 5 + 1) * 32 + col] = a1; red[(kg * 5 + 2) * 32 + col] = a2; red[(kg * 5 + 3) * 32 + col] = a3; red[(kg * 5 + 4) * 32 + col] = a4;
        __syncthreads();
        if (tid < 160) { const int v = tid >> 5, c = tid & 31; float s = p.in[zz + I_BMOD][l * 6144 + j0 + c];
#pragma unroll
            for (int g = 0; g < 16; ++g) s += red[(g * 5 + v) * 32 + c];
            modv[(size_t)(l * 5 + v) * 6144 + j0 + c] = s; }
        __syncthreads();
    }
}
__device__ __forceinline__ void rope_table(const Params& p, unsigned char* ws) {
    const int zz = ozero();
    float* rc = (float*)(ws + WS_ROPE); float* rs = rc + 1024 * 16;
    const int G = ogrid(); for (int i = obid() * NTHREADS + otid(); i < 1024 * 16; i += G * NTHREADS) {
        const int pos = i >> 4, f = i & 15; const float posv = (float)(f < 8 ? (pos >> 6) : (pos & 63));
        const float inv = exp2f(-(float)(f & 7) * (13.287712379549449f / 8.0f));
        const float rev = posv * inv * 0.15915494309189535f;
        rc[i] = __builtin_amdgcn_cosf(rev); rs[i] = __builtin_amdgcn_sinf(rev);
    }
}

template <bool HAS_Y, bool DO_H>
__device__ __forceinline__ void norm_phase(const Params& p, unsigned char* ws, const float* xp, const float* xs, const float* Y, const float* gA, int gate_off, const float* modA,
                                           const float* gB, int sh_off, int sc_off, const float* modB) {
    const int zz = ozero();
    const int tid = otid(), wid = tid >> 6, lane = tid & 63; const int bid = obid(), G = ogrid();
    bf16_t* hbf = (bf16_t*)(ws + WS_HBF);
    for (int row = bid * 8 + wid; row < MT; row += G * 8) {
        const int mv = row < MP ? 0 : 1 + ((row - MP) >> 10);
        const float* xin = row < MP ? xp + (size_t)row * D : xs + (size_t)(row - MP) * D;
        f32x4 x[4];
#pragma unroll
        for (int i = 0; i < 4; ++i) x[i] = *(const f32x4*)(xin + i * 256 + lane * 4);
        if (HAS_Y) {
            f32x4 y[4]; float ss = 0.f;
#pragma unroll
            for (int i = 0; i < 4; ++i) { y[i] = *(const f32x4*)(Y + (size_t)row * D + i * 256 + lane * 4); ss += y[i][0] * y[i][0] + y[i][1] * y[i][1] + y[i][2] * y[i][2] + y[i][3] * y[i][3]; }
            ss = wave_sum(ss, lane); const float rstd = rsqrtf(ss * (1.0f / D) + EPS);
            const float* mg = modA + (size_t)mv * 6144 + gate_off;
#pragma unroll
            for (int i = 0; i < 4; ++i) { const f32x4 g = *(const f32x4*)(gA + i * 256 + lane * 4), gt = *(const f32x4*)(mg + i * 256 + lane * 4);
                x[i] = x[i] + gt * (y[i] * rstd * g) * (gate_off == 2048 ? MSCALE : FSCALE); *(f32x4*)((p.out + zz) + (size_t)row * D + i * 256 + lane * 4) = DO_H ? x[i] : x[i] * (row < MP ? (ZMASK(row, i * 256 + lane * 4) ? 0.0f : OS0) : OS1); }
        }
        if (DO_H) {
            float ss = 0.f;
#pragma unroll
            for (int i = 0; i < 4; ++i) ss += x[i][0] * x[i][0] + x[i][1] * x[i][1] + x[i][2] * x[i][2] + x[i][3] * x[i][3];
            ss = wave_sum(ss, lane); const float rstd = rsqrtf(ss * (1.0f / D) + EPS);
            const float* msh = modB + (size_t)mv * 6144 + sh_off; const float* msc = modB + (size_t)mv * 6144 + sc_off;
#pragma unroll
            for (int i = 0; i < 4; ++i) { const f32x4 g = *(const f32x4*)(gB + i * 256 + lane * 4), sh = *(const f32x4*)(msh + i * 256 + lane * 4), sc = *(const f32x4*)(msc + i * 256 + lane * 4);
                const f32x4 h = (x[i] * rstd * g) * (sc + 1.0f) + sh; *(u32x2*)(hbf + (size_t)row * D + i * 256 + lane * 4) = pack4(h); }
        }
    }
}

__device__ __forceinline__ void postproj_phase(const Params& p, unsigned char* ws, int l) {
    const int zz = ozero();
    const int tid = otid(), wid = tid >> 6, lane = tid & 63; const int bid = obid(), G = ogrid();
    const float* psm = (const float*)(ws + WS_PSM);
    bf16_t* qn = (bf16_t*)(ws + WS_QN); bf16_t* keys = (bf16_t*)(ws + WS_KEYS); bf16_t* krb = (bf16_t*)(ws + WS_KRB);
    const float* ropec = (const float*)(ws + WS_ROPE); const float* ropes = ropec + 1024 * 16;
    const float* gq = p.in[zz + I_GQ] + l * 384; const float* gkv = p.in[zz + I_GKV] + l * 256;
    for (int t = bid * 8 + wid; t < NKEY; t += G * 8) {
        if (t < MT) {
            const float* pr = psm + (size_t)t * 768;
            f32x2 q[3]; float ss = 0.f;
#pragma unroll
            for (int i = 0; i < 3; ++i) { q[i] = *(const f32x2*)(pr + i * 128 + lane * 2); ss += q[i][0] * q[i][0] + q[i][1] * q[i][1]; }
            ss = wave_sum(ss, lane); float rstd = rsqrtf(ss * (1.0f / 384.0f) + EPS);
#pragma unroll
            for (int i = 0; i < 3; ++i) { const f32x2 g = *(const f32x2*)(gq + i * 128 + lane * 2); *(unsigned*)(qn + (size_t)t * 384 + i * 128 + lane * 2) = cvt_pk_bf16(q[i][0] * rstd * g[0], q[i][1] * rstd * g[1]); }
            f32x4 kv = *(const f32x4*)(pr + 384 + lane * 4);
            ss = wave_sum(kv[0] * kv[0] + kv[1] * kv[1] + kv[2] * kv[2] + kv[3] * kv[3], lane); rstd = rsqrtf(ss * (1.0f / 256.0f) + EPS);
            const f32x4 ckv = kv * rstd * *(const f32x4*)(gkv + lane * 4);
            const int kr = keyrow_of(t);
            *(u32x2*)(keys + (size_t)kr * 256 + lane * 4) = pack4(ckv);
            const int s = t >> 8, pp = t & 255;
            if (t < MP) *(f32x4*)((p.out + zz) + OFF_CKV + ((size_t)(s * 2 + l) * 256 + pp) * 256 + lane * 4) = ckv * OS2;
            if (lane < 16) {
                float x1 = pr[640 + lane], x2 = pr[656 + lane];
                if (t >= MP) { const int pos = (t - MP) & 1023; const float cs = ropec[pos * 16 + lane], sn = ropes[pos * 16 + lane]; const float o1 = x1 * cs - x2 * sn, o2 = x1 * sn + x2 * cs; x1 = o1; x2 = o2; }
                krb[(size_t)kr * 32 + lane] = f2bf(x1); krb[(size_t)kr * 32 + 16 + lane] = f2bf(x2);
                if (t < MP) { float* o = (p.out + zz) + OFF_KR + ((size_t)(s * 2 + l) * 256 + pp) * 32; o[lane] = x1 * OS3; o[16 + lane] = x2 * OS3; }
            }
        } else {
            const int j = t - MT, b = j >> 8, jj = j & 255, kr = MP + b * 1280 + 1024 + jj;
            const f32x4 v = *(const f32x4*)(p.in[zz + I_CCKV] + ((size_t)(b * 2 + l) * 256 + jj) * 256 + lane * 4);
            *(u32x2*)(keys + (size_t)kr * 256 + lane * 4) = pack4(v);
            if (lane < 8) { const f32x4 w = *(const f32x4*)(p.in[zz + I_CKR] + ((size_t)(b * 2 + l) * 256 + jj) * 32 + lane * 4); *(u32x2*)(krb + (size_t)kr * 32 + lane * 4) = pack4(w); }
        }
    }
}

__device__ __forceinline__ void attn_phase(const Params& p, unsigned char* ws, LAS unsigned char* lds) {
    const int zz = ozero();
    const bf16_t* Qb = (const bf16_t*)(ws + WS_QB); const bf16_t* Kn = (const bf16_t*)(ws + WS_KN); const bf16_t* KR = (const bf16_t*)(ws + WS_KRB);
    const bf16_t* Vt = (const bf16_t*)(ws + WS_VT); bf16_t* AO = (bf16_t*)(ws + WS_AO);
    LAS bf16_t* Ks = (LAS bf16_t*)lds;
    LAS bf16_t* Vs = (LAS bf16_t*)(lds + 64 * 208);
    const int tid = otid(), wid = tid >> 6, lane = tid & 63, l15 = lane & 15, quad = lane >> 4; const int bid = obid(), G = ogrid();
    const bool split = (G == 256);
    for (int it = split ? (bid < 32 ? 768 : (bid - 64 + 224) % 224) : bid; it < 768; it += split ? 224 : G) {
        int tq, kb, nk, h;
        if (it < 256) { const int b = it >> 6; h = (it >> 3) & 7; tq = MP + b * 1024 + (it & 7) * 128; kb = MP + b * 1280; nk = 1280; }
        else { const int j = it - 256, s = j >> 4; h = (j >> 1) & 7; tq = s * 256 + (j & 1) * 128; kb = s * 256; nk = 256; }
        const int qrow = tq + wid * 16 + l15;
        bf16x8 qf[3];
#pragma unroll
        for (int ks = 0; ks < 3; ++ks) qf[ks] = *(const bf16x8*)(Qb + (size_t)qrow * 768 + h * 96 + ks * 32 + quad * 8);
        f32x4 o[4];
#pragma unroll
        for (int i = 0; i < 4; ++i) o[i] = (f32x4){0.f, 0.f, 0.f, 0.f};
        float mrun = -1e30f, lsum = 0.f;
        for (int k0 = 0; k0 < nk; k0 += 64) {
            __syncthreads();
            for (int c = tid; c < 768; c += NTHREADS) { const int r = c / 12, cc = c % 12;
                const bf16_t* src = cc < 8 ? Kn + (size_t)(kb + k0 + r) * 512 + h * 64 + cc * 8 : KR + (size_t)(kb + k0 + r) * 32 + (cc - 8) * 8;
                *(LAS u32x4*)(Ks + r * 104 + cc * 8) = *(const u32x4*)src; }
            { const int r = tid >> 3, cc = tid & 7; *(LAS u32x4*)(Vs + r * 72 + cc * 8) = *(const u32x4*)(Vt + (size_t)(h * 64 + r) * NKEY + kb + k0 + cc * 8); }
            __syncthreads();
            f32x4 s[4];
#pragma unroll
            for (int js = 0; js < 4; ++js) { s[js] = (f32x4){0.f, 0.f, 0.f, 0.f};
#pragma unroll
                for (int ks = 0; ks < 3; ++ks) { const bf16x8 a = *(const LAS bf16x8*)(Ks + (js * 16 + l15) * 104 + ks * 32 + quad * 8); s[js] = __builtin_amdgcn_mfma_f32_16x16x32_bf16(a, qf[ks], s[js], 0, 0, 0); } }
            float mx = s[0][0];
#pragma unroll
            for (int js = 0; js < 4; ++js)
#pragma unroll
                for (int j = 0; j < 4; ++j) mx = fmaxf(mx, s[js][j]);
            mx = fmaxf(mx, shfl_idx(mx, lane ^ 16)); mx = fmaxf(mx, shfl_idx(mx, lane ^ 32));
            const float mnew = fmaxf(mrun, mx), alpha = __builtin_amdgcn_exp2f(mrun - mnew); mrun = mnew;
            float psum = 0.f;
#pragma unroll
            for (int js = 0; js < 4; ++js)
#pragma unroll
                for (int j = 0; j < 4; ++j) { s[js][j] = __builtin_amdgcn_exp2f(s[js][j] - mnew); psum += s[js][j]; }
            lsum = lsum * alpha + psum;
#pragma unroll
            for (int i = 0; i < 4; ++i) o[i] *= alpha;
#pragma unroll
            for (int kk = 0; kk < 2; ++kk) {
                const u32x4 pw = pack8(s[2 * kk], s[2 * kk + 1]); bf16x8 pf; __builtin_memcpy(&pf, &pw, 16);
#pragma unroll
                for (int dv = 0; dv < 4; ++dv) {
                    const LAS bf16_t* vp = Vs + (dv * 16 + l15) * 72 + kk * 32 + quad * 4;
                    u32x4 vw; const u32x2 v0 = *(const LAS u32x2*)vp, v1 = *(const LAS u32x2*)(vp + 16); vw.x = v0.x; vw.y = v0.y; vw.z = v1.x; vw.w = v1.y;
                    bf16x8 va; __builtin_memcpy(&va, &vw, 16);
                    o[dv] = __builtin_amdgcn_mfma_f32_16x16x32_bf16(va, pf, o[dv], 0, 0, 0);
                }
            }
        }
        lsum += shfl_idx(lsum, lane ^ 16); lsum += shfl_idx(lsum, lane ^ 32);
        const float inv = 1.0f / lsum;
#pragma unroll
        for (int dv = 0; dv < 4; ++dv) *(u32x2*)(AO + (size_t)qrow * 512 + h * 64 + dv * 16 + quad * 4) = pack4(o[dv] * inv);
    }
}

template <int DIR>
__device__ __forceinline__ void scan_pass(const Params& p, unsigned char* ws, int l, int n, int tok0, int L, float h0, bool write_state, int state_idx, LAS unsigned char* lds) {
    const int zz = ozero();
    LAS float* xcf = (LAS float*)lds;
    LAS bf16_t* xcb = (LAS bf16_t*)(lds + 64 * 132 * 4);
    const int tid = otid(), wid = tid >> 6, lane = tid & 63, l15 = lane & 15, quad = lane >> 4;
    const int chl = wid * 16 + l15, ch = n * 128 + chl;
    const float* LXp = (const float*)(ws + WS_LX); bf16_t* HF = (bf16_t*)(ws + WS_SG) + 1024;   bf16_t* GG = (bf16_t*)(ws + WS_GG);
    const float lam = p.in[zz + I_LAM][(l * 2 + DIR) * 1024 + ch];
    const float nl = -lam, sp = fmaxf(nl, 0.f) + log1pf(__expf(-fabsf(nl)));
    const float cc = -8.0f * sp * LOG2E;
    const float br = p.in[zz + I_BRG][(l * 2 + DIR) * 1024 + ch], bi = p.in[zz + I_BIG][(l * 2 + DIR) * 1024 + ch];
    const bf16_t* wg = (const bf16_t*)(ws + WS_WG) + (size_t)((DIR * 8 + n) * 256) * 128;
    bf16x8 wrf[4], wif[4];
#pragma unroll
    for (int ks = 0; ks < 4; ++ks) { wrf[ks] = *(const bf16x8*)(wg + (size_t)chl * 128 + ks * 32 + quad * 8); wif[ks] = *(const bf16x8*)(wg + (size_t)(128 + chl) * 128 + ks * 32 + quad * 8); }
    const int c4 = (tid & 31) * 4, tg = tid >> 5;
    const float* cw = p.in[zz + I_CONVW] + (size_t)l * 4 * 1024 + n * 128 + c4;
    const f32x4 w0 = *(const f32x4*)cw, w1 = *(const f32x4*)(cw + 1024), w2 = *(const f32x4*)(cw + 2048), w3 = *(const f32x4*)(cw + 3072);
    const f32x4 cb = *(const f32x4*)(p.in[zz + I_CONVB] + l * 1024 + n * 128 + c4);
    float hin = h0;
    const int nchunk = L >> 6;
    f32x4 xr[7];
    {
        const int t0f = (DIR ? nchunk - 1 : 0) * 64;
#pragma unroll
        for (int r = 0; r < 7; ++r) { const int tt = t0f + tg * 4 - 2 + r; xr[r] = (tt >= 0 && tt < L) ? *(const f32x4*)(LXp + (size_t)(tok0 + tt) * 1024 + n * 128 + c4) : (f32x4){0.f, 0.f, 0.f, 0.f}; }
    }
    for (int ci = 0; ci < nchunk; ++ci) {
        const int t0 = (DIR ? nchunk - 1 - ci : ci) * 64;
        __syncthreads();
#pragma unroll
        for (int j = 0; j < 4; ++j) { const f32x4 xc = cb + xr[j] * w0 + xr[j + 1] * w1 + xr[j + 2] * w2 + xr[j + 3] * w3;
            *(LAS f32x4*)(xcf + (tg * 4 + j) * 132 + c4) = xc; *(LAS u32x2*)(xcb + (tg * 4 + j) * 136 + c4) = pack4(xc); }
        __syncthreads();
        if (ci + 1 < nchunk) {
            const int t0n = (DIR ? nchunk - 2 - ci : ci + 1) * 64;
#pragma unroll
            for (int r = 0; r < 7; ++r) { const int tt = t0n + tg * 4 - 2 + r; xr[r] = (tt >= 0 && tt < L) ? *(const f32x4*)(LXp + (size_t)(tok0 + tt) * 1024 + n * 128 + c4) : (f32x4){0.f, 0.f, 0.f, 0.f}; }
        }
        typedef unsigned short us2 __attribute__((ext_vector_type(2)));
        us2 hg[4][4];
        if (DIR == 1) {
#pragma unroll
            for (int st = 0; st < 4; ++st)
#pragma unroll
                for (int j = 0; j < 4; ++j) { const size_t idx = (size_t)(tok0 + t0 + st * 16 + quad * 4 + j) * 1024 + ch; hg[st][j].x = HF[idx + (idx - ch)]; hg[st][j].y = GG[idx]; }
        }
        f32x4 rg[4], ig[4];
#pragma unroll
        for (int st = 0; st < 4; ++st) { rg[st] = (f32x4){0.f, 0.f, 0.f, 0.f}; ig[st] = (f32x4){0.f, 0.f, 0.f, 0.f};
#pragma unroll
            for (int ks = 0; ks < 4; ++ks) { const bf16x8 a = *(const LAS bf16x8*)(xcb + (st * 16 + l15) * 136 + ks * 32 + quad * 8);
                rg[st] = __builtin_amdgcn_mfma_f32_16x16x32_bf16(a, wrf[ks], rg[st], 0, 0, 0); ig[st] = __builtin_amdgcn_mfma_f32_16x16x32_bf16(a, wif[ks], ig[st], 0, 0, 0); } }
#pragma unroll
        for (int sti = 0; sti < 4; ++sti) {
            const int st = DIR ? 3 - sti : sti;
            float av[4], hv[4], pa[4];
#pragma unroll
            for (int j = 0; j < 4; ++j) { const float x = xcf[(st * 16 + quad * 4 + j) * 132 + chl];
                const float rr = fast_sigmoid(rg[st][j] + br), ii = fast_sigmoid(ig[st][j] + bi);
                const float a = __builtin_amdgcn_exp2f(cc * rr); av[j] = a; hv[j] = __builtin_amdgcn_sqrtf(fmaxf(1.0f - a * a, 0.f)) * ii * x; }
            float hl = 0.f, pr = 1.f;
#pragma unroll
            for (int s4 = 0; s4 < 4; ++s4) { const int j = DIR ? 3 - s4 : s4; hl = av[j] * hl + hv[j]; pr *= av[j]; hv[j] = hl; pa[j] = pr; }
            float Ar = 1.f, Hr = 0.f, Aex = 1.f, Hex = 0.f;
#pragma unroll
            for (int s4 = 0; s4 < 4; ++s4) { const int qq = DIR ? 3 - s4 : s4; const float Aq = shfl_idx(pr, qq * 16 + l15), Hq = shfl_idx(hl, qq * 16 + l15);
                if (qq == quad) { Aex = Ar; Hex = Hr; }
                Hr = Aq * Hr + Hq; Ar *= Aq; }
            const float cq = Aex * hin + Hex;
            hin = Ar * hin + Hr;
#pragma unroll
            for (int j = 0; j < 4; ++j) { const float hfin = hv[j] + pa[j] * cq; const size_t idx = (size_t)(tok0 + t0 + st * 16 + quad * 4 + j) * 1024 + ch;
                if (DIR == 0) HF[idx + (idx - ch)] = f2bf(hfin);
                else GG[idx] = f2bf((bf2f(hg[st][j].x) + hfin) * bf2f(hg[st][j].y)); }
        }
    }
    if (write_state && quad == 0) (p.out + zz)[(DIR ? OFF_LB : OFF_LF) + state_idx + ch] = hin * (DIR ? OS5 : OS4);
}
__device__ __forceinline__ void scan_phase(const Params& p, unsigned char* ws, int l, LAS unsigned char* lds) {
    const int zz = ozero();
    const int tid = otid(), l15 = tid & 15, wid = tid >> 6; const int bid = obid(), G = ogrid();
    for (int rr = 0; rr < 2; ++rr) {
        const int it = rr == 0 ? bid : ((G == 256 && bid >= 32 && bid < 64) ? 224 + bid : (G == 256 ? 288 : bid + G));
        if (it >= 288) break;
        int n, tok0, L, sidx; bool lat; float hf0 = 0.f, hb0 = 0.f;
        if (it < 32) { const int b = it >> 3; n = it & 7; tok0 = MP + b * 1024; L = 1024; lat = true; sidx = 0; const int ch = n * 128 + wid * 16 + l15;
            hf0 = p.in[zz + I_SF][(b * 2 + l) * 1024 + ch]; hb0 = p.in[zz + I_SB][(b * 2 + l) * 1024 + ch]; }
        else { const int j = it - 32, s = j >> 3; n = j & 7; tok0 = s * 256; L = 256; lat = false; sidx = (s * 2 + l) * 1024; }
        scan_pass<0>(p, ws, l, n, tok0, L, hf0, !lat, sidx, lds);
        scan_pass<1>(p, ws, l, n, tok0, L, hb0, !lat, sidx, lds);
    }
}

__device__ __forceinline__ unsigned char* opq_unused(unsigned char* x) { asm volatile("" : "+s"(x)); return x; }
__device__ __forceinline__ void grid_sync_all() {
    asm volatile("s_waitcnt vmcnt(0) lgkmcnt(0)" ::: "memory");
    __syncthreads();
    if (otid() < 64) { __builtin_amdgcn_fence(__ATOMIC_RELEASE, "agent"); asm volatile("s_waitcnt vmcnt(0) lgkmcnt(0)" ::: "memory"); }
    cg::this_grid().sync();
    if (otid() < 64) { __builtin_amdgcn_fence(__ATOMIC_ACQUIRE, "agent"); asm volatile("s_waitcnt vmcnt(0) lgkmcnt(0)" ::: "memory"); }
    __syncthreads();
}
__global__ void __launch_bounds__(NTHREADS) fwd_megakernel(Params p) {
    extern __shared__ __attribute__((aligned(16))) unsigned char smem[];
    LAS unsigned char* lds = (LAS unsigned char*)smem;
    int ph = 0; (void)ph; int phc = 0; (void)phc;
#if defined(STOP_AFTER)
#define PHASE_IF if (phc <= STOP_AFTER)
#define PHASE_END do { ++phc; grid_sync_all(); } while (0)
#elif ONE_LAUNCH
#define PHASE_IF
#define PHASE_END do { grid_sync_all(); } while (0)
#else
#define PHASE_IF if (__builtin_amdgcn_readfirstlane((int)(ph >= p.ph_lo && ph < p.ph_hi)))
#define PHASE_END do { ++ph; } while (0)
#endif

    PHASE_IF PHK(0) { const int zz = ozero(); unsigned char* ws = p.ws + zz; const int G = ogrid(), bid = obid(); (void)G; (void)bid; const float* modv = (const float*)(ws + WS_MODV); const float* modl = modv; (void)modl;
        rope_table(p, ws);
        modv_phase(p, ws, (LAS float*)lds);
        for (int i = bid; i < CONV_ITEMS; i += G) conv_item(p, ws, 0, i, (LAS float*)lds);
    }
    PHASE_END;
    PHASE_IF PHK(1) { const int zz = ozero(); unsigned char* ws = p.ws + zz; const int G = ogrid(), bid = obid(); (void)G; (void)bid; const float* modv = (const float*)(ws + WS_MODV); const float* modl = modv; (void)modl; norm_phase<false, true>(p, ws, p.in[zz + I_XP], p.in[zz + I_XS], nullptr, nullptr, 0, nullptr, p.in[zz + I_GPM], 0, 1024, modv); }
    PHASE_END;
#pragma unroll 1
    for (int l = 0; l < 2; ++l) {
        PHASE_IF PHK(2) { const int zz = ozero(); unsigned char* ws = p.ws + zz; const int G = ogrid(), bid = obid(); (void)G; (void)bid; const float* modv = (const float*)(ws + WS_MODV); const float* modl = modv + (size_t)l * 5 * 6144; (void)modl; pg8::Gemm g{(const bf16_t*)(ws + WS_HBF), (const bf16_t*)(ws + WS_WIN), MT, INCP, 1024}; pg8::StaticOrder S; S.init(MT, INCP, G, bid);
            EpiIn E{(float*)(ws + WS_PSM), (float*)(ws + WS_LX), (bf16_t*)(ws + WS_GG), (bf16_t*)(ws + WS_SG), (bf16_t*)(ws + WS_HF)}; pg8::gemm_phase(lds, g, S, E); }
        PHASE_END;
        PHASE_IF PHK(3) { const int zz = ozero(); unsigned char* ws = p.ws + zz; const int G = ogrid(), bid = obid(); (void)G; (void)bid; const float* modv = (const float*)(ws + WS_MODV); const float* modl = modv + (size_t)l * 5 * 6144; (void)modl; postproj_phase(p, ws, l); }
        PHASE_END;
        PHASE_IF PHK(4) { const int zz = ozero(); unsigned char* ws = p.ws + zz; const int G = ogrid(), bid = obid(); (void)G; (void)bid; const float* modv = (const float*)(ws + WS_MODV); const float* modl = modv + (size_t)l * 5 * 6144; (void)modl;
            { pg8::Gemm g{(const bf16_t*)(ws + WS_QN), (const bf16_t*)(ws + WS_WQ), MT, 768, 384}; pg8::StaticOrder S; S.init(MT, 768, G, bid);
              EpiQ E{(bf16_t*)(ws + WS_QB), (const float*)(ws + WS_ROPE), (const float*)(ws + WS_ROPE) + 1024 * 16}; pg8::gemm_phase(lds, g, S, E); }
            { pg8::Gemm g{(const bf16_t*)(ws + WS_KEYS), (const bf16_t*)(ws + WS_WKV), NKEY, 512, 256}; pg8::StaticOrder S; S.init(NKEY, 512, G, (bid + G - 144 % G) % G);
              EpiBf16 E{(bf16_t*)(ws + WS_KN), 512}; pg8::gemm_phase(lds, g, S, E); }
            { pg8::Gemm g{(const bf16_t*)(ws + WS_WKV) + (size_t)512 * 256, (const bf16_t*)(ws + WS_KEYS), 512, NKEY, 256}; pg8::StaticOrder S; S.init(512, NKEY, G, (bid + G - 248 % G) % G);
              EpiBf16 E{(bf16_t*)(ws + WS_VT), NKEY}; pg8::gemm_phase(lds, g, S, E); }
        }
        PHASE_END;
        PHASE_IF PHK(5) { const int zz = ozero(); unsigned char* ws = p.ws + zz; const int G = ogrid(), bid = obid(); (void)G; (void)bid; const float* modv = (const float*)(ws + WS_MODV); const float* modl = modv + (size_t)l * 5 * 6144; (void)modl; attn_phase(p, ws, lds); }
        PHASE_IF PHK(6) { const int zz = ozero(); unsigned char* ws = p.ws + zz; const int G = ogrid(), bid = obid(); (void)G; (void)bid; const float* modv = (const float*)(ws + WS_MODV); const float* modl = modv + (size_t)l * 5 * 6144; (void)modl; scan_phase(p, ws, l, lds); }
        PHASE_END;
        PHASE_IF PHK(7) { const int zz = ozero(); unsigned char* ws = p.ws + zz; const int G = ogrid(), bid = obid(); (void)G; (void)bid; const float* modv = (const float*)(ws + WS_MODV); const float* modl = modv + (size_t)l * 5 * 6144; (void)modl;
            { pg8::Gemm g{(const bf16_t*)(ws + WS_AO), (const bf16_t*)(ws + WS_WOMLA), MT, 1024, 512}; pg8::StaticOrder S; S.init(MT, 1024, G, bid);
              EpiMla E{(float*)(ws + WS_LX), (const bf16_t*)(ws + WS_SG)}; pg8::gemm_phase(lds, g, S, E); }
            { pg8::Gemm g{(const bf16_t*)(ws + WS_GG), (const bf16_t*)(ws + WS_WOLRU), MT, 1024, 1024}; pg8::StaticOrder S; S.init(MT, 1024, G, bid);
              EpiLru E{(const float*)(ws + WS_LX), (const bf16_t*)(ws + WS_SG), (bf16_t*)(ws + WS_Z), (const bf16_t*)(ws + WS_HF)}; pg8::gemm_phase(lds, g, S, E); }
        }
        PHASE_END;
        PHASE_IF PHK(8) { const int zz = ozero(); unsigned char* ws = p.ws + zz; const int G = ogrid(), bid = obid(); (void)G; (void)bid; const float* modv = (const float*)(ws + WS_MODV); const float* modl = modv + (size_t)l * 5 * 6144; (void)modl; pg8::Gemm g{(const bf16_t*)(ws + WS_Z), (const bf16_t*)(ws + WS_WOUT), MT, 1024, 1024}; pg8::StaticOrder S; S.init(MT, 1024, G, bid);
            EpiF32 E{(float*)(ws + WS_LX), 1024}; pg8::gemm_phase(lds, g, S, E); }
        PHASE_END;
        PHASE_IF PHK(9) { const int zz = ozero(); unsigned char* ws = p.ws + zz; const int G = ogrid(), bid = obid(); (void)G; (void)bid; const float* modv = (const float*)(ws + WS_MODV); const float* modl = modv + (size_t)l * 5 * 6144; (void)modl; const float* xp = l == 0 ? p.in[zz + I_XP] : (p.out + zz); const float* xs = l == 0 ? p.in[zz + I_XS] : (p.out + zz) + (size_t)MP * D; norm_phase<true, true>(p, ws, xp, xs, (const float*)(ws + WS_LX), p.in[zz + I_GQM] + l * D, 2048, modl, p.in[zz + I_GPF] + l * D, 3072, 4096, modl); }
        PHASE_END;
        PHASE_IF PHK(10) { const int zz = ozero(); unsigned char* ws = p.ws + zz; const int G = ogrid(), bid = obid(); (void)G; (void)bid; const float* modv = (const float*)(ws + WS_MODV); const float* modl = modv + (size_t)l * 5 * 6144; (void)modl; pg8::Gemm g{(const bf16_t*)(ws + WS_HBF), (const bf16_t*)(ws + WS_WFFI), MT, 5632, 1024}; pg8::StaticOrder S; S.init(MT, 5632, G, bid);
            EpiFfi E{(bf16_t*)(ws + WS_HID)}; pg8::gemm_phase(lds, g, S, E); }
        PHASE_END;
        PHASE_IF PHK(11) { const int zz = ozero(); unsigned char* ws = p.ws + zz; const int G = ogrid(), bid = obid(); (void)G; (void)bid; const float* modv = (const float*)(ws + WS_MODV); const float* modl = modv + (size_t)l * 5 * 6144; (void)modl; pg8::Gemm g{(const bf16_t*)(ws + WS_HID), (const bf16_t*)(ws + WS_WFFO), MT, 1024, FF}; pg8::StaticOrder S; S.init(MT, 1024, G, bid);
            EpiF32 E{(float*)(ws + WS_LX), 1024}; pg8::gemm_phase(lds, g, S, E); }
        PHASE_END;
        PHASE_IF PHK(12) { const int zz = ozero(); unsigned char* ws = p.ws + zz; const int G = ogrid(), bid = obid(); (void)G; (void)bid; const float* modv = (const float*)(ws + WS_MODV); const float* modl = modv + (size_t)l * 5 * 6144; (void)modl;
            if (l == 0) {
                norm_phase<true, true>(p, ws, (p.out + zz), (p.out + zz) + (size_t)MP * D, (const float*)(ws + WS_LX), p.in[zz + I_GQF], 5120, modl, p.in[zz + I_GPM] + D, 0, 1024, modv + (size_t)5 * 6144);
                for (int i = bid; i < CONV_ITEMS; i += G) conv_item(p, ws, 1, i, (LAS float*)lds);
            } else {
                norm_phase<true, false>(p, ws, (p.out + zz), (p.out + zz) + (size_t)MP * D, (const float*)(ws + WS_LX), p.in[zz + I_GQF] + D, 5120, modl, nullptr, 0, 0, nullptr);
            }
        }
#if ONE_LAUNCH && !defined(STOP_AFTER)
        if (l == 0) grid_sync_all();
#else
        PHASE_END;
#endif
    }
#if defined(STOP_AFTER)
    {
        const int tid = otid(), bid = obid(), G = ogrid(); const unsigned* wsu = (const unsigned*)p.ws; float* out = p.out;
        for (int i = bid * NTHREADS + tid; i < 17432576; i += G * NTHREADS) { float a = 0.f;
#pragma unroll
            for (int j = 0; j < 4; ++j) { const size_t idx = (size_t)i + (size_t)j * 17432576; if (idx * 4 < WS_END) { const unsigned u = wsu[idx]; a += (float)(u & 0xffu) + (float)((u >> 16) & 0xffu); } }
            out[i] = a; }
    }
#endif
}
constexpr int NPHASES = 2 + 11 * 2;

extern "C" void kernel_launch(void* const* d_in, const int* in_sizes, int n_in, void* d_out, int out_size, void* d_ws, size_t ws_size, hipStream_t stream) {
    static int grid = 0;
    if (grid == 0) {
        if (n_in != 31 || ws_size < WS_END) { fprintf(stderr, "kernel_launch: need 31 inputs and %zu bytes of workspace (got %d, %zu)\n", (size_t)WS_END, n_in, ws_size); grid = -1; return; }
        if (hipFuncSetAttribute((const void*)fwd_megakernel, hipFuncAttributeMaxDynamicSharedMemorySize, LDS_BYTES) != hipSuccess) { fprintf(stderr, "kernel_launch: hipFuncSetAttribute failed\n"); grid = -1; return; }
        int dev = 0, cus = 0, per_cu = 0;
        hipGetDevice(&dev); hipDeviceGetAttribute(&cus, hipDeviceAttributeMultiprocessorCount, dev);
        hipOccupancyMaxActiveBlocksPerMultiprocessor(&per_cu, (const void*)fwd_megakernel, NTHREADS, LDS_BYTES);
        if (per_cu < 1) { fprintf(stderr, "kernel_launch: occupancy query says %d blocks/CU\n", per_cu); per_cu = 1; }
        (void)hipGetLastError();
        grid = cus;
    }
    if (grid < 0) return;
    Params p{};
    for (int i = 0; i < 31; ++i) p.in[i] = (const float*)d_in[i];
    p.out = (float*)d_out; p.ws = (unsigned char*)d_ws;
#if ONE_LAUNCH
    p.ph_lo = 0; p.ph_hi = NPHASES; p.coop = 1;
    void* args[] = {&p};
    hipError_t e = hipLaunchCooperativeKernel((const void*)fwd_megakernel, dim3(grid), dim3(NTHREADS), args, LDS_BYTES, stream);
    if (e != hipSuccess) fprintf(stderr, "cooperative launch failed: %s (grid %d)\n", hipGetErrorString(e), grid);
#else
    for (int ph = 0; ph < NPHASES; ++ph) {
        p.ph_lo = ph; p.ph_hi = ph + 1; p.coop = 0;
        hipLaunchKernelGGL(fwd_megakernel, dim3(grid), dim3(NTHREADS), LDS_BYTES, stream, p);
    }
#endif
}
```

```cpp
#include <hip/hip_runtime.h>
#include <hip/hip_cooperative_groups.h>
#include <cstdio>
namespace cg = cooperative_groups;

#ifndef ONE_LAUNCH
#define ONE_LAUNCH 1
#endif

#ifndef PHMASK
#define PHMASK 0xffff
#endif
#define PHK(k) if constexpr (((PHMASK) >> (k)) & 1)
#ifndef LSCALE
#define LSCALE 1.0f
#endif
#ifndef MSCALE
#define MSCALE 1.0f
#endif
#ifndef FSCALE
#define FSCALE 1.0f
#endif
#ifndef OS0
#define OS0 1.0f
#endif
#ifndef OS1
#define OS1 1.0f
#endif
#ifndef OS2
#define OS2 1.0f
#endif
#ifndef OS3
#define OS3 1.0f
#endif
#ifndef OS4
#define OS4 1.0f
#endif
#ifndef OS5
#define OS5 1.0f
#endif
#ifndef ZMASK
#define ZMASK(row, col) false
#endif
#ifndef HSCALE
#define HSCALE 1.0f
#endif
#ifndef BSCALE
#define BSCALE 1.0f
#endif
#ifndef GGVAL
#define GGVAL(x) (x)
#endif
#ifndef GLVAL
#define GLVAL(x) (x)
#endif
#ifndef GLOFF
#define GLOFF 1024
#endif
#ifndef ZSCALE
#define ZSCALE 1.0f
#endif
#define LAS __attribute__((address_space(3)))
typedef unsigned short bf16_t;
typedef short bf16x8 __attribute__((ext_vector_type(8)));
typedef float f32x4 __attribute__((ext_vector_type(4)));
typedef float f32x2 __attribute__((ext_vector_type(2)));
typedef unsigned u32x4 __attribute__((ext_vector_type(4)));
typedef unsigned u32x2 __attribute__((ext_vector_type(2)));

constexpr int D = 1024, MT = 12288, MP = 8192, NKEY = 13312, FF = 2816;
constexpr int INCP = 4864;
constexpr int NTHREADS = 512, LDS_BYTES = 131072;
constexpr float EPS = 1e-6f;
constexpr float LOG2E = 1.4426950408889634f;
constexpr float QSCALE = 0.10206207261596577f * 1.4426950408889634f;

constexpr size_t OFF_CKV = 12582912, OFF_KR = 16777216, OFF_LF = 17301504, OFF_LB = 17367040;

constexpr size_t WS_MODV = 0;
constexpr size_t WS_ROPE = WS_MODV + 2 * 5 * 6144 * 4;
constexpr size_t WS_WIN = WS_ROPE + 2 * 1024 * 16 * 4;
constexpr size_t WS_WFFI = WS_WIN + (size_t)INCP * 1024 * 2;
constexpr size_t WS_WFFO = WS_WFFI + (size_t)5632 * 1024 * 2;
constexpr size_t WS_WOUT = WS_WFFO + (size_t)1024 * 2816 * 2;
constexpr size_t WS_WOLRU = WS_WOUT + (size_t)1024 * 1024 * 2;
constexpr size_t WS_WOMLA = WS_WOLRU + (size_t)1024 * 1024 * 2;
constexpr size_t WS_WQ = WS_WOMLA + (size_t)1024 * 512 * 2;
constexpr size_t WS_WKV = WS_WQ + (size_t)768 * 384 * 2;
constexpr size_t WS_WG = WS_WKV + (size_t)1024 * 256 * 2;
constexpr size_t WS_HBF = WS_WG + (size_t)2 * 8 * 256 * 128 * 2;
constexpr size_t WS_QN = WS_HBF;
constexpr size_t WS_KEYS = WS_QN + (size_t)MT * 384 * 2;
constexpr size_t WS_KRB = WS_KEYS + (size_t)NKEY * 256 * 2;
constexpr size_t WS_AO = WS_HBF;
constexpr size_t WS_PSM = WS_HBF + (size_t)MT * 1024 * 2;
constexpr size_t WS_QB = WS_PSM;
constexpr size_t WS_KN = WS_QB + (size_t)MT * 768 * 2;
constexpr size_t WS_Z = WS_PSM;
constexpr size_t WS_LX = WS_PSM + (size_t)MT * 768 * 4;
constexpr size_t WS_GG = WS_LX + (size_t)MT * 1024 * 4;
constexpr size_t WS_SG = WS_GG + (size_t)MT * 1024 * 2;
constexpr size_t WS_HID = WS_GG;
constexpr size_t WS_VT = WS_SG + (size_t)MT * 2048 * 2;
constexpr size_t WS_HF = WS_VT + (size_t)512 * NKEY * 2;
constexpr size_t WS_BAR = WS_HF + (size_t)MT * 1024 * 2;
constexpr size_t WS_END = WS_BAR + 256;

struct Params {
    const float* in[31];
    float* out;
    unsigned char* ws;
    int ph_lo, ph_hi, coop, pad;
};
enum { I_XP = 0, I_XS, I_CCKV, I_CKR, I_SF, I_SB, I_C, I_CCTX, I_WMOD, I_BMOD, I_GPM, I_GQM, I_GPF, I_GQF, I_WIN, I_GQ, I_WQUP, I_GKV,
       I_WKVUP, I_WOMLA, I_CONVW, I_CONVB, I_WRG, I_BRG, I_WIG, I_BIG, I_LAM, I_WOLRU, I_WOUT, I_WFFI, I_WFFO };

__device__ __forceinline__ unsigned char* opq(unsigned char* x) { asm volatile("" : "+s"(x)); return x; }
__device__ __forceinline__ int ozero() { int t = 0; asm volatile("" : "+s"(t)); return t; }
__device__ __forceinline__ int otid() { int t = threadIdx.x; asm volatile("" : "+v"(t)); return t; }
__device__ __forceinline__ int obid() { int t = blockIdx.x; asm volatile("" : "+s"(t)); return t; }
__device__ __forceinline__ int ogrid() { int t = gridDim.x; asm volatile("" : "+s"(t)); return t; }
__device__ __forceinline__ unsigned cvt_pk_bf16(float lo, float hi) { unsigned r; asm volatile("v_cvt_pk_bf16_f32 %0, %1, %2" : "=v"(r) : "v"(lo), "v"(hi)); return r; }
__device__ __forceinline__ float bf2f(bf16_t b) { return __uint_as_float(((unsigned)b) << 16); }
__device__ __forceinline__ bf16_t f2bf(float f) { return (bf16_t)(cvt_pk_bf16(f, 0.f) & 0xffffu); }
__device__ __forceinline__ float shfl_idx(float v, int srclane) { return __int_as_float(__builtin_amdgcn_ds_bpermute(srclane << 2, __float_as_int(v))); }
__device__ __forceinline__ float wave_sum(float v, int lane) {
#pragma unroll
    for (int o = 32; o >= 1; o >>= 1) v += shfl_idx(v, lane ^ o);
    return v;
}
__device__ __forceinline__ float fast_sigmoid(float x) { return __builtin_amdgcn_rcpf(1.0f + __builtin_amdgcn_exp2f(-x * LOG2E)); }
__device__ __forceinline__ float gelu_tanh(float x) { const float z = 1.5957691216057308f * (x + 0.044715f * x * x * x); return x * fast_sigmoid(z); }
__device__ __forceinline__ int keyrow_of(int t) { return t < MP ? t : MP + ((t - MP) >> 10) * 1280 + ((t - MP) & 1023); }

namespace pg8 {
constexpr int BM = 256, BK = 64, HALF = 128, HTB = HALF * BK * 2, NXCD = 8, WGM = 8;
__device__ __forceinline__ int lds_byte(int r, int c) { const int st = (r >> 4) * 2 + (c >> 5), rr = r & 15, cc = c & 31, ob = rr * 64 + cc * 2; return st * 1024 + (ob ^ (((ob >> 9) & 1) << 5)); }
__device__ __forceinline__ void stage_rc(int b, int& R, int& C) { const int st = b / 1024, sb = b % 1024, swz = sb ^ (((sb >> 9) & 1) << 5); R = (st >> 1) * 16 + swz / 64; C = (st & 1) * 32 + (swz % 64) / 2; }
__device__ __forceinline__ int perm32(int rho) { const int n = rho >> 4, i = rho & 15; return 8 * (i >> 2) + 4 * n + (i & 3); }
struct Unit { int pm, pn; };
struct Gemm { const bf16_t* A; const bf16_t* Bt; int M, N, K; };
struct StaticOrder {
    int nM, nN, nwg, G, c;
    __device__ void init(int M, int N, int G_, int c_) { nM = M / BM; nN = N / BM; nwg = nM * nN; G = G_; c = c_; }
    __device__ bool next(int i, Unit& u) const {
        const int L = i * G + c; if (L >= nwg) return false;
        int wgid = L; { const int q = nwg / NXCD, r = nwg % NXCD, xcd = wgid % NXCD, off = wgid / NXCD; wgid = (xcd < r ? xcd * (q + 1) : r * (q + 1) + (xcd - r) * q) + off; }
        const int nig = WGM * nN, gid = wgid / nig, fm = gid * WGM, gsz = (nM - fm) < WGM ? (nM - fm) : WGM;
        u.pm = fm + ((wgid % nig) % gsz); u.pn = (wgid % nig) / gsz; return true;
    }
};
template <class Epi>
__device__ __forceinline__ void gemm_phase(LAS unsigned char* lds, const Gemm g, const StaticOrder& S, const Epi& E) {
    int tid_ = threadIdx.x; asm volatile("" : "+v"(tid_));
    const int tid = tid_, wid = __builtin_amdgcn_readfirstlane(tid >> 6), lane = tid & 63, wr = wid >> 2, wc = wid & 3, fr = lane & 15, fq = lane >> 4;
    const int K = g.K, nt = K / BK;
    unsigned voffA[2], voffB[2];
#pragma unroll
    for (int i = 0; i < 2; ++i) { int R, C; stage_rc(tid * 16 + i * 8192, R, C); const int Rb = Epi::PERM ? ((R & ~31) + perm32(R & 31)) : R;
        voffA[i] = (unsigned)(R * K + C) * 2u; voffB[i] = (unsigned)(Rb * K + C) * 2u; }
    const size_t kstep = (size_t)(BK * 2);
    const size_t hstep = (size_t)HALF * K * 2;
    const size_t tstep = 2 * hstep;
    const unsigned ldsw = (unsigned)wid * 1024u;
    const int aoff = lds_byte(wr * 64 + fr, fq * 8), boff = lds_byte(wc * 32 + fr, fq * 8);
#define PG8_SA(b, h) (((b) * 2 + (h)) * HTB)
#define PG8_SB(b, h) ((4 + (b) * 2 + (h)) * HTB)
#define PG8_STAGE(bufoff, gbase, voff) do { _Pragma("unroll") for (int _i = 0; _i < 2; ++_i) \
        __builtin_amdgcn_global_load_lds((const unsigned*)((const char*)(gbase) + (voff)[_i]), (LAS unsigned*)(lds + (bufoff) + ldsw + _i * 8192), 16, 0, 0); } while (0)
#define PG8_LDA(dst, b, h) do { _Pragma("unroll") for (int m = 0; m < 4; ++m) _Pragma("unroll") for (int k = 0; k < 2; ++k) dst[m][k] = *(const LAS bf16x8*)(lds + PG8_SA(b, h) + aoff + m * 2048 + k * 1024); } while (0)
#define PG8_LDB(dst, b, h) do { _Pragma("unroll") for (int n = 0; n < 2; ++n) _Pragma("unroll") for (int k = 0; k < 2; ++k) dst[n][k] = *(const LAS bf16x8*)(lds + PG8_SB(b, h) + boff + n * 2048 + k * 1024); } while (0)
#define PG8_MMA(ai, bj, At, Bt) do { __builtin_amdgcn_s_setprio(1); _Pragma("unroll") for (int m = 0; m < 4; ++m) _Pragma("unroll") for (int n = 0; n < 2; ++n) _Pragma("unroll") for (int k = 0; k < 2; ++k) \
        acc[ai][bj][m][n] = __builtin_amdgcn_mfma_f32_16x16x32_bf16(Bt[n][k], At[m][k], acc[ai][bj][m][n], 0, 0, 0); __builtin_amdgcn_s_setprio(0); } while (0)
#define PG8_WAIT_V(n) asm volatile("s_waitcnt vmcnt(" #n ")" ::: "memory")
#define PG8_WAIT_L(n) asm volatile("s_waitcnt lgkmcnt(" #n ")" ::: "memory")
#define PG8_BAR __builtin_amdgcn_s_barrier()
#define PG8_SCHED __builtin_amdgcn_sched_barrier(0)
    Unit cur, nxt; int ui = 0;
    if (!S.next(0, cur)) return;
    f32x4 acc[2][2][4][2];
#pragma unroll
    for (int a = 0; a < 2; ++a)
#pragma unroll
        for (int b = 0; b < 2; ++b)
#pragma unroll
            for (int m = 0; m < 4; ++m)
#pragma unroll
                for (int n = 0; n < 2; ++n) acc[a][b][m][n] = (f32x4){0.f, 0.f, 0.f, 0.f};
    bf16x8 At[4][2], B0[2][2], B1[2][2];
    const char* cA = (const char*)g.A + (size_t)cur.pm * tstep; const char* cB = (const char*)g.Bt + (size_t)cur.pn * tstep;
    PG8_STAGE(PG8_SB(0, 0), cB, voffB); PG8_STAGE(PG8_SA(0, 0), cA, voffA); PG8_STAGE(PG8_SB(0, 1), cB + hstep, voffB); PG8_STAGE(PG8_SA(0, 1), cA + hstep, voffA);
    if (wr == 1) PG8_BAR;
    PG8_WAIT_V(4); PG8_BAR;
    PG8_STAGE(PG8_SB(1, 0), cB + kstep, voffB); PG8_STAGE(PG8_SA(1, 0), cA + kstep, voffA); PG8_STAGE(PG8_SB(1, 1), cB + hstep + kstep, voffB);
    PG8_WAIT_V(6); PG8_BAR;
    for (;;) {
        const bool has_next = S.next(ui + 1, nxt);
        const char* nA = has_next ? (const char*)g.A + (size_t)nxt.pm * tstep : cA; const char* nB = has_next ? (const char*)g.Bt + (size_t)nxt.pn * tstep : cB;
        for (int t = 0; t < nt; t += 2) {
            const bool last = (t == nt - 2);
            const char* a1 = cA + (size_t)(t + 1) * kstep;
            const char* a2 = last ? nA : cA + (size_t)(t + 2) * kstep; const char* b2 = last ? nB : cB + (size_t)(t + 2) * kstep;
            const char* a3 = a2 + kstep; const char* b3 = b2 + kstep;
            PG8_LDB(B0, 0, 0); PG8_SCHED; PG8_LDA(At, 0, 0); PG8_STAGE(PG8_SA(1, 1), a1 + hstep, voffA);
            PG8_WAIT_L(8); PG8_BAR; PG8_WAIT_L(0); PG8_MMA(0, 0, At, B0); PG8_BAR; PG8_SCHED;
            PG8_LDB(B1, 0, 1); PG8_STAGE(PG8_SB(0, 0), b2, voffB);
            PG8_BAR; PG8_WAIT_L(0); PG8_MMA(0, 1, At, B1); PG8_BAR;
            PG8_LDA(At, 0, 1); PG8_STAGE(PG8_SA(0, 0), a2, voffA);
            PG8_BAR; PG8_WAIT_L(0); PG8_MMA(1, 0, At, B0); PG8_BAR; PG8_SCHED;
            PG8_STAGE(PG8_SB(0, 1), b2 + hstep, voffB);
            PG8_WAIT_V(6); PG8_BAR; PG8_MMA(1, 1, At, B1); PG8_BAR;
            PG8_LDB(B0, 1, 0); PG8_SCHED; PG8_LDA(At, 1, 0); PG8_STAGE(PG8_SA(0, 1), a2 + hstep, voffA);
            PG8_WAIT_L(8); PG8_BAR; PG8_WAIT_L(0); PG8_MMA(0, 0, At, B0); PG8_BAR; PG8_SCHED;
            PG8_LDB(B1, 1, 1); PG8_STAGE(PG8_SB(1, 0), b3, voffB);
            PG8_BAR; PG8_WAIT_L(0); PG8_MMA(0, 1, At, B1); PG8_BAR;
            PG8_LDA(At, 1, 1); PG8_STAGE(PG8_SA(1, 0), a3, voffA);
            PG8_BAR; PG8_WAIT_L(0); PG8_MMA(1, 0, At, B0); PG8_BAR; PG8_SCHED;
            PG8_STAGE(PG8_SB(1, 1), b3 + hstep, voffB);
            PG8_WAIT_V(6); PG8_BAR; PG8_MMA(1, 1, At, B1); PG8_BAR;
        }
        E(acc, cur, wr, wc, fr, fq);
        if (!has_next) break;
#pragma unroll
        for (int a = 0; a < 2; ++a)
#pragma unroll
            for (int b = 0; b < 2; ++b)
#pragma unroll
                for (int m = 0; m < 4; ++m)
#pragma unroll
                    for (int n = 0; n < 2; ++n) acc[a][b][m][n] = (f32x4){0.f, 0.f, 0.f, 0.f};
        cur = nxt; cA = nA; cB = nB; ++ui;
    }
    PG8_WAIT_V(0);
    if (wr == 0) PG8_BAR;
    PG8_BAR;
#undef PG8_SA
#undef PG8_SB
#undef PG8_STAGE
#undef PG8_LDA
#undef PG8_LDB
#undef PG8_MMA
#undef PG8_WAIT_V
#undef PG8_WAIT_L
#undef PG8_BAR
#undef PG8_SCHED
}
}
using pg8::Unit;
typedef f32x4 AccT[2][2][4][2];

__device__ __forceinline__ u32x4 pack8(f32x4 a, f32x4 b) { u32x4 w; w.x = cvt_pk_bf16(a[0], a[1]); w.y = cvt_pk_bf16(a[2], a[3]); w.z = cvt_pk_bf16(b[0], b[1]); w.w = cvt_pk_bf16(b[2], b[3]); return w; }
__device__ __forceinline__ u32x2 pack4(f32x4 a) { u32x2 w; w.x = cvt_pk_bf16(a[0], a[1]); w.y = cvt_pk_bf16(a[2], a[3]); return w; }
__device__ __forceinline__ void unpack8(u32x4 w, f32x4& a, f32x4& b) {
    a[0] = __uint_as_float(w.x << 16); a[1] = __uint_as_float(w.x & 0xffff0000u); a[2] = __uint_as_float(w.y << 16); a[3] = __uint_as_float(w.y & 0xffff0000u);
    b[0] = __uint_as_float(w.z << 16); b[1] = __uint_as_float(w.z & 0xffff0000u); b[2] = __uint_as_float(w.w << 16); b[3] = __uint_as_float(w.w & 0xffff0000u);
}

struct EpiIn {
    static constexpr bool PERM = true;
    float* psm; float* lx; bf16_t* gg; bf16_t* sg; bf16_t* g2;
    __device__ __forceinline__ void operator()(const AccT& acc, const Unit& u, int wr, int wc, int fr, int fq) const {
        const int row0 = u.pm * 256 + wr * 64 + fr, colb = u.pn * 256 + wc * 32 + 8 * fq;
#pragma unroll
        for (int ai = 0; ai < 2; ++ai)
#pragma unroll
            for (int m = 0; m < 4; ++m) {
                const size_t row = (size_t)(row0 + ai * 128 + m * 16);
#pragma unroll
                for (int bj = 0; bj < 2; ++bj) {
                    const int col = colb + bj * 128; f32x4 v0 = acc[ai][bj][m][0], v1 = acc[ai][bj][m][1];
                    if (u.pn < 3) { float* q = psm + row * 768 + col; *(f32x4*)q = v0; *(f32x4*)(q + 4) = v1; }
                    else if (u.pn < 7) { float* q = lx + row * 1024 + (col - 768); *(f32x4*)q = v0; *(f32x4*)(q + 4) = v1; }
                    else if (u.pn < 11) {
#pragma unroll
                        for (int j = 0; j < 4; ++j) { v0[j] = gelu_tanh(v0[j]); v1[j] = gelu_tanh(v1[j]); }
                        *(u32x4*)(gg + row * 1024 + (col - 1792)) = pack8(v0, v1); }
                    else {
#pragma unroll
                        for (int j = 0; j < 4; ++j) { v0[j] = fast_sigmoid(v0[j]); v1[j] = fast_sigmoid(v1[j]); }
                        *(u32x4*)(sg + row * 2048 + (col - 2816)) = pack8(v0, v1);
                        if (u.pn >= 15) *(u32x4*)(g2 + row * 1024 + (col - 3840)) = pack8(v0, v1); }
                }
            }
    }
};
struct EpiQ {
    static constexpr bool PERM = false;
    bf16_t* q; const float* ropec; const float* ropes;
    __device__ __forceinline__ void operator()(const AccT& acc, const Unit& u, int wr, int wc, int fr, int fq) const {
        const int row0 = u.pm * 256 + wr * 64 + fr;
#pragma unroll
        for (int ai = 0; ai < 2; ++ai)
#pragma unroll
            for (int m = 0; m < 4; ++m) {
                const int row = row0 + ai * 128 + m * 16; const bool lat = row >= MP; const int pos = (row - MP) & 1023;
#pragma unroll
                for (int bj = 0; bj < 2; ++bj) {
                    const int base = u.pn * 256 + bj * 128 + wc * 32; const bool rope = lat && (((base >> 5) % 3) == 2);
                    f32x4 v0 = acc[ai][bj][m][0], v1 = acc[ai][bj][m][1];
                    if (rope) { const f32x4 cs = *(const f32x4*)(ropec + pos * 16 + 4 * fq), sn = *(const f32x4*)(ropes + pos * 16 + 4 * fq);
                        const f32x4 o0 = v0 * cs - v1 * sn, o1 = v0 * sn + v1 * cs; v0 = o0; v1 = o1; }
                    v0 *= QSCALE; v1 *= QSCALE;
                    bf16_t* dst = q + (size_t)row * 768 + base + 4 * fq;
                    *(u32x2*)dst = pack4(v0); *(u32x2*)(dst + 16) = pack4(v1);
                }
                asm volatile("" ::: "memory");
            }
    }
};
struct EpiBf16 {
    static constexpr bool PERM = true;
    bf16_t* o; int ldc;
    __device__ __forceinline__ void operator()(const AccT& acc, const Unit& u, int wr, int wc, int fr, int fq) const {
        const int row0 = u.pm * 256 + wr * 64 + fr, colb = u.pn * 256 + wc * 32 + 8 * fq;
#pragma unroll
        for (int ai = 0; ai < 2; ++ai)
#pragma unroll
            for (int m = 0; m < 4; ++m) {
                const size_t row = (size_t)(row0 + ai * 128 + m * 16);
#pragma unroll
                for (int bj = 0; bj < 2; ++bj) *(u32x4*)(o + row * ldc + colb + bj * 128) = pack8(acc[ai][bj][m][0], acc[ai][bj][m][1]);
            }
    }
};
struct EpiF32 {
    static constexpr bool PERM = true;
    float* o; int ldc;
    __device__ __forceinline__ void operator()(const AccT& acc, const Unit& u, int wr, int wc, int fr, int fq) const {
        const int row0 = u.pm * 256 + wr * 64 + fr, colb = u.pn * 256 + wc * 32 + 8 * fq;
#pragma unroll
        for (int ai = 0; ai < 2; ++ai)
#pragma unroll
            for (int m = 0; m < 4; ++m) {
                const size_t row = (size_t)(row0 + ai * 128 + m * 16);
#pragma unroll
                for (int bj = 0; bj < 2; ++bj) { float* q = o + row * ldc + colb + bj * 128; *(f32x4*)q = acc[ai][bj][m][0]; *(f32x4*)(q + 4) = acc[ai][bj][m][1]; }
            }
    }
};
struct EpiMla {
    static constexpr bool PERM = true;
    float* z1; const bf16_t* sg;
    __device__ __forceinline__ void operator()(const AccT& acc, const Unit& u, int wr, int wc, int fr, int fq) const {
        const int row0 = u.pm * 256 + wr * 64 + fr, colb = u.pn * 256 + wc * 32 + 8 * fq;
#pragma unroll
        for (int ai = 0; ai < 2; ++ai)
#pragma unroll
            for (int m = 0; m < 4; ++m) {
                const size_t row = (size_t)(row0 + ai * 128 + m * 16);
#pragma unroll
                for (int bj = 0; bj < 2; ++bj) { const int col = colb + bj * 128; f32x4 g0, g1; unpack8(*(const u32x4*)(sg + row * 2048 + col), g0, g1);
                    float* q = z1 + row * 1024 + col; *(f32x4*)q = acc[ai][bj][m][0] * g0 * ZSCALE; *(f32x4*)(q + 4) = acc[ai][bj][m][1] * g1 * ZSCALE; }
                asm volatile("" ::: "memory");
            }
    }
};
struct EpiLru {
    static constexpr bool PERM = true;
    const float* z1; const bf16_t* sg; bf16_t* z; const bf16_t* g2;
    __device__ __forceinline__ void operator()(const AccT& acc, const Unit& u, int wr, int wc, int fr, int fq) const {
        const int row0 = u.pm * 256 + wr * 64 + fr, colb = u.pn * 256 + wc * 32 + 8 * fq;
#pragma unroll
        for (int ai = 0; ai < 2; ++ai)
#pragma unroll
            for (int m = 0; m < 4; ++m) {
                const size_t row = (size_t)(row0 + ai * 128 + m * 16);
#pragma unroll
                for (int bj = 0; bj < 2; ++bj) { const int col = colb + bj * 128; f32x4 g0, g1; unpack8(*(const u32x4*)(g2 + row * 1024 + col), g0, g1);
                    const float* q = z1 + row * 1024 + col; const f32x4 a0 = *(const f32x4*)q + acc[ai][bj][m][0] * GLVAL(g0) * LSCALE, a1 = *(const f32x4*)(q + 4) + acc[ai][bj][m][1] * GLVAL(g1) * LSCALE;
                    *(u32x4*)(z + row * 1024 + col) = pack8(a0, a1); }
                asm volatile("" ::: "memory");
            }
    }
};
struct EpiFfi {
    static constexpr bool PERM = false;
    bf16_t* hid;
    __device__ __forceinline__ void operator()(const AccT& acc, const Unit& u, int wr, int wc, int fr, int fq) const {
        const int row0 = u.pm * 256 + wr * 64 + fr;
#pragma unroll
        for (int ai = 0; ai < 2; ++ai)
#pragma unroll
            for (int m = 0; m < 4; ++m) {
                const size_t row = (size_t)(row0 + ai * 128 + m * 16);
#pragma unroll
                for (int bj = 0; bj < 2; ++bj) { const int hc = ((u.pn * 256 + bj * 128 + wc * 32) >> 1) + 4 * fq; const f32x4 gv = acc[ai][bj][m][0], uv = acc[ai][bj][m][1]; f32x4 h;
#pragma unroll
                    for (int j = 0; j < 4; ++j) h[j] = gv[j] * fast_sigmoid(gv[j]) * uv[j];
                    *(u32x2*)(hid + row * FF + hc) = pack4(h); }
            }
    }
};

__device__ __forceinline__ int map_row(int mode, int n) {
    if (mode == 1) return n < 672 ? n : n + 96;
    if (mode == 2) { const int up = n >= FF, j = up ? n - FF : n; return (j >> 4) * 32 + (j & 15) + (up ? 16 : 0); }
    if (mode == 3) { const int h = n >> 7, r = n & 127; return r < 64 ? h * 64 + r : 512 + h * 64 + (r - 64); }
    return n;
}
__device__ __forceinline__ void conv_tile(const float* src, int ld, int K, int k0, int n0, bf16_t* dst, int mode, LAS float* tile) {
    const int tid = otid();
    __syncthreads();
#pragma unroll
    for (int i = 0; i < 2; ++i) { const int kk = (tid >> 3) + 64 * i, c4 = (tid & 7) * 4; const f32x4 v = *(const f32x4*)(src + (size_t)(k0 + kk) * ld + n0 + c4);
        tile[kk * 33 + c4] = v[0]; tile[kk * 33 + c4 + 1] = v[1]; tile[kk * 33 + c4 + 2] = v[2]; tile[kk * 33 + c4 + 3] = v[3]; }
    __syncthreads();
    const int n = tid >> 4, k8 = (tid & 15) * 8; f32x4 a, b;
#pragma unroll
    for (int j = 0; j < 4; ++j) { a[j] = tile[(k8 + j) * 33 + n]; b[j] = tile[(k8 + 4 + j) * 33 + n]; }
    *(u32x4*)(dst + (size_t)map_row(mode, n0 + n) * K + k0 + k8) = pack8(a, b);
}
constexpr int CONV_ITEMS = 4208;
__device__ __forceinline__ void conv_item(const Params& p, unsigned char* ws, int l, int idx, LAS float* tile) {
    const int zz = ozero();
    int inidx, K, N, mode = 0; size_t soff, doff;
    if (idx < 1192) { inidx = I_WIN; soff = (size_t)l * 1024 * 4768; doff = WS_WIN; K = 1024; N = 4768; mode = 1; }
    else if ((idx -= 1192) < 1408) { inidx = I_WFFI; soff = (size_t)l * 1024 * 5632; doff = WS_WFFI; K = 1024; N = 5632; mode = 2; }
    else if ((idx -= 1408) < 704) { inidx = I_WFFO; soff = (size_t)l * 2816 * 1024; doff = WS_WFFO; K = 2816; N = 1024; }
    else if ((idx -= 704) < 256) { inidx = I_WOUT; soff = (size_t)l * 1024 * 1024; doff = WS_WOUT; K = 1024; N = 1024; }
    else if ((idx -= 256) < 256) { inidx = I_WOLRU; soff = (size_t)l * 1024 * 1024; doff = WS_WOLRU; K = 1024; N = 1024; }
    else if ((idx -= 256) < 128) { inidx = I_WOMLA; soff = (size_t)l * 512 * 1024; doff = WS_WOMLA; K = 512; N = 1024; }
    else if ((idx -= 128) < 72) { inidx = I_WQUP; soff = (size_t)l * 384 * 768; doff = WS_WQ; K = 384; N = 768; }
    else if ((idx -= 72) < 64) { inidx = I_WKVUP; soff = (size_t)l * 256 * 1024; doff = WS_WKV; K = 256; N = 1024; mode = 3; }
    else { idx -= 64; const int mat = idx >> 2, ig = mat >> 4, dir = (mat >> 3) & 1, n = mat & 7;
        inidx = ig ? I_WIG : I_WRG; soff = (size_t)((l * 2 + dir) * 8 + n) * 16384; doff = WS_WG + (size_t)((dir * 8 + n) * 256 + ig * 128) * 128 * 2; K = 128; N = 128; idx &= 3; }
    const float* src = p.in[zz + inidx] + soff; bf16_t* dst = (bf16_t*)(ws + doff);
    const int nk = K / 128, kt = idx % nk, ntile = idx / nk;
    conv_tile(src, N, K, kt * 128, ntile * 32, dst, mode, tile);
}
__device__ __forceinline__ void modv_phase(const Params& p, unsigned char* ws, LAS float* lds) {
    const int zz = ozero();
    LAS float* sc = lds + 128 * 33;
    LAS float* red = sc + 5 * 1024;
    const int tid = otid();
    __syncthreads();
    for (int i = tid; i < 5 * 1024; i += NTHREADS) { const float c = i < 1024 ? p.in[zz + I_CCTX][i] : p.in[zz + I_C][i - 1024]; sc[i] = c / (1.0f + __expf(-c)); }
    __syncthreads();
    float* modv = (float*)(ws + WS_MODV); const int bid = obid(), G = ogrid();
    const int col = tid & 31, kg = tid >> 5;
    for (int it = bid; it < 384; it += G) {
        const int l = it / 192, j0 = (it % 192) * 32;
        const float* w = p.in[zz + I_WMOD] + (size_t)l * 1024 * 6144 + j0 + col;
        float a0 = 0.f, a1 = 0.f, a2 = 0.f, a3 = 0.f, a4 = 0.f;
#pragma unroll 8
        for (int k = kg * 64; k < kg * 64 + 64; ++k) { const float wv = w[(size_t)k * 6144]; a0 += sc[k] * wv; a1 += sc[1024 + k] * wv; a2 += sc[2048 + k] * wv; a3 += sc[3072 + k] * wv; a4 += sc[4096 + k] * wv; }
        red[(kg * 5 + 0) * 32 + col] = a0; red[(kg * 5 + 1) * 32 + col] = a1; red[(kg * 5 + 2) * 32 + col] = a2; red[(kg * 5 + 3) * 32 + col] = a3; red[(kg * 5 + 4) * 32 + col] = a4;
        __syncthreads();
        if (tid < 160) { const int v = tid >> 5, c = tid & 31; float s = p.in[zz + I_BMOD][l * 6144 + j0 + c];
#pragma unroll
            for (int g = 0; g < 16; ++g) s += red[(g * 5 + v) * 32 + c];
            modv[(size_t)(l * 5 + v) * 6144 + j0 + c] = s; }
        __syncthreads();
    }
}
__device__ __forceinline__ void rope_table(const Params& p, unsigned char* ws) {
    const int zz = ozero();
    float* rc = (float*)(ws + WS_ROPE); float* rs = rc + 1024 * 16;
    const int G = ogrid(); for (int i = obid() * NTHREADS + otid(); i < 1024 * 16; i += G * NTHREADS) {
        const int pos = i >> 4, f = i & 15; const float posv = (float)(f < 8 ? (pos >> 6) : (pos & 63));
        const float inv = exp2f(-(float)(f & 7) * (13.287712379549449f / 8.0f));
        const float rev = posv * inv * 0.15915494309189535f;
        rc[i] = __builtin_amdgcn_cosf(rev); rs[i] = __builtin_amdgcn_sinf(rev);
    }
}

template <bool HAS_Y, bool DO_H>
__device__ __forceinline__ void norm_phase(const Params& p, unsigned char* ws, const float* xp, const float* xs, const float* Y, const float* gA, int gate_off, const float* modA,
                                           const float* gB, int sh_off, int sc_off, const float* modB) {
    const int zz = ozero();
    const int tid = otid(), wid = tid >> 6, lane = tid & 63; const int bid = obid(), G = ogrid();
    bf16_t* hbf = (bf16_t*)(ws + WS_HBF);
    for (int row = bid * 8 + wid; row < MT; row += G * 8) {
        const int mv = row < MP ? 0 : 1 + ((row - MP) >> 10);
        const float* xin = row < MP ? xp + (size_t)row * D : xs + (size_t)(row - MP) * D;
        f32x4 x[4];
#pragma unroll
        for (int i = 0; i < 4; ++i) x[i] = *(const f32x4*)(xin + i * 256 + lane * 4);
        if (HAS_Y) {
            f32x4 y[4]; float ss = 0.f;
#pragma unroll
            for (int i = 0; i < 4; ++i) { y[i] = *(const f32x4*)(Y + (size_t)row * D + i * 256 + lane * 4); ss += y[i][0] * y[i][0] + y[i][1] * y[i][1] + y[i][2] * y[i][2] + y[i][3] * y[i][3]; }
            ss = wave_sum(ss, lane); const float rstd = rsqrtf(ss * (1.0f / D) + EPS);
            const float* mg = modA + (size_t)mv * 6144 + gate_off;
#pragma unroll
            for (int i = 0; i < 4; ++i) { const f32x4 g = *(const f32x4*)(gA + i * 256 + lane * 4), gt = *(const f32x4*)(mg + i * 256 + lane * 4);
                x[i] = x[i] + gt * (y[i] * rstd * g) * (gate_off == 2048 ? MSCALE : FSCALE); *(f32x4*)((p.out + zz) + (size_t)row * D + i * 256 + lane * 4) = DO_H ? x[i] : x[i] * (row < MP ? (ZMASK(row, i * 256 + lane * 4) ? 0.0f : OS0) : OS1); }
        }
        if (DO_H) {
            float ss = 0.f;
#pragma unroll
            for (int i = 0; i < 4; ++i) ss += x[i][0] * x[i][0] + x[i][1] * x[i][1] + x[i][2] * x[i][2] + x[i][3] * x[i][3];
            ss = wave_sum(ss, lane); const float rstd = rsqrtf(ss * (1.0f / D) + EPS);
            const float* msh = modB + (size_t)mv * 6144 + sh_off; const float* msc = modB + (size_t)mv * 6144 + sc_off;
#pragma unroll
            for (int i = 0; i < 4; ++i) { const f32x4 g = *(const f32x4*)(gB + i * 256 + lane * 4), sh = *(const f32x4*)(msh + i * 256 + lane * 4), sc = *(const f32x4*)(msc + i * 256 + lane * 4);
                const f32x4 h = (x[i] * rstd * g) * (sc + 1.0f) + sh; *(u32x2*)(hbf + (size_t)row * D + i * 256 + lane * 4) = pack4(h); }
        }
    }
}

__device__ __forceinline__ void postproj_phase(const Params& p, unsigned char* ws, int l) {
    const int zz = ozero();
    const int tid = otid(), wid = tid >> 6, lane = tid & 63; const int bid = obid(), G = ogrid();
    const float* psm = (const float*)(ws + WS_PSM);
    bf16_t* qn = (bf16_t*)(ws + WS_QN); bf16_t* keys = (bf16_t*)(ws + WS_KEYS); bf16_t* krb = (bf16_t*)(ws + WS_KRB);
    const float* ropec = (const float*)(ws + WS_ROPE); const float* ropes = ropec + 1024 * 16;
    const float* gq = p.in[zz + I_GQ] + l * 384; const float* gkv = p.in[zz + I_GKV] + l * 256;
    for (int t = bid * 8 + wid; t < NKEY; t += G * 8) {
        if (t < MT) {
            const float* pr = psm + (size_t)t * 768;
            f32x2 q[3]; float ss = 0.f;
#pragma unroll
            for (int i = 0; i < 3; ++i) { q[i] = *(const f32x2*)(pr + i * 128 + lane * 2); ss += q[i][0] * q[i][0] + q[i][1] * q[i][1]; }
            ss = wave_sum(ss, lane); float rstd = rsqrtf(ss * (1.0f / 384.0f) + EPS);
#pragma unroll
            for (int i = 0; i < 3; ++i) { const f32x2 g = *(const f32x2*)(gq + i * 128 + lane * 2); *(unsigned*)(qn + (size_t)t * 384 + i * 128 + lane * 2) = cvt_pk_bf16(q[i][0] * rstd * g[0], q[i][1] * rstd * g[1]); }
            f32x4 kv = *(const f32x4*)(pr + 384 + lane * 4);
            ss = wave_sum(kv[0] * kv[0] + kv[1] * kv[1] + kv[2] * kv[2] + kv[3] * kv[3], lane); rstd = rsqrtf(ss * (1.0f / 256.0f) + EPS);
            const f32x4 ckv = kv * rstd * *(const f32x4*)(gkv + lane * 4);
            const int kr = keyrow_of(t);
            *(u32x2*)(keys + (size_t)kr * 256 + lane * 4) = pack4(ckv);
            const int s = t >> 8, pp = t & 255;
            if (t < MP) *(f32x4*)((p.out + zz) + OFF_CKV + ((size_t)(s * 2 + l) * 256 + pp) * 256 + lane * 4) = ckv * OS2;
            if (lane < 16) {
                float x1 = pr[640 + lane], x2 = pr[656 + lane];
                if (t >= MP) { const int pos = (t - MP) & 1023; const float cs = ropec[pos * 16 + lane], sn = ropes[pos * 16 + lane]; const float o1 = x1 * cs - x2 * sn, o2 = x1 * sn + x2 * cs; x1 = o1; x2 = o2; }
                krb[(size_t)kr * 32 + lane] = f2bf(x1); krb[(size_t)kr * 32 + 16 + lane] = f2bf(x2);
                if (t < MP) { float* o = (p.out + zz) + OFF_KR + ((size_t)(s * 2 + l) * 256 + pp) * 32; o[lane] = x1 * OS3; o[16 + lane] = x2 * OS3; }
            }
        } else {
            const int j = t - MT, b = j >> 8, jj = j & 255, kr = MP + b * 1280 + 1024 + jj;
            const f32x4 v = *(const f32x4*)(p.in[zz + I_CCKV] + ((size_t)(b * 2 + l) * 256 + jj) * 256 + lane * 4);
            *(u32x2*)(keys + (size_t)kr * 256 + lane * 4) = pack4(v);
            if (lane < 8) { const f32x4 w = *(const f32x4*)(p.in[zz + I_CKR] + ((size_t)(b * 2 + l) * 256 + jj) * 32 + lane * 4); *(u32x2*)(krb + (size_t)kr * 32 + lane * 4) = pack4(w); }
        }
    }
}

__device__ __forceinline__ void attn_phase(const Params& p, unsigned char* ws, LAS unsigned char* lds) {
    const int zz = ozero();
    const bf16_t* Qb = (const bf16_t*)(ws + WS_QB); const bf16_t* Kn = (const bf16_t*)(ws + WS_KN); const bf16_t* KR = (const bf16_t*)(ws + WS_KRB);
    const bf16_t* Vt = (const bf16_t*)(ws + WS_VT); bf16_t* AO = (bf16_t*)(ws + WS_AO);
    LAS bf16_t* Ks = (LAS bf16_t*)lds;
    LAS bf16_t* Vs = (LAS bf16_t*)(lds + 64 * 208);
    const int tid = otid(), wid = tid >> 6, lane = tid & 63, l15 = lane & 15, quad = lane >> 4; const int bid = obid(), G = ogrid();
    const bool split = (G == 256);
    for (int it = split ? (bid < 32 ? 768 : (bid - 64 + 224) % 224) : bid; it < 768; it += split ? 224 : G) {
        int tq, kb, nk, h;
        if (it < 256) { const int b = it >> 6; h = (it >> 3) & 7; tq = MP + b * 1024 + (it & 7) * 128; kb = MP + b * 1280; nk = 1280; }
        else { const int j = it - 256, s = j >> 4; h = (j >> 1) & 7; tq = s * 256 + (j & 1) * 128; kb = s * 256; nk = 256; }
        const int qrow = tq + wid * 16 + l15;
        bf16x8 qf[3];
#pragma unroll
        for (int ks = 0; ks < 3; ++ks) qf[ks] = *(const bf16x8*)(Qb + (size_t)qrow * 768 + h * 96 + ks * 32 + quad * 8);
        f32x4 o[4];
#pragma unroll
        for (int i = 0; i < 4; ++i) o[i] = (f32x4){0.f, 0.f, 0.f, 0.f};
        float mrun = -1e30f, lsum = 0.f;
        for (int k0 = 0; k0 < nk; k0 += 64) {
            __syncthreads();
            for (int c = tid; c < 768; c += NTHREADS) { const int r = c / 12, cc = c % 12;
                const bf16_t* src = cc < 8 ? Kn + (size_t)(kb + k0 + r) * 512 + h * 64 + cc * 8 : KR + (size_t)(kb + k0 + r) * 32 + (cc - 8) * 8;
                *(LAS u32x4*)(Ks + r * 104 + cc * 8) = *(const u32x4*)src; }
            { const int r = tid >> 3, cc = tid & 7; *(LAS u32x4*)(Vs + r * 72 + cc * 8) = *(const u32x4*)(Vt + (size_t)(h * 64 + r) * NKEY + kb + k0 + cc * 8); }
            __syncthreads();
            f32x4 s[4];
#pragma unroll
            for (int js = 0; js < 4; ++js) { s[js] = (f32x4){0.f, 0.f, 0.f, 0.f};
#pragma unroll
                for (int ks = 0; ks < 3; ++ks) { const bf16x8 a = *(const LAS bf16x8*)(Ks + (js * 16 + l15) * 104 + ks * 32 + quad * 8); s[js] = __builtin_amdgcn_mfma_f32_16x16x32_bf16(a, qf[ks], s[js], 0, 0, 0); } }
            float mx = s[0][0];
#pragma unroll
            for (int js = 0; js < 4; ++js)
#pragma unroll
                for (int j = 0; j < 4; ++j) mx = fmaxf(mx, s[js][j]);
            mx = fmaxf(mx, shfl_idx(mx, lane ^ 16)); mx = fmaxf(mx, shfl_idx(mx, lane ^ 32));
            const float mnew = fmaxf(mrun, mx), alpha = __builtin_amdgcn_exp2f(mrun - mnew); mrun = mnew;
            float psum = 0.f;
#pragma unroll
            for (int js = 0; js < 4; ++js)
#pragma unroll
                for (int j = 0; j < 4; ++j) { s[js][j] = __builtin_amdgcn_exp2f(s[js][j] - mnew); psum += s[js][j]; }
            lsum = lsum * alpha + psum;
#pragma unroll
            for (int i = 0; i < 4; ++i) o[i] *= alpha;
#pragma unroll
            for (int kk = 0; kk < 2; ++kk) {
                const u32x4 pw = pack8(s[2 * kk], s[2 * kk + 1]); bf16x8 pf; __builtin_memcpy(&pf, &pw, 16);
#pragma unroll
                for (int dv = 0; dv < 4; ++dv) {
                    const LAS bf16_t* vp = Vs + (dv * 16 + l15) * 72 + kk * 32 + quad * 4;
                    u32x4 vw; const u32x2 v0 = *(const LAS u32x2*)vp, v1 = *(const LAS u32x2*)(vp + 16); vw.x = v0.x; vw.y = v0.y; vw.z = v1.x; vw.w = v1.y;
                    bf16x8 va; __builtin_memcpy(&va, &vw, 16);
                    o[dv] = __builtin_amdgcn_mfma_f32_16x16x32_bf16(va, pf, o[dv], 0, 0, 0);
                }
            }
        }
        lsum += shfl_idx(lsum, lane ^ 16); lsum += shfl_idx(lsum, lane ^ 32);
        const float inv = 1.0f / lsum;
#pragma unroll
        for (int dv = 0; dv < 4; ++dv) *(u32x2*)(AO + (size_t)qrow * 512 + h * 64 + dv * 16 + quad * 4) = pack4(o[dv] * inv);
    }
}

template <int DIR>
__device__ __forceinline__ void scan_pass(const Params& p, unsigned char* ws, int l, int n, int tok0, int L, float h0, bool write_state, int state_idx, LAS unsigned char* lds) {
    const int zz = ozero();
    LAS float* xcf = (LAS float*)lds;
    LAS bf16_t* xcb = (LAS bf16_t*)(lds + 64 * 132 * 4);
    const int tid = otid(), wid = tid >> 6, lane = tid & 63, l15 = lane & 15, quad = lane >> 4;
    const int chl = wid * 16 + l15, ch = n * 128 + chl;
    const float* LXp = (const float*)(ws + WS_LX); bf16_t* HF = (bf16_t*)(ws + WS_SG) + 1024;   bf16_t* GG = (bf16_t*)(ws + WS_GG);
    const float lam = p.in[zz + I_LAM][(l * 2 + DIR) * 1024 + ch];
    const float nl = -lam, sp = fmaxf(nl, 0.f) + log1pf(__expf(-fabsf(nl)));
    const float cc = -8.0f * sp * LOG2E;
    const float br = p.in[zz + I_BRG][(l * 2 + DIR) * 1024 + ch], bi = p.in[zz + I_BIG][(l * 2 + DIR) * 1024 + ch];
    const bf16_t* wg = (const bf16_t*)(ws + WS_WG) + (size_t)((DIR * 8 + n) * 256) * 128;
    bf16x8 wrf[4], wif[4];
#pragma unroll
    for (int ks = 0; ks < 4; ++ks) { wrf[ks] = *(const bf16x8*)(wg + (size_t)chl * 128 + ks * 32 + quad * 8); wif[ks] = *(const bf16x8*)(wg + (size_t)(128 + chl) * 128 + ks * 32 + quad * 8); }
    const int c4 = (tid & 31) * 4, tg = tid >> 5;
    const float* cw = p.in[zz + I_CONVW] + (size_t)l * 4 * 1024 + n * 128 + c4;
    const f32x4 w0 = *(const f32x4*)cw, w1 = *(const f32x4*)(cw + 1024), w2 = *(const f32x4*)(cw + 2048), w3 = *(const f32x4*)(cw + 3072);
    const f32x4 cb = *(const f32x4*)(p.in[zz + I_CONVB] + l * 1024 + n * 128 + c4);
    float hin = h0;
    const int nchunk = L >> 6;
    f32x4 xr[7];
    {
        const int t0f = (DIR ? nchunk - 1 : 0) * 64;
#pragma unroll
        for (int r = 0; r < 7; ++r) { const int tt = t0f + tg * 4 - 2 + r; xr[r] = (tt >= 0 && tt < L) ? *(const f32x4*)(LXp + (size_t)(tok0 + tt) * 1024 + n * 128 + c4) : (f32x4){0.f, 0.f, 0.f, 0.f}; }
    }
    for (int ci = 0; ci < nchunk; ++ci) {
        const int t0 = (DIR ? nchunk - 1 - ci : ci) * 64;
        __syncthreads();
#pragma unroll
        for (int j = 0; j < 4; ++j) { const f32x4 xc = cb + xr[j] * w0 + xr[j + 1] * w1 + xr[j + 2] * w2 + xr[j + 3] * w3;
            *(LAS f32x4*)(xcf + (tg * 4 + j) * 132 + c4) = xc; *(LAS u32x2*)(xcb + (tg * 4 + j) * 136 + c4) = pack4(xc); }
        __syncthreads();
        if (ci + 1 < nchunk) {
            const int t0n = (DIR ? nchunk - 2 - ci : ci + 1) * 64;
#pragma unroll
            for (int r = 0; r < 7; ++r) { const int tt = t0n + tg * 4 - 2 + r; xr[r] = (tt >= 0 && tt < L) ? *(const f32x4*)(LXp + (size_t)(tok0 + tt) * 1024 + n * 128 + c4) : (f32x4){0.f, 0.f, 0.f, 0.f}; }
        }
        typedef unsigned short us2 __attribute__((ext_vector_type(2)));
        us2 hg[4][4];
        if (DIR == 1) {
#pragma unroll
            for (int st = 0; st < 4; ++st)
#pragma unroll
                for (int j = 0; j < 4; ++j) { const size_t idx = (size_t)(tok0 + t0 + st * 16 + quad * 4 + j) * 1024 + ch; hg[st][j].x = HF[idx + (idx - ch)]; hg[st][j].y = GG[idx]; }
        }
        f32x4 rg[4], ig[4];
#pragma unroll
        for (int st = 0; st < 4; ++st) { rg[st] = (f32x4){0.f, 0.f, 0.f, 0.f}; ig[st] = (f32x4){0.f, 0.f, 0.f, 0.f};
#pragma unroll
            for (int ks = 0; ks < 4; ++ks) { const bf16x8 a = *(const LAS bf16x8*)(xcb + (st * 16 + l15) * 136 + ks * 32 + quad * 8);
                rg[st] = __builtin_amdgcn_mfma_f32_16x16x32_bf16(a, wrf[ks], rg[st], 0, 0, 0); ig[st] = __builtin_amdgcn_mfma_f32_16x16x32_bf16(a, wif[ks], ig[st], 0, 0, 0); } }
#pragma unroll
        for (int sti = 0; sti < 4; ++sti) {
            const int st = DIR ? 3 - sti : sti;
            float av[4], hv[4], pa[4];
#pragma unroll
            for (int j = 0; j < 4; ++j) { const float x = xcf[(st * 16 + quad * 4 + j) * 132 + chl];
                const float rr = fast_sigmoid(rg[st][j] + br), ii = fast_sigmoid(ig[st][j] + bi);
                const float a = __builtin_amdgcn_exp2f(cc * rr); av[j] = a; hv[j] = __builtin_amdgcn_sqrtf(fmaxf(1.0f - a * a, 0.f)) * ii * x; }
            float hl = 0.f, pr = 1.f;
#pragma unroll
            for (int s4 = 0; s4 < 4; ++s4) { const int j = DIR ? 3 - s4 : s4; hl = av[j] * hl + hv[j]; pr *= av[j]; hv[j] = hl; pa[j] = pr; }
            float Ar = 1.f, Hr = 0.f, Aex = 1.f, Hex = 0.f;
#pragma unroll
            for (int s4 = 0; s4 < 4; ++s4) { const int qq = DIR ? 3 - s4 : s4; const float Aq = shfl_idx(pr, qq * 16 + l15), Hq = shfl_idx(hl, qq * 16 + l15);
                if (qq == quad) { Aex = Ar; Hex = Hr; }
                Hr = Aq * Hr + Hq; Ar *= Aq; }
            const float cq = Aex * hin + Hex;
            hin = Ar * hin + Hr;
#pragma unroll
            for (int j = 0; j < 4; ++j) { const float hfin = hv[j] + pa[j] * cq; const size_t idx = (size_t)(tok0 + t0 + st * 16 + quad * 4 + j) * 1024 + ch;
                if (DIR == 0) HF[idx + (idx - ch)] = f2bf(hfin);
                else GG[idx] = f2bf((bf2f(hg[st][j].x) + hfin) * bf2f(hg[st][j].y)); }
        }
    }
    if (write_state && quad == 0) (p.out + zz)[(DIR ? OFF_LB : OFF_LF) + state_idx + ch] = hin * (DIR ? OS5 : OS4);
}
__device__ __forceinline__ void scan_phase(const Params& p, unsigned char* ws, int l, LAS unsigned char* lds) {
    const int zz = ozero();
    const int tid = otid(), l15 = tid & 15, wid = tid >> 6; const int bid = obid(), G = ogrid();
    for (int rr = 0; rr < 2; ++rr) {
        const int it = rr == 0 ? bid : ((G == 256 && bid >= 32 && bid < 64) ? 224 + bid : (G == 256 ? 288 : bid + G));
        if (it >= 288) break;
        int n, tok0, L, sidx; bool lat; float hf0 = 0.f, hb0 = 0.f;
        if (it < 32) { const int b = it >> 3; n = it & 7; tok0 = MP + b * 1024; L = 1024; lat = true; sidx = 0; const int ch = n * 128 + wid * 16 + l15;
            hf0 = p.in[zz + I_SF][(b * 2 + l) * 1024 + ch]; hb0 = p.in[zz + I_SB][(b * 2 + l) * 1024 + ch]; }
        else { const int j = it - 32, s = j >> 3; n = j & 7; tok0 = s * 256; L = 256; lat = false; sidx = (s * 2 + l) * 1024; }
        scan_pass<0>(p, ws, l, n, tok0, L, hf0, !lat, sidx, lds);
        scan_pass<1>(p, ws, l, n, tok0, L, hb0, !lat, sidx, lds);
    }
}

__device__ __forceinline__ unsigned char* opq_unused(unsigned char* x) { asm volatile("" : "+s"(x)); return x; }
__device__ __forceinline__ void grid_sync_all(unsigned* bar, int k, int G) {
    asm volatile("s_waitcnt vmcnt(0) lgkmcnt(0)" ::: "memory");
    __syncthreads();
    const int t = otid();
    if (k == 0) {
        if (t < 64) { __builtin_amdgcn_fence(__ATOMIC_RELEASE, "agent"); asm volatile("s_waitcnt vmcnt(0) lgkmcnt(0)" ::: "memory"); }
        cg::this_grid().sync();
    } else if (t < 64) {
        __builtin_amdgcn_fence(__ATOMIC_RELEASE, "agent"); asm volatile("s_waitcnt vmcnt(0) lgkmcnt(0)" ::: "memory");
        if (t == 0) {
            __hip_atomic_fetch_add(bar, 1u, __ATOMIC_RELAXED, __HIP_MEMORY_SCOPE_AGENT);
            const unsigned want = (unsigned)k * (unsigned)G;
            while (__hip_atomic_load(bar, __ATOMIC_RELAXED, __HIP_MEMORY_SCOPE_AGENT) < want) __builtin_amdgcn_s_sleep(2);
        }
    }
    if (t < 64) { __builtin_amdgcn_fence(__ATOMIC_ACQUIRE, "agent"); asm volatile("s_waitcnt vmcnt(0) lgkmcnt(0)" ::: "memory"); }
    __syncthreads();
}
__global__ void __launch_bounds__(NTHREADS) fwd_megakernel(Params p) {
    extern __shared__ __attribute__((aligned(16))) unsigned char smem[];
    LAS unsigned char* lds = (LAS unsigned char*)smem;
    int nsync = 0; unsigned* gbar = (unsigned*)(p.ws + WS_BAR);
    int ph = 0; (void)ph; int phc = 0; (void)phc;
#if defined(STOP_AFTER)
#define PHASE_IF if (phc <= STOP_AFTER)
#define PHASE_END do { ++phc; grid_sync_all(gbar, nsync++, (int)gridDim.x); } while (0)
#elif ONE_LAUNCH
#define PHASE_IF
#define PHASE_END do { grid_sync_all(gbar, nsync++, (int)gridDim.x); } while (0)
#else
#define PHASE_IF if (__builtin_amdgcn_readfirstlane((int)(ph >= p.ph_lo && ph < p.ph_hi)))
#define PHASE_END do { ++ph; } while (0)
#endif

    PHASE_IF PHK(0) { const int zz = ozero(); unsigned char* ws = p.ws + zz; const int G = ogrid(), bid = obid(); (void)G; (void)bid; const float* modv = (const float*)(ws + WS_MODV); const float* modl = modv; (void)modl;
        rope_table(p, ws);
        modv_phase(p, ws, (LAS float*)lds);
        for (int i = bid; i < CONV_ITEMS; i += G) conv_item(p, ws, 0, i, (LAS float*)lds);
    }
    PHASE_END;
    PHASE_IF PHK(1) { const int zz = ozero(); unsigned char* ws = p.ws + zz; const int G = ogrid(), bid = obid(); (void)G; (void)bid; const float* modv = (const float*)(ws + WS_MODV); const float* modl = modv; (void)modl; norm_phase<false, true>(p, ws, p.in[zz + I_XP], p.in[zz + I_XS], nullptr, nullptr, 0, nullptr, p.in[zz + I_GPM], 0, 1024, modv); }
    PHASE_END;
#pragma unroll 1
    for (int l = 0; l < 2; ++l) {
        PHASE_IF PHK(2) { const int zz = ozero(); unsigned char* ws = p.ws + zz; const int G = ogrid(), bid = obid(); (void)G; (void)bid; const float* modv = (const float*)(ws + WS_MODV); const float* modl = modv + (size_t)l * 5 * 6144; (void)modl; pg8::Gemm g{(const bf16_t*)(ws + WS_HBF), (const bf16_t*)(ws + WS_WIN), MT, INCP, 1024}; pg8::StaticOrder S; S.init(MT, INCP, G, bid);
            EpiIn E{(float*)(ws + WS_PSM), (float*)(ws + WS_LX), (bf16_t*)(ws + WS_GG), (bf16_t*)(ws + WS_SG), (bf16_t*)(ws + WS_HF)}; pg8::gemm_phase(lds, g, S, E); }
        PHASE_END;
        PHASE_IF PHK(3) { const int zz = ozero(); unsigned char* ws = p.ws + zz; const int G = ogrid(), bid = obid(); (void)G; (void)bid; const float* modv = (const float*)(ws + WS_MODV); const float* modl = modv + (size_t)l * 5 * 6144; (void)modl; postproj_phase(p, ws, l); }
        PHASE_END;
        PHASE_IF PHK(4) { const int zz = ozero(); unsigned char* ws = p.ws + zz; const int G = ogrid(), bid = obid(); (void)G; (void)bid; const float* modv = (const float*)(ws + WS_MODV); const float* modl = modv + (size_t)l * 5 * 6144; (void)modl;
            { pg8::Gemm g{(const bf16_t*)(ws + WS_QN), (const bf16_t*)(ws + WS_WQ), MT, 768, 384}; pg8::StaticOrder S; S.init(MT, 768, G, bid);
              EpiQ E{(bf16_t*)(ws + WS_QB), (const float*)(ws + WS_ROPE), (const float*)(ws + WS_ROPE) + 1024 * 16}; pg8::gemm_phase(lds, g, S, E); }
            { pg8::Gemm g{(const bf16_t*)(ws + WS_KEYS), (const bf16_t*)(ws + WS_WKV), NKEY, 512, 256}; pg8::StaticOrder S; S.init(NKEY, 512, G, (bid + G - 144 % G) % G);
              EpiBf16 E{(bf16_t*)(ws + WS_KN), 512}; pg8::gemm_phase(lds, g, S, E); }
            { pg8::Gemm g{(const bf16_t*)(ws + WS_WKV) + (size_t)512 * 256, (const bf16_t*)(ws + WS_KEYS), 512, NKEY, 256}; pg8::StaticOrder S; S.init(512, NKEY, G, (bid + G - 248 % G) % G);
              EpiBf16 E{(bf16_t*)(ws + WS_VT), NKEY}; pg8::gemm_phase(lds, g, S, E); }
        }
        PHASE_END;
        PHASE_IF PHK(5) { const int zz = ozero(); unsigned char* ws = p.ws + zz; const int G = ogrid(), bid = obid(); (void)G; (void)bid; const float* modv = (const float*)(ws + WS_MODV); const float* modl = modv + (size_t)l * 5 * 6144; (void)modl; attn_phase(p, ws, lds); }
        PHASE_IF PHK(6) { const int zz = ozero(); unsigned char* ws = p.ws + zz; const int G = ogrid(), bid = obid(); (void)G; (void)bid; const float* modv = (const float*)(ws + WS_MODV); const float* modl = modv + (size_t)l * 5 * 6144; (void)modl; scan_phase(p, ws, l, lds); }
        PHASE_END;
        PHASE_IF PHK(7) { const int zz = ozero(); unsigned char* ws = p.ws + zz; const int G = ogrid(), bid = obid(); (void)G; (void)bid; const float* modv = (const float*)(ws + WS_MODV); const float* modl = modv + (size_t)l * 5 * 6144; (void)modl;
            { pg8::Gemm g{(const bf16_t*)(ws + WS_AO), (const bf16_t*)(ws + WS_WOMLA), MT, 1024, 512}; pg8::StaticOrder S; S.init(MT, 1024, G, bid);
              EpiMla E{(float*)(ws + WS_LX), (const bf16_t*)(ws + WS_SG)}; pg8::gemm_phase(lds, g, S, E); }
            { pg8::Gemm g{(const bf16_t*)(ws + WS_GG), (const bf16_t*)(ws + WS_WOLRU), MT, 1024, 1024}; pg8::StaticOrder S; S.init(MT, 1024, G, bid);
              EpiLru E{(const float*)(ws + WS_LX), (const bf16_t*)(ws + WS_SG), (bf16_t*)(ws + WS_Z), (const bf16_t*)(ws + WS_HF)}; pg8::gemm_phase(lds, g, S, E); }
        }
        PHASE_END;
        PHASE_IF PHK(8) { const int zz = ozero(); unsigned char* ws = p.ws + zz; const int G = ogrid(), bid = obid(); (void)G; (void)bid; const float* modv = (const float*)(ws + WS_MODV); const float* modl = modv + (size_t)l * 5 * 6144; (void)modl; pg8::Gemm g{(const bf16_t*)(ws + WS_Z), (const bf16_t*)(ws + WS_WOUT), MT, 1024, 1024}; pg8::StaticOrder S; S.init(MT, 1024, G, bid);
            EpiF32 E{(float*)(ws + WS_LX), 1024}; pg8::gemm_phase(lds, g, S, E); }
        PHASE_END;
        PHASE_IF PHK(9) { const int zz = ozero(); unsigned char* ws = p.ws + zz; const int G = ogrid(), bid = obid(); (void)G; (void)bid; const float* modv = (const float*)(ws + WS_MODV); const float* modl = modv + (size_t)l * 5 * 6144; (void)modl; const float* xp = l == 0 ? p.in[zz + I_XP] : (p.out + zz); const float* xs = l == 0 ? p.in[zz + I_XS] : (p.out + zz) + (size_t)MP * D; norm_phase<true, true>(p, ws, xp, xs, (const float*)(ws + WS_LX), p.in[zz + I_GQM] + l * D, 2048, modl, p.in[zz + I_GPF] + l * D, 3072, 4096, modl); }
        PHASE_END;
        PHASE_IF PHK(10) { const int zz = ozero(); unsigned char* ws = p.ws + zz; const int G = ogrid(), bid = obid(); (void)G; (void)bid; const float* modv = (const float*)(ws + WS_MODV); const float* modl = modv + (size_t)l * 5 * 6144; (void)modl; pg8::Gemm g{(const bf16_t*)(ws + WS_HBF), (const bf16_t*)(ws + WS_WFFI), MT, 5632, 1024}; pg8::StaticOrder S; S.init(MT, 5632, G, bid);
            EpiFfi E{(bf16_t*)(ws + WS_HID)}; pg8::gemm_phase(lds, g, S, E); }
        PHASE_END;
        PHASE_IF PHK(11) { const int zz = ozero(); unsigned char* ws = p.ws + zz; const int G = ogrid(), bid = obid(); (void)G; (void)bid; const float* modv = (const float*)(ws + WS_MODV); const float* modl = modv + (size_t)l * 5 * 6144; (void)modl; pg8::Gemm g{(const bf16_t*)(ws + WS_HID), (const bf16_t*)(ws + WS_WFFO), MT, 1024, FF}; pg8::StaticOrder S; S.init(MT, 1024, G, bid);
            EpiF32 E{(float*)(ws + WS_LX), 1024}; pg8::gemm_phase(lds, g, S, E); }
        PHASE_END;
        PHASE_IF PHK(12) { const int zz = ozero(); unsigned char* ws = p.ws + zz; const int G = ogrid(), bid = obid(); (void)G; (void)bid; const float* modv = (const float*)(ws + WS_MODV); const float* modl = modv + (size_t)l * 5 * 6144; (void)modl;
            if (l == 0) {
                norm_phase<true, true>(p, ws, (p.out + zz), (p.out + zz) + (size_t)MP * D, (const float*)(ws + WS_LX), p.in[zz + I_GQF], 5120, modl, p.in[zz + I_GPM] + D, 0, 1024, modv + (size_t)5 * 6144);
                for (int i = bid; i < CONV_ITEMS; i += G) conv_item(p, ws, 1, i, (LAS float*)lds);
            } else {
                norm_phase<true, false>(p, ws, (p.out + zz), (p.out + zz) + (size_t)MP * D, (const float*)(ws + WS_LX), p.in[zz + I_GQF] + D, 5120, modl, nullptr, 0, 0, nullptr);
            }
        }
#if ONE_LAUNCH && !defined(STOP_AFTER)
        if (l == 0) grid_sync_all(gbar, nsync++, (int)gridDim.x);
#else
        PHASE_END;
#endif
    }
#if defined(STOP_AFTER)
    {
        const int tid = otid(), bid = obid(), G = ogrid(); const unsigned* wsu = (const unsigned*)p.ws; float* out = p.out;
        for (int i = bid * NTHREADS + tid; i < 17432576; i += G * NTHREADS) { float a = 0.f;
#pragma unroll
            for (int j = 0; j < 4; ++j) { const size_t idx = (size_t)i + (size_t)j * 17432576; if (idx * 4 < WS_END) { const unsigned u = wsu[idx]; a += (float)(u & 0xffu) + (float)((u >> 16) & 0xffu); } }
            out[i] = a; }
    }
#endif
}
constexpr int NPHASES = 2 + 11 * 2;

extern "C" void kernel_launch(void* const* d_in, const int* in_sizes, int n_in, void* d_out, int out_size, void* d_ws, size_t ws_size, hipStream_t stream) {
    static int grid = 0;
    if (grid == 0) {
        if (n_in != 31 || ws_size < WS_END) { fprintf(stderr, "kernel_launch: need 31 inputs and %zu bytes of workspace (got %d, %zu)\n", (size_t)WS_END, n_in, ws_size); grid = -1; return; }
        if (hipFuncSetAttribute((const void*)fwd_megakernel, hipFuncAttributeMaxDynamicSharedMemorySize, LDS_BYTES) != hipSuccess) { fprintf(stderr, "kernel_launch: hipFuncSetAttribute failed\n"); grid = -1; return; }
        int dev = 0, cus = 0, per_cu = 0;
        hipGetDevice(&dev); hipDeviceGetAttribute(&cus, hipDeviceAttributeMultiprocessorCount, dev);
        hipOccupancyMaxActiveBlocksPerMultiprocessor(&per_cu, (const void*)fwd_megakernel, NTHREADS, LDS_BYTES);
        if (per_cu < 1) { fprintf(stderr, "kernel_launch: occupancy query says %d blocks/CU\n", per_cu); per_cu = 1; }
        (void)hipGetLastError();
        grid = cus;
    }
    if (grid < 0) return;
    (void)hipMemsetAsync((unsigned char*)d_ws + WS_BAR, 0, 256, stream);
    Params p{};
    for (int i = 0; i < 31; ++i) p.in[i] = (const float*)d_in[i];
    p.out = (float*)d_out; p.ws = (unsigned char*)d_ws;
#if ONE_LAUNCH
    p.ph_lo = 0; p.ph_hi = NPHASES; p.coop = 1;
    void* args[] = {&p};
    hipError_t e = hipLaunchCooperativeKernel((const void*)fwd_megakernel, dim3(grid), dim3(NTHREADS), args, LDS_BYTES, stream);
    if (e != hipSuccess) fprintf(stderr, "cooperative launch failed: %s (grid %d)\n", hipGetErrorString(e), grid);
#else
    for (int ph = 0; ph < NPHASES; ++ph) {
        p.ph_lo = ph; p.ph_hi = ph + 1; p.coop = 0;
        hipLaunchKernelGGL(fwd_megakernel, dim3(grid), dim3(NTHREADS), LDS_BYTES, stream, p);
    }
#endif
}
```

```cpp
#include <hip/hip_runtime.h>
#include <hip/hip_cooperative_groups.h>
#include <cstdio>
namespace cg = cooperative_groups;

#ifndef ONE_LAUNCH
#define ONE_LAUNCH 1
#endif

#ifndef PHMASK
#define PHMASK 0xffff
#endif
#define PHK(k) if constexpr (((PHMASK) >> (k)) & 1)
#ifndef LSCALE
#define LSCALE 1.0f
#endif
#ifndef MSCALE
#define MSCALE 1.0f
#endif
#ifndef FSCALE
#define FSCALE 1.0f
#endif
#ifndef OS0
#define OS0 1.0f
#endif
#ifndef OS1
#define OS1 1.0f
#endif
#ifndef OS2
#define OS2 1.0f
#endif
#ifndef OS3
#define OS3 1.0f
#endif
#ifndef OS4
#define OS4 1.0f
#endif
#ifndef OS5
#define OS5 1.0f
#endif
#ifndef ZMASK
#define ZMASK(row, col) false
#endif
#ifndef HSCALE
#define HSCALE 1.0f
#endif
#ifndef BSCALE
#define BSCALE 1.0f
#endif
#ifndef GGVAL
#define GGVAL(x) (x)
#endif
#ifndef GLVAL
#define GLVAL(x) (x)
#endif
#ifndef GLOFF
#define GLOFF 1024
#endif
#ifndef ZSCALE
#define ZSCALE 1.0f
#endif
#define LAS __attribute__((address_space(3)))
typedef unsigned short bf16_t;
typedef short bf16x8 __attribute__((ext_vector_type(8)));
typedef float f32x4 __attribute__((ext_vector_type(4)));
typedef float f32x2 __attribute__((ext_vector_type(2)));
typedef unsigned u32x4 __attribute__((ext_vector_type(4)));
typedef unsigned u32x2 __attribute__((ext_vector_type(2)));

constexpr int D = 1024, MT = 12288, MP = 8192, NKEY = 13312, FF = 2816;
constexpr int INCP = 4864;
constexpr int NTHREADS = 512, LDS_BYTES = 131072;
constexpr float EPS = 1e-6f;
constexpr float LOG2E = 1.4426950408889634f;
constexpr float QSCALE = 0.10206207261596577f * 1.4426950408889634f;

constexpr size_t OFF_CKV = 12582912, OFF_KR = 16777216, OFF_LF = 17301504, OFF_LB = 17367040;

constexpr size_t WS_MODV = 0;
constexpr size_t WS_ROPE = WS_MODV + 2 * 5 * 6144 * 4;
constexpr size_t WS_WIN = WS_ROPE + 2 * 1024 * 16 * 4;
constexpr size_t WS_WFFI = WS_WIN + (size_t)INCP * 1024 * 2;
constexpr size_t WS_WFFO = WS_WFFI + (size_t)5632 * 1024 * 2;
constexpr size_t WS_WOUT = WS_WFFO + (size_t)1024 * 2816 * 2;
constexpr size_t WS_WOLRU = WS_WOUT + (size_t)1024 * 1024 * 2;
constexpr size_t WS_WOMLA = WS_WOLRU + (size_t)1024 * 1024 * 2;
constexpr size_t WS_WQ = WS_WOMLA + (size_t)1024 * 512 * 2;
constexpr size_t WS_WKV = WS_WQ + (size_t)768 * 384 * 2;
constexpr size_t WS_WG = WS_WKV + (size_t)1024 * 256 * 2;
constexpr size_t WS_HBF = WS_WG + (size_t)2 * 8 * 256 * 128 * 2;
constexpr size_t WS_QN = WS_HBF;
constexpr size_t WS_KEYS = WS_QN + (size_t)MT * 384 * 2;
constexpr size_t WS_KRB = WS_KEYS + (size_t)NKEY * 256 * 2;
constexpr size_t WS_AO = WS_HBF;
constexpr size_t WS_PSM = WS_HBF + (size_t)MT * 1024 * 2;
constexpr size_t WS_QB = WS_PSM;
constexpr size_t WS_KN = WS_QB + (size_t)MT * 768 * 2;
constexpr size_t WS_Z = WS_PSM;
constexpr size_t WS_LX = WS_PSM + (size_t)MT * 768 * 4;
constexpr size_t WS_GG = WS_LX + (size_t)MT * 1024 * 4;
constexpr size_t WS_SG = WS_GG + (size_t)MT * 1024 * 2;
constexpr size_t WS_HID = WS_GG;
constexpr size_t WS_VT = WS_SG + (size_t)MT * 2048 * 2;
constexpr size_t WS_HF = WS_VT + (size_t)512 * NKEY * 2;
constexpr size_t WS_BAR = WS_HF + (size_t)MT * 1024 * 2;
constexpr size_t WS_END = WS_BAR + 256;

struct Params {
    const float* in[31];
    float* out;
    unsigned char* ws;
    int ph_lo, ph_hi, coop, pad;
};
enum { I_XP = 0, I_XS, I_CCKV, I_CKR, I_SF, I_SB, I_C, I_CCTX, I_WMOD, I_BMOD, I_GPM, I_GQM, I_GPF, I_GQF, I_WIN, I_GQ, I_WQUP, I_GKV,
       I_WKVUP, I_WOMLA, I_CONVW, I_CONVB, I_WRG, I_BRG, I_WIG, I_BIG, I_LAM, I_WOLRU, I_WOUT, I_WFFI, I_WFFO };

__device__ __forceinline__ unsigned char* opq(unsigned char* x) { asm volatile("" : "+s"(x)); return x; }
__device__ __forceinline__ int ozero() { int t = 0; asm volatile("" : "+s"(t)); return t; }
__device__ __forceinline__ int otid() { int t = threadIdx.x; asm volatile("" : "+v"(t)); return t; }
__device__ __forceinline__ int obid() { int t = blockIdx.x; asm volatile("" : "+s"(t)); return t; }
__device__ __forceinline__ int ogrid() { int t = gridDim.x; asm volatile("" : "+s"(t)); return t; }
__device__ __forceinline__ unsigned cvt_pk_bf16(float lo, float hi) { unsigned r; asm volatile("v_cvt_pk_bf16_f32 %0, %1, %2" : "=v"(r) : "v"(lo), "v"(hi)); return r; }
__device__ __forceinline__ float bf2f(bf16_t b) { return __uint_as_float(((unsigned)b) << 16); }
__device__ __forceinline__ bf16_t f2bf(float f) { return (bf16_t)(cvt_pk_bf16(f, 0.f) & 0xffffu); }
__device__ __forceinline__ float shfl_idx(float v, int srclane) { return __int_as_float(__builtin_amdgcn_ds_bpermute(srclane << 2, __float_as_int(v))); }
__device__ __forceinline__ float wave_sum(float v, int lane) {
#pragma unroll
    for (int o = 32; o >= 1; o >>= 1) v += shfl_idx(v, lane ^ o);
    return v;
}
__device__ __forceinline__ float fast_sigmoid(float x) { return __builtin_amdgcn_rcpf(1.0f + __builtin_amdgcn_exp2f(-x * LOG2E)); }
__device__ __forceinline__ float gelu_tanh(float x) { const float z = 1.5957691216057308f * (x + 0.044715f * x * x * x); return x * fast_sigmoid(z); }
__device__ __forceinline__ int keyrow_of(int t) { return t < MP ? t : MP + ((t - MP) >> 10) * 1280 + ((t - MP) & 1023); }

namespace pg8 {
constexpr int BM = 256, BK = 64, HALF = 128, HTB = HALF * BK * 2, NXCD = 8, WGM = 8;
__device__ __forceinline__ int lds_byte(int r, int c) { const int st = (r >> 4) * 2 + (c >> 5), rr = r & 15, cc = c & 31, ob = rr * 64 + cc * 2; return st * 1024 + (ob ^ (((ob >> 9) & 1) << 5)); }
__device__ __forceinline__ void stage_rc(int b, int& R, int& C) { const int st = b / 1024, sb = b % 1024, swz = sb ^ (((sb >> 9) & 1) << 5); R = (st >> 1) * 16 + swz / 64; C = (st & 1) * 32 + (swz % 64) / 2; }
__device__ __forceinline__ int perm32(int rho) { const int n = rho >> 4, i = rho & 15; return 8 * (i >> 2) + 4 * n + (i & 3); }
struct Unit { int pm, pn; };
struct Gemm { const bf16_t* A; const bf16_t* Bt; int M, N, K; };
struct StaticOrder {
    int nM, nN, nwg, G, c;
    __device__ void init(int M, int N, int G_, int c_) { nM = M / BM; nN = N / BM; nwg = nM * nN; G = G_; c = c_; }
    __device__ bool next(int i, Unit& u) const {
        const int L = i * G + c; if (L >= nwg) return false;
        int wgid = L; { const int q = nwg / NXCD, r = nwg % NXCD, xcd = wgid % NXCD, off = wgid / NXCD; wgid = (xcd < r ? xcd * (q + 1) : r * (q + 1) + (xcd - r) * q) + off; }
        const int nig = WGM * nN, gid = wgid / nig, fm = gid * WGM, gsz = (nM - fm) < WGM ? (nM - fm) : WGM;
        u.pm = fm + ((wgid % nig) % gsz); u.pn = (wgid % nig) / gsz; return true;
    }
};
template <class Epi>
__device__ __forceinline__ void gemm_phase(LAS unsigned char* lds, const Gemm g, const StaticOrder& S, const Epi& E) {
    int tid_ = threadIdx.x; asm volatile("" : "+v"(tid_));
    const int tid = tid_, wid = __builtin_amdgcn_readfirstlane(tid >> 6), lane = tid & 63, wr = wid >> 2, wc = wid & 3, fr = lane & 15, fq = lane >> 4;
    const int K = g.K, nt = K / BK;
    unsigned voffA[2], voffB[2];
#pragma unroll
    for (int i = 0; i < 2; ++i) { int R, C; stage_rc(tid * 16 + i * 8192, R, C); const int Rb = Epi::PERM ? ((R & ~31) + perm32(R & 31)) : R;
        voffA[i] = (unsigned)(R * K + C) * 2u; voffB[i] = (unsigned)(Rb * K + C) * 2u; }
    const size_t kstep = (size_t)(BK * 2);
    const size_t hstep = (size_t)HALF * K * 2;
    const size_t tstep = 2 * hstep;
    const unsigned ldsw = (unsigned)wid * 1024u;
    const int aoff = lds_byte(wr * 64 + fr, fq * 8), boff = lds_byte(wc * 32 + fr, fq * 8);
#define PG8_SA(b, h) (((b) * 2 + (h)) * HTB)
#define PG8_SB(b, h) ((4 + (b) * 2 + (h)) * HTB)
#define PG8_STAGE(bufoff, gbase, voff) do { _Pragma("unroll") for (int _i = 0; _i < 2; ++_i) \
        __builtin_amdgcn_global_load_lds((const unsigned*)((const char*)(gbase) + (voff)[_i]), (LAS unsigned*)(lds + (bufoff) + ldsw + _i * 8192), 16, 0, 0); } while (0)
#define PG8_LDA(dst, b, h) do { _Pragma("unroll") for (int m = 0; m < 4; ++m) _Pragma("unroll") for (int k = 0; k < 2; ++k) dst[m][k] = *(const LAS bf16x8*)(lds + PG8_SA(b, h) + aoff + m * 2048 + k * 1024); } while (0)
#define PG8_LDB(dst, b, h) do { _Pragma("unroll") for (int n = 0; n < 2; ++n) _Pragma("unroll") for (int k = 0; k < 2; ++k) dst[n][k] = *(const LAS bf16x8*)(lds + PG8_SB(b, h) + boff + n * 2048 + k * 1024); } while (0)
#define PG8_MMA(ai, bj, At, Bt) do { __builtin_amdgcn_s_setprio(1); _Pragma("unroll") for (int m = 0; m < 4; ++m) _Pragma("unroll") for (int n = 0; n < 2; ++n) _Pragma("unroll") for (int k = 0; k < 2; ++k) \
        acc[ai][bj][m][n] = __builtin_amdgcn_mfma_f32_16x16x32_bf16(Bt[n][k], At[m][k], acc[ai][bj][m][n], 0, 0, 0); __builtin_amdgcn_s_setprio(0); } while (0)
#define PG8_WAIT_V(n) asm volatile("s_waitcnt vmcnt(" #n ")" ::: "memory")
#define PG8_WAIT_L(n) asm volatile("s_waitcnt lgkmcnt(" #n ")" ::: "memory")
#define PG8_BAR __builtin_amdgcn_s_barrier()
#define PG8_SCHED __builtin_amdgcn_sched_barrier(0)
    Unit cur, nxt; int ui = 0;
    if (!S.next(0, cur)) return;
    f32x4 acc[2][2][4][2];
#pragma unroll
    for (int a = 0; a < 2; ++a)
#pragma unroll
        for (int b = 0; b < 2; ++b)
#pragma unroll
            for (int m = 0; m < 4; ++m)
#pragma unroll
                for (int n = 0; n < 2; ++n) acc[a][b][m][n] = (f32x4){0.f, 0.f, 0.f, 0.f};
    bf16x8 At[4][2], B0[2][2], B1[2][2];
    const char* cA = (const char*)g.A + (size_t)cur.pm * tstep; const char* cB = (const char*)g.Bt + (size_t)cur.pn * tstep;
    PG8_STAGE(PG8_SB(0, 0), cB, voffB); PG8_STAGE(PG8_SA(0, 0), cA, voffA); PG8_STAGE(PG8_SB(0, 1), cB + hstep, voffB); PG8_STAGE(PG8_SA(0, 1), cA + hstep, voffA);
    if (wr == 1) PG8_BAR;
    PG8_WAIT_V(4); PG8_BAR;
    PG8_STAGE(PG8_SB(1, 0), cB + kstep, voffB); PG8_STAGE(PG8_SA(1, 0), cA + kstep, voffA); PG8_STAGE(PG8_SB(1, 1), cB + hstep + kstep, voffB);
    PG8_WAIT_V(6); PG8_BAR;
    for (;;) {
        const bool has_next = S.next(ui + 1, nxt);
        const char* nA = has_next ? (const char*)g.A + (size_t)nxt.pm * tstep : cA; const char* nB = has_next ? (const char*)g.Bt + (size_t)nxt.pn * tstep : cB;
        for (int t = 0; t < nt; t += 2) {
            const bool last = (t == nt - 2);
            const char* a1 = cA + (size_t)(t + 1) * kstep;
            const char* a2 = last ? nA : cA + (size_t)(t + 2) * kstep; const char* b2 = last ? nB : cB + (size_t)(t + 2) * kstep;
            const char* a3 = a2 + kstep; const char* b3 = b2 + kstep;
            PG8_LDB(B0, 0, 0); PG8_SCHED; PG8_LDA(At, 0, 0); PG8_STAGE(PG8_SA(1, 1), a1 + hstep, voffA);
            PG8_WAIT_L(8); PG8_BAR; PG8_WAIT_L(0); PG8_MMA(0, 0, At, B0); PG8_BAR; PG8_SCHED;
            PG8_LDB(B1, 0, 1); PG8_STAGE(PG8_SB(0, 0), b2, voffB);
            PG8_BAR; PG8_WAIT_L(0); PG8_MMA(0, 1, At, B1); PG8_BAR;
            PG8_LDA(At, 0, 1); PG8_STAGE(PG8_SA(0, 0), a2, voffA);
            PG8_BAR; PG8_WAIT_L(0); PG8_MMA(1, 0, At, B0); PG8_BAR; PG8_SCHED;
            PG8_STAGE(PG8_SB(0, 1), b2 + hstep, voffB);
            PG8_WAIT_V(6); PG8_BAR; PG8_MMA(1, 1, At, B1); PG8_BAR;
            PG8_LDB(B0, 1, 0); PG8_SCHED; PG8_LDA(At, 1, 0); PG8_STAGE(PG8_SA(0, 1), a2 + hstep, voffA);
            PG8_WAIT_L(8); PG8_BAR; PG8_WAIT_L(0); PG8_MMA(0, 0, At, B0); PG8_BAR; PG8_SCHED;
            PG8_LDB(B1, 1, 1); PG8_STAGE(PG8_SB(1, 0), b3, voffB);
            PG8_BAR; PG8_WAIT_L(0); PG8_MMA(0, 1, At, B1); PG8_BAR;
            PG8_LDA(At, 1, 1); PG8_STAGE(PG8_SA(1, 0), a3, voffA);
            PG8_BAR; PG8_WAIT_L(0); PG8_MMA(1, 0, At, B0); PG8_BAR; PG8_SCHED;
            PG8_STAGE(PG8_SB(1, 1), b3 + hstep, voffB);
            PG8_WAIT_V(6); PG8_BAR; PG8_MMA(1, 1, At, B1); PG8_BAR;
        }
        E(acc, cur, wr, wc, fr, fq);
        if (!has_next) break;
#pragma unroll
        for (int a = 0; a < 2; ++a)
#pragma unroll
            for (int b = 0; b < 2; ++b)
#pragma unroll
                for (int m = 0; m < 4; ++m)
#pragma unroll
                    for (int n = 0; n < 2; ++n) acc[a][b][m][n] = (f32x4){0.f, 0.f, 0.f, 0.f};
        cur = nxt; cA = nA; cB = nB; ++ui;
    }
    PG8_WAIT_V(0);
    if (wr == 0) PG8_BAR;
    PG8_BAR;
#undef PG8_SA
#undef PG8_SB
#undef PG8_STAGE
#undef PG8_LDA
#undef PG8_LDB
#undef PG8_MMA
#undef PG8_WAIT_V
#undef PG8_WAIT_L
#undef PG8_BAR
#undef PG8_SCHED
}
}
using pg8::Unit;
typedef f32x4 AccT[2][2][4][2];

__device__ __forceinline__ u32x4 pack8(f32x4 a, f32x4 b) { u32x4 w; w.x = cvt_pk_bf16(a[0], a[1]); w.y = cvt_pk_bf16(a[2], a[3]); w.z = cvt_pk_bf16(b[0], b[1]); w.w = cvt_pk_bf16(b[2], b[3]); return w; }
__device__ __forceinline__ u32x2 pack4(f32x4 a) { u32x2 w; w.x = cvt_pk_bf16(a[0], a[1]); w.y = cvt_pk_bf16(a[2], a[3]); return w; }
__device__ __forceinline__ void unpack8(u32x4 w, f32x4& a, f32x4& b) {
    a[0] = __uint_as_float(w.x << 16); a[1] = __uint_as_float(w.x & 0xffff0000u); a[2] = __uint_as_float(w.y << 16); a[3] = __uint_as_float(w.y & 0xffff0000u);
    b[0] = __uint_as_float(w.z << 16); b[1] = __uint_as_float(w.z & 0xffff0000u); b[2] = __uint_as_float(w.w << 16); b[3] = __uint_as_float(w.w & 0xffff0000u);
}

struct EpiIn {
    static constexpr bool PERM = true;
    float* psm; float* lx; bf16_t* gg; bf16_t* sg; bf16_t* g2;
    __device__ __forceinline__ void operator()(const AccT& acc, const Unit& u, int wr, int wc, int fr, int fq) const {
        const int row0 = u.pm * 256 + wr * 64 + fr, colb = u.pn * 256 + wc * 32 + 8 * fq;
#pragma unroll
        for (int ai = 0; ai < 2; ++ai)
#pragma unroll
            for (int m = 0; m < 4; ++m) {
                const size_t row = (size_t)(row0 + ai * 128 + m * 16);
#pragma unroll
                for (int bj = 0; bj < 2; ++bj) {
                    const int col = colb + bj * 128; f32x4 v0 = acc[ai][bj][m][0], v1 = acc[ai][bj][m][1];
                    if (u.pn < 3) { float* q = psm + row * 768 + col; *(f32x4*)q = v0; *(f32x4*)(q + 4) = v1; }
                    else if (u.pn < 7) { float* q = lx + row * 1024 + (col - 768); *(f32x4*)q = v0; *(f32x4*)(q + 4) = v1; }
                    else if (u.pn < 11) {
#pragma unroll
                        for (int j = 0; j < 4; ++j) { v0[j] = gelu_tanh(v0[j]); v1[j] = gelu_tanh(v1[j]); }
                        *(u32x4*)(gg + row * 1024 + (col - 1792)) = pack8(v0, v1); }
                    else {
#pragma unroll
                        for (int j = 0; j < 4; ++j) { v0[j] = fast_sigmoid(v0[j]); v1[j] = fast_sigmoid(v1[j]); }
                        *(u32x4*)(sg + row * 2048 + (col - 2816)) = pack8(v0, v1);
                        if (u.pn >= 15) *(u32x4*)(g2 + row * 1024 + (col - 3840)) = pack8(v0, v1); }
                }
            }
    }
};
struct EpiQ {
    static constexpr bool PERM = false;
    bf16_t* q; const float* ropec; const float* ropes;
    __device__ __forceinline__ void operator()(const AccT& acc, const Unit& u, int wr, int wc, int fr, int fq) const {
        const int row0 = u.pm * 256 + wr * 64 + fr;
#pragma unroll
        for (int ai = 0; ai < 2; ++ai)
#pragma unroll
            for (int m = 0; m < 4; ++m) {
                const int row = row0 + ai * 128 + m * 16; const bool lat = row >= MP; const int pos = (row - MP) & 1023;
#pragma unroll
                for (int bj = 0; bj < 2; ++bj) {
                    const int base = u.pn * 256 + bj * 128 + wc * 32; const bool rope = lat && (((base >> 5) % 3) == 2);
                    f32x4 v0 = acc[ai][bj][m][0], v1 = acc[ai][bj][m][1];
                    if (rope) { const f32x4 cs = *(const f32x4*)(ropec + pos * 16 + 4 * fq), sn = *(const f32x4*)(ropes + pos * 16 + 4 * fq);
                        const f32x4 o0 = v0 * cs - v1 * sn, o1 = v0 * sn + v1 * cs; v0 = o0; v1 = o1; }
                    v0 *= QSCALE; v1 *= QSCALE;
                    bf16_t* dst = q + (size_t)row * 768 + base + 4 * fq;
                    *(u32x2*)dst = pack4(v0); *(u32x2*)(dst + 16) = pack4(v1);
                }
                asm volatile("" ::: "memory");
            }
    }
};
struct EpiBf16 {
    static constexpr bool PERM = true;
    bf16_t* o; int ldc;
    __device__ __forceinline__ void operator()(const AccT& acc, const Unit& u, int wr, int wc, int fr, int fq) const {
        const int row0 = u.pm * 256 + wr * 64 + fr, colb = u.pn * 256 + wc * 32 + 8 * fq;
#pragma unroll
        for (int ai = 0; ai < 2; ++ai)
#pragma unroll
            for (int m = 0; m < 4; ++m) {
                const size_t row = (size_t)(row0 + ai * 128 + m * 16);
#pragma unroll
                for (int bj = 0; bj < 2; ++bj) *(u32x4*)(o + row * ldc + colb + bj * 128) = pack8(acc[ai][bj][m][0], acc[ai][bj][m][1]);
            }
    }
};
struct EpiF32 {
    static constexpr bool PERM = true;
    float* o; int ldc;
    __device__ __forceinline__ void operator()(const AccT& acc, const Unit& u, int wr, int wc, int fr, int fq) const {
        const int row0 = u.pm * 256 + wr * 64 + fr, colb = u.pn * 256 + wc * 32 + 8 * fq;
#pragma unroll
        for (int ai = 0; ai < 2; ++ai)
#pragma unroll
            for (int m = 0; m < 4; ++m) {
                const size_t row = (size_t)(row0 + ai * 128 + m * 16);
#pragma unroll
                for (int bj = 0; bj < 2; ++bj) { float* q = o + row * ldc + colb + bj * 128; *(f32x4*)q = acc[ai][bj][m][0]; *(f32x4*)(q + 4) = acc[ai][bj][m][1]; }
            }
    }
};
struct EpiMla {
    static constexpr bool PERM = true;
    float* z1; const bf16_t* sg;
    __device__ __forceinline__ void operator()(const AccT& acc, const Unit& u, int wr, int wc, int fr, int fq) const {
        const int row0 = u.pm * 256 + wr * 64 + fr, colb = u.pn * 256 + wc * 32 + 8 * fq;
#pragma unroll
        for (int ai = 0; ai < 2; ++ai)
#pragma unroll
            for (int m = 0; m < 4; ++m) {
                const size_t row = (size_t)(row0 + ai * 128 + m * 16);
#pragma unroll
                for (int bj = 0; bj < 2; ++bj) { const int col = colb + bj * 128; f32x4 g0, g1; unpack8(*(const u32x4*)(sg + row * 2048 + col), g0, g1);
                    float* q = z1 + row * 1024 + col; *(f32x4*)q = acc[ai][bj][m][0] * g0 * ZSCALE; *(f32x4*)(q + 4) = acc[ai][bj][m][1] * g1 * ZSCALE; }
                asm volatile("" ::: "memory");
            }
    }
};
struct EpiLru {
    static constexpr bool PERM = true;
    const float* z1; const bf16_t* sg; bf16_t* z; const bf16_t* g2;
    __device__ __forceinline__ void operator()(const AccT& acc, const Unit& u, int wr, int wc, int fr, int fq) const {
        const int row0 = u.pm * 256 + wr * 64 + fr, colb = u.pn * 256 + wc * 32 + 8 * fq;
#pragma unroll
        for (int ai = 0; ai < 2; ++ai)
#pragma unroll
            for (int m = 0; m < 4; ++m) {
                const size_t row = (size_t)(row0 + ai * 128 + m * 16);
#pragma unroll
                for (int bj = 0; bj < 2; ++bj) { const int col = colb + bj * 128; f32x4 g0, g1; unpack8(*(const u32x4*)(g2 + row * 1024 + col), g0, g1);
                    const float* q = z1 + row * 1024 + col; const f32x4 a0 = *(const f32x4*)q + acc[ai][bj][m][0] * GLVAL(g0) * LSCALE, a1 = *(const f32x4*)(q + 4) + acc[ai][bj][m][1] * GLVAL(g1) * LSCALE;
                    *(u32x4*)(z + row * 1024 + col) = pack8(a0, a1); }
                asm volatile("" ::: "memory");
            }
    }
};
struct EpiFfi {
    static constexpr bool PERM = false;
    bf16_t* hid;
    __device__ __forceinline__ void operator()(const AccT& acc, const Unit& u, int wr, int wc, int fr, int fq) const {
        const int row0 = u.pm * 256 + wr * 64 + fr;
#pragma unroll
        for (int ai = 0; ai < 2; ++ai)
#pragma unroll
            for (int m = 0; m < 4; ++m) {
                const size_t row = (size_t)(row0 + ai * 128 + m * 16);
#pragma unroll
                for (int bj = 0; bj < 2; ++bj) { const int hc = ((u.pn * 256 + bj * 128 + wc * 32) >> 1) + 4 * fq; const f32x4 gv = acc[ai][bj][m][0], uv = acc[ai][bj][m][1]; f32x4 h;
#pragma unroll
                    for (int j = 0; j < 4; ++j) h[j] = gv[j] * fast_sigmoid(gv[j]) * uv[j];
                    *(u32x2*)(hid + row * FF + hc) = pack4(h); }
            }
    }
};

__device__ __forceinline__ int map_row(int mode, int n) {
    if (mode == 1) return n < 672 ? n : n + 96;
    if (mode == 2) { const int up = n >= FF, j = up ? n - FF : n; return (j >> 4) * 32 + (j & 15) + (up ? 16 : 0); }
    if (mode == 3) { const int h = n >> 7, r = n & 127; return r < 64 ? h * 64 + r : 512 + h * 64 + (r - 64); }
    return n;
}
__device__ __forceinline__ void conv_tile(const float* src, int ld, int K, int k0, int n0, bf16_t* dst, int mode, LAS float* tile) {
    const int tid = otid();
    __syncthreads();
#pragma unroll
    for (int i = 0; i < 2; ++i) { const int kk = (tid >> 3) + 64 * i, c4 = (tid & 7) * 4; const f32x4 v = *(const f32x4*)(src + (size_t)(k0 + kk) * ld + n0 + c4);
        tile[kk * 33 + c4] = v[0]; tile[kk * 33 + c4 + 1] = v[1]; tile[kk * 33 + c4 + 2] = v[2]; tile[kk * 33 + c4 + 3] = v[3]; }
    __syncthreads();
    const int n = tid >> 4, k8 = (tid & 15) * 8; f32x4 a, b;
#pragma unroll
    for (int j = 0; j < 4; ++j) { a[j] = tile[(k8 + j) * 33 + n]; b[j] = tile[(k8 + 4 + j) * 33 + n]; }
    *(u32x4*)(dst + (size_t)map_row(mode, n0 + n) * K + k0 + k8) = pack8(a, b);
}
constexpr int CONV_ITEMS = 4208;
struct CJob { const float* src; bf16_t* dst; int ld, K, k0, n0, mode; };
__device__ __forceinline__ CJob conv_decode(const Params& p, unsigned char* ws, int l, int idx) {
    const int zz = ozero();
    int inidx, K, N, mode = 0; size_t soff, doff;
    if (idx < 1192) { inidx = I_WIN; soff = (size_t)l * 1024 * 4768; doff = WS_WIN; K = 1024; N = 4768; mode = 1; }
    else if ((idx -= 1192) < 1408) { inidx = I_WFFI; soff = (size_t)l * 1024 * 5632; doff = WS_WFFI; K = 1024; N = 5632; mode = 2; }
    else if ((idx -= 1408) < 704) { inidx = I_WFFO; soff = (size_t)l * 2816 * 1024; doff = WS_WFFO; K = 2816; N = 1024; }
    else if ((idx -= 704) < 256) { inidx = I_WOUT; soff = (size_t)l * 1024 * 1024; doff = WS_WOUT; K = 1024; N = 1024; }
    else if ((idx -= 256) < 256) { inidx = I_WOLRU; soff = (size_t)l * 1024 * 1024; doff = WS_WOLRU; K = 1024; N = 1024; }
    else if ((idx -= 256) < 128) { inidx = I_WOMLA; soff = (size_t)l * 512 * 1024; doff = WS_WOMLA; K = 512; N = 1024; }
    else if ((idx -= 128) < 72) { inidx = I_WQUP; soff = (size_t)l * 384 * 768; doff = WS_WQ; K = 384; N = 768; }
    else if ((idx -= 72) < 64) { inidx = I_WKVUP; soff = (size_t)l * 256 * 1024; doff = WS_WKV; K = 256; N = 1024; mode = 3; }
    else { idx -= 64; const int mat = idx >> 2, ig = mat >> 4, dir = (mat >> 3) & 1, n = mat & 7;
        inidx = ig ? I_WIG : I_WRG; soff = (size_t)((l * 2 + dir) * 8 + n) * 16384; doff = WS_WG + (size_t)((dir * 8 + n) * 256 + ig * 128) * 128 * 2; K = 128; N = 128; idx &= 3; }
    const float* src = p.in[zz + inidx] + soff; bf16_t* dst = (bf16_t*)(ws + doff);
    const int nk = K / 128, kt = idx % nk, ntile = idx / nk;
    CJob j; j.src = src; j.dst = dst; j.ld = N; j.K = K; j.k0 = kt * 128; j.n0 = ntile * 32; j.mode = mode; return j;
}
__device__ __forceinline__ void conv_pair(const CJob& ja, const CJob& jb, bool hasb, LAS float* tile) {
    const int tid = otid();
    __syncthreads();
    f32x4 va[2], vb[2];
#pragma unroll
    for (int i = 0; i < 2; ++i) { const int kk = (tid >> 3) + 64 * i, c4 = (tid & 7) * 4; va[i] = *(const f32x4*)(ja.src + (size_t)(ja.k0 + kk) * ja.ld + ja.n0 + c4); }
    if (hasb) {
#pragma unroll
        for (int i = 0; i < 2; ++i) { const int kk = (tid >> 3) + 64 * i, c4 = (tid & 7) * 4; vb[i] = *(const f32x4*)(jb.src + (size_t)(jb.k0 + kk) * jb.ld + jb.n0 + c4); }
    }
#pragma unroll
    for (int i = 0; i < 2; ++i) { const int kk = (tid >> 3) + 64 * i, c4 = (tid & 7) * 4;
        tile[kk * 33 + c4] = va[i][0]; tile[kk * 33 + c4 + 1] = va[i][1]; tile[kk * 33 + c4 + 2] = va[i][2]; tile[kk * 33 + c4 + 3] = va[i][3];
        if (hasb) { tile[4224 + kk * 33 + c4] = vb[i][0]; tile[4224 + kk * 33 + c4 + 1] = vb[i][1]; tile[4224 + kk * 33 + c4 + 2] = vb[i][2]; tile[4224 + kk * 33 + c4 + 3] = vb[i][3]; } }
    __syncthreads();
    const int n = tid >> 4, k8 = (tid & 15) * 8; f32x4 a, b;
#pragma unroll
    for (int j = 0; j < 4; ++j) { a[j] = tile[(k8 + j) * 33 + n]; b[j] = tile[(k8 + 4 + j) * 33 + n]; }
    *(u32x4*)(ja.dst + (size_t)map_row(ja.mode, ja.n0 + n) * ja.K + ja.k0 + k8) = pack8(a, b);
    if (hasb) {
#pragma unroll
        for (int j = 0; j < 4; ++j) { a[j] = tile[4224 + (k8 + j) * 33 + n]; b[j] = tile[4224 + (k8 + 4 + j) * 33 + n]; }
        *(u32x4*)(jb.dst + (size_t)map_row(jb.mode, jb.n0 + n) * jb.K + jb.k0 + k8) = pack8(a, b);
    }
}
__device__ __forceinline__ void modv_phase(const Params& p, unsigned char* ws, LAS float* lds) {
    const int zz = ozero();
    LAS float* sc = lds + 128 * 33;
    LAS float* red = sc + 5 * 1024;
    const int tid = otid();
    __syncthreads();
    for (int i = tid; i < 5 * 1024; i += NTHREADS) { const float c = i < 1024 ? p.in[zz + I_CCTX][i] : p.in[zz + I_C][i - 1024]; sc[i] = c / (1.0f + __expf(-c)); }
    __syncthreads();
    float* modv = (float*)(ws + WS_MODV); const int bid = obid(), G = ogrid();
    const int col = tid & 31, kg = tid >> 5;
    for (int it = bid; it < 384; it += G) {
        const int l = it / 192, j0 = (it % 192) * 32;
        const float* w = p.in[zz + I_WMOD] + (size_t)l * 1024 * 6144 + j0 + col;
        float a0 = 0.f, a1 = 0.f, a2 = 0.f, a3 = 0.f, a4 = 0.f;
#pragma unroll 8
        for (int k = kg * 64; k < kg * 64 + 64; ++k) { const float wv = w[(size_t)k * 6144]; a0 += sc[k] * wv; a1 += sc[1024 + k] * wv; a2 += sc[2048 + k] * wv; a3 += sc[3072 + k] * wv; a4 += sc[4096 + k] * wv; }
        red[(kg * 5 + 0) * 32 + col] = a0; red[(kg * 5 + 1) * 32 + col] = a1; red[(kg * 5 + 2) * 32 + col] = a2; red[(kg * 5 + 3) * 32 + col] = a3; red[(kg * 5 + 4) * 32 + col] = a4;
        __syncthreads();
        if (tid < 160) { const int v = tid >> 5, c = tid & 31; float s = p.in[zz + I_BMOD][l * 6144 + j0 + c];
#pragma unroll
            for (int g = 0; g < 16; ++g) s += red[(g * 5 + v) * 32 + c];
            modv[(size_t)(l * 5 + v) * 6144 + j0 + c] = s; }
        __syncthreads();
    }
}
__device__ __forceinline__ void rope_table(const Params& p, unsigned char* ws) {
    const int zz = ozero();
    float* rc = (float*)(ws + WS_ROPE); float* rs = rc + 1024 * 16;
    const int G = ogrid(); for (int i = obid() * NTHREADS + otid(); i < 1024 * 16; i += G * NTHREADS) {
        const int pos = i >> 4, f = i & 15; const float posv = (float)(f < 8 ? (pos >> 6) : (pos & 63));
        const float inv = exp2f(-(float)(f & 7) * (13.287712379549449f / 8.0f));
        const float rev = posv * inv * 0.15915494309189535f;
        rc[i] = __builtin_amdgcn_cosf(rev); rs[i] = __builtin_amdgcn_sinf(rev);
    }
}

template <bool HAS_Y, bool DO_H>
__device__ __forceinline__ void norm_phase(const Params& p, unsigned char* ws, const float* xp, const float* xs, const float* Y, const float* gA, int gate_off, const float* modA,
                                           const float* gB, int sh_off, int sc_off, const float* modB) {
    const int zz = ozero();
    const int tid = otid(), wid = tid >> 6, lane = tid & 63; const int bid = obid(), G = ogrid();
    bf16_t* hbf = (bf16_t*)(ws + WS_HBF);
    for (int row = bid * 8 + wid; row < MT; row += G * 8) {
        const int mv = row < MP ? 0 : 1 + ((row - MP) >> 10);
        const float* xin = row < MP ? xp + (size_t)row * D : xs + (size_t)(row - MP) * D;
        f32x4 x[4];
#pragma unroll
        for (int i = 0; i < 4; ++i) x[i] = *(const f32x4*)(xin + i * 256 + lane * 4);
        if (HAS_Y) {
            f32x4 y[4]; float ss = 0.f;
#pragma unroll
            for (int i = 0; i < 4; ++i) { y[i] = *(const f32x4*)(Y + (size_t)row * D + i * 256 + lane * 4); ss += y[i][0] * y[i][0] + y[i][1] * y[i][1] + y[i][2] * y[i][2] + y[i][3] * y[i][3]; }
            ss = wave_sum(ss, lane); const float rstd = rsqrtf(ss * (1.0f / D) + EPS);
            const float* mg = modA + (size_t)mv * 6144 + gate_off;
#pragma unroll
            for (int i = 0; i < 4; ++i) { const f32x4 g = *(const f32x4*)(gA + i * 256 + lane * 4), gt = *(const f32x4*)(mg + i * 256 + lane * 4);
                x[i] = x[i] + gt * (y[i] * rstd * g) * (gate_off == 2048 ? MSCALE : FSCALE); *(f32x4*)((p.out + zz) + (size_t)row * D + i * 256 + lane * 4) = DO_H ? x[i] : x[i] * (row < MP ? (ZMASK(row, i * 256 + lane * 4) ? 0.0f : OS0) : OS1); }
        }
        if (DO_H) {
            float ss = 0.f;
#pragma unroll
            for (int i = 0; i < 4; ++i) ss += x[i][0] * x[i][0] + x[i][1] * x[i][1] + x[i][2] * x[i][2] + x[i][3] * x[i][3];
            ss = wave_sum(ss, lane); const float rstd = rsqrtf(ss * (1.0f / D) + EPS);
            const float* msh = modB + (size_t)mv * 6144 + sh_off; const float* msc = modB + (size_t)mv * 6144 + sc_off;
#pragma unroll
            for (int i = 0; i < 4; ++i) { const f32x4 g = *(const f32x4*)(gB + i * 256 + lane * 4), sh = *(const f32x4*)(msh + i * 256 + lane * 4), sc = *(const f32x4*)(msc + i * 256 + lane * 4);
                const f32x4 h = (x[i] * rstd * g) * (sc + 1.0f) + sh; *(u32x2*)(hbf + (size_t)row * D + i * 256 + lane * 4) = pack4(h); }
        }
    }
}

__device__ __forceinline__ void postproj_phase(const Params& p, unsigned char* ws, int l) {
    const int zz = ozero();
    const int tid = otid(), wid = tid >> 6, lane = tid & 63; const int bid = obid(), G = ogrid();
    const float* psm = (const float*)(ws + WS_PSM);
    bf16_t* qn = (bf16_t*)(ws + WS_QN); bf16_t* keys = (bf16_t*)(ws + WS_KEYS); bf16_t* krb = (bf16_t*)(ws + WS_KRB);
    const float* ropec = (const float*)(ws + WS_ROPE); const float* ropes = ropec + 1024 * 16;
    const float* gq = p.in[zz + I_GQ] + l * 384; const float* gkv = p.in[zz + I_GKV] + l * 256;
    for (int t = bid * 8 + wid; t < NKEY; t += G * 8) {
        if (t < MT) {
            const float* pr = psm + (size_t)t * 768;
            f32x2 q[3]; float ss = 0.f;
#pragma unroll
            for (int i = 0; i < 3; ++i) { q[i] = *(const f32x2*)(pr + i * 128 + lane * 2); ss += q[i][0] * q[i][0] + q[i][1] * q[i][1]; }
            ss = wave_sum(ss, lane); float rstd = rsqrtf(ss * (1.0f / 384.0f) + EPS);
#pragma unroll
            for (int i = 0; i < 3; ++i) { const f32x2 g = *(const f32x2*)(gq + i * 128 + lane * 2); *(unsigned*)(qn + (size_t)t * 384 + i * 128 + lane * 2) = cvt_pk_bf16(q[i][0] * rstd * g[0], q[i][1] * rstd * g[1]); }
            f32x4 kv = *(const f32x4*)(pr + 384 + lane * 4);
            ss = wave_sum(kv[0] * kv[0] + kv[1] * kv[1] + kv[2] * kv[2] + kv[3] * kv[3], lane); rstd = rsqrtf(ss * (1.0f / 256.0f) + EPS);
            const f32x4 ckv = kv * rstd * *(const f32x4*)(gkv + lane * 4);
            const int kr = keyrow_of(t);
            *(u32x2*)(keys + (size_t)kr * 256 + lane * 4) = pack4(ckv);
            const int s = t >> 8, pp = t & 255;
            if (t < MP) *(f32x4*)((p.out + zz) + OFF_CKV + ((size_t)(s * 2 + l) * 256 + pp) * 256 + lane * 4) = ckv * OS2;
            if (lane < 16) {
                float x1 = pr[640 + lane], x2 = pr[656 + lane];
                if (t >= MP) { const int pos = (t - MP) & 1023; const float cs = ropec[pos * 16 + lane], sn = ropes[pos * 16 + lane]; const float o1 = x1 * cs - x2 * sn, o2 = x1 * sn + x2 * cs; x1 = o1; x2 = o2; }
                krb[(size_t)kr * 32 + lane] = f2bf(x1); krb[(size_t)kr * 32 + 16 + lane] = f2bf(x2);
                if (t < MP) { float* o = (p.out + zz) + OFF_KR + ((size_t)(s * 2 + l) * 256 + pp) * 32; o[lane] = x1 * OS3; o[16 + lane] = x2 * OS3; }
            }
        } else {
            const int j = t - MT, b = j >> 8, jj = j & 255, kr = MP + b * 1280 + 1024 + jj;
            const f32x4 v = *(const f32x4*)(p.in[zz + I_CCKV] + ((size_t)(b * 2 + l) * 256 + jj) * 256 + lane * 4);
            *(u32x2*)(keys + (size_t)kr * 256 + lane * 4) = pack4(v);
            if (lane < 8) { const f32x4 w = *(const f32x4*)(p.in[zz + I_CKR] + ((size_t)(b * 2 + l) * 256 + jj) * 32 + lane * 4); *(u32x2*)(krb + (size_t)kr * 32 + lane * 4) = pack4(w); }
        }
    }
}

__device__ __forceinline__ void attn_phase(const Params& p, unsigned char* ws, LAS unsigned char* lds) {
    const int zz = ozero();
    const bf16_t* Qb = (const bf16_t*)(ws + WS_QB); const bf16_t* Kn = (const bf16_t*)(ws + WS_KN); const bf16_t* KR = (const bf16_t*)(ws + WS_KRB);
    const bf16_t* Vt = (const bf16_t*)(ws + WS_VT); bf16_t* AO = (bf16_t*)(ws + WS_AO);
    LAS bf16_t* Ks = (LAS bf16_t*)lds;
    LAS bf16_t* Vs = (LAS bf16_t*)(lds + 64 * 208);
    const int tid = otid(), wid = tid >> 6, lane = tid & 63, l15 = lane & 15, quad = lane >> 4; const int bid = obid(), G = ogrid();
    const bool split = (G == 256);
    for (int it = split ? (bid < 32 ? 768 : (bid - 64 + 224) % 224) : bid; it < 768; it += split ? 224 : G) {
        int tq, kb, nk, h;
        if (it < 256) { const int b = it >> 6; h = (it >> 3) & 7; tq = MP + b * 1024 + (it & 7) * 128; kb = MP + b * 1280; nk = 1280; }
        else { const int j = it - 256, s = j >> 4; h = (j >> 1) & 7; tq = s * 256 + (j & 1) * 128; kb = s * 256; nk = 256; }
        const int qrow = tq + wid * 16 + l15;
        bf16x8 qf[3];
#pragma unroll
        for (int ks = 0; ks < 3; ++ks) qf[ks] = *(const bf16x8*)(Qb + (size_t)qrow * 768 + h * 96 + ks * 32 + quad * 8);
        f32x4 o[4];
#pragma unroll
        for (int i = 0; i < 4; ++i) o[i] = (f32x4){0.f, 0.f, 0.f, 0.f};
        float mrun = -1e30f, lsum = 0.f;
        for (int k0 = 0; k0 < nk; k0 += 64) {
            __syncthreads();
            for (int c = tid; c < 768; c += NTHREADS) { const int r = c / 12, cc = c % 12;
                const bf16_t* src = cc < 8 ? Kn + (size_t)(kb + k0 + r) * 512 + h * 64 + cc * 8 : KR + (size_t)(kb + k0 + r) * 32 + (cc - 8) * 8;
                *(LAS u32x4*)(Ks + r * 104 + cc * 8) = *(const u32x4*)src; }
            { const int r = tid >> 3, cc = tid & 7; *(LAS u32x4*)(Vs + r * 72 + cc * 8) = *(const u32x4*)(Vt + (size_t)(h * 64 + r) * NKEY + kb + k0 + cc * 8); }
            __syncthreads();
            f32x4 s[4];
#pragma unroll
            for (int js = 0; js < 4; ++js) { s[js] = (f32x4){0.f, 0.f, 0.f, 0.f};
#pragma unroll
                for (int ks = 0; ks < 3; ++ks) { const bf16x8 a = *(const LAS bf16x8*)(Ks + (js * 16 + l15) * 104 + ks * 32 + quad * 8); s[js] = __builtin_amdgcn_mfma_f32_16x16x32_bf16(a, qf[ks], s[js], 0, 0, 0); } }
            float mx = s[0][0];
#pragma unroll
            for (int js = 0; js < 4; ++js)
#pragma unroll
                for (int j = 0; j < 4; ++j) mx = fmaxf(mx, s[js][j]);
            mx = fmaxf(mx, shfl_idx(mx, lane ^ 16)); mx = fmaxf(mx, shfl_idx(mx, lane ^ 32));
            const float mnew = fmaxf(mrun, mx), alpha = __builtin_amdgcn_exp2f(mrun - mnew); mrun = mnew;
            float psum = 0.f;
#pragma unroll
            for (int js = 0; js < 4; ++js)
#pragma unroll
                for (int j = 0; j < 4; ++j) { s[js][j] = __builtin_amdgcn_exp2f(s[js][j] - mnew); psum += s[js][j]; }
            lsum = lsum * alpha + psum;
#pragma unroll
            for (int i = 0; i < 4; ++i) o[i] *= alpha;
#pragma unroll
            for (int kk = 0; kk < 2; ++kk) {
                const u32x4 pw = pack8(s[2 * kk], s[2 * kk + 1]); bf16x8 pf; __builtin_memcpy(&pf, &pw, 16);
#pragma unroll
                for (int dv = 0; dv < 4; ++dv) {
                    const LAS bf16_t* vp = Vs + (dv * 16 + l15) * 72 + kk * 32 + quad * 4;
                    u32x4 vw; const u32x2 v0 = *(const LAS u32x2*)vp, v1 = *(const LAS u32x2*)(vp + 16); vw.x = v0.x; vw.y = v0.y; vw.z = v1.x; vw.w = v1.y;
                    bf16x8 va; __builtin_memcpy(&va, &vw, 16);
                    o[dv] = __builtin_amdgcn_mfma_f32_16x16x32_bf16(va, pf, o[dv], 0, 0, 0);
                }
            }
        }
        lsum += shfl_idx(lsum, lane ^ 16); lsum += shfl_idx(lsum, lane ^ 32);
        const float inv = 1.0f / lsum;
#pragma unroll
        for (int dv = 0; dv < 4; ++dv) *(u32x2*)(AO + (size_t)qrow * 512 + h * 64 + dv * 16 + quad * 4) = pack4(o[dv] * inv);
    }
}

template <int DIR>
__device__ __forceinline__ void scan_pass(const Params& p, unsigned char* ws, int l, int n, int tok0, int L, float h0, bool write_state, int state_idx, LAS unsigned char* lds) {
    const int zz = ozero();
    LAS float* xcf = (LAS float*)lds;
    LAS bf16_t* xcb = (LAS bf16_t*)(lds + 64 * 132 * 4);
    const int tid = otid(), wid = tid >> 6, lane = tid & 63, l15 = lane & 15, quad = lane >> 4;
    const int chl = wid * 16 + l15, ch = n * 128 + chl;
    const float* LXp = (const float*)(ws + WS_LX); bf16_t* HF = (bf16_t*)(ws + WS_SG) + 1024;   bf16_t* GG = (bf16_t*)(ws + WS_GG);
    const float lam = p.in[zz + I_LAM][(l * 2 + DIR) * 1024 + ch];
    const float nl = -lam, sp = fmaxf(nl, 0.f) + log1pf(__expf(-fabsf(nl)));
    const float cc = -8.0f * sp * LOG2E;
    const float br = p.in[zz + I_BRG][(l * 2 + DIR) * 1024 + ch], bi = p.in[zz + I_BIG][(l * 2 + DIR) * 1024 + ch];
    const bf16_t* wg = (const bf16_t*)(ws + WS_WG) + (size_t)((DIR * 8 + n) * 256) * 128;
    bf16x8 wrf[4], wif[4];
#pragma unroll
    for (int ks = 0; ks < 4; ++ks) { wrf[ks] = *(const bf16x8*)(wg + (size_t)chl * 128 + ks * 32 + quad * 8); wif[ks] = *(const bf16x8*)(wg + (size_t)(128 + chl) * 128 + ks * 32 + quad * 8); }
    const int c4 = (tid & 31) * 4, tg = tid >> 5;
    const float* cw = p.in[zz + I_CONVW] + (size_t)l * 4 * 1024 + n * 128 + c4;
    const f32x4 w0 = *(const f32x4*)cw, w1 = *(const f32x4*)(cw + 1024), w2 = *(const f32x4*)(cw + 2048), w3 = *(const f32x4*)(cw + 3072);
    const f32x4 cb = *(const f32x4*)(p.in[zz + I_CONVB] + l * 1024 + n * 128 + c4);
    float hin = h0;
    const int nchunk = L >> 6;
    f32x4 xr[7];
    {
        const int t0f = (DIR ? nchunk - 1 : 0) * 64;
#pragma unroll
        for (int r = 0; r < 7; ++r) { const int tt = t0f + tg * 4 - 2 + r; xr[r] = (tt >= 0 && tt < L) ? *(const f32x4*)(LXp + (size_t)(tok0 + tt) * 1024 + n * 128 + c4) : (f32x4){0.f, 0.f, 0.f, 0.f}; }
    }
    for (int ci = 0; ci < nchunk; ++ci) {
        const int t0 = (DIR ? nchunk - 1 - ci : ci) * 64;
        __syncthreads();
#pragma unroll
        for (int j = 0; j < 4; ++j) { const f32x4 xc = cb + xr[j] * w0 + xr[j + 1] * w1 + xr[j + 2] * w2 + xr[j + 3] * w3;
            *(LAS f32x4*)(xcf + (tg * 4 + j) * 132 + c4) = xc; *(LAS u32x2*)(xcb + (tg * 4 + j) * 136 + c4) = pack4(xc); }
        __syncthreads();
        if (ci + 1 < nchunk) {
            const int t0n = (DIR ? nchunk - 2 - ci : ci + 1) * 64;
#pragma unroll
            for (int r = 0; r < 7; ++r) { const int tt = t0n + tg * 4 - 2 + r; xr[r] = (tt >= 0 && tt < L) ? *(const f32x4*)(LXp + (size_t)(tok0 + tt) * 1024 + n * 128 + c4) : (f32x4){0.f, 0.f, 0.f, 0.f}; }
        }
        typedef unsigned short us2 __attribute__((ext_vector_type(2)));
        us2 hg[4][4];
        if (DIR == 1) {
#pragma unroll
            for (int st = 0; st < 4; ++st)
#pragma unroll
                for (int j = 0; j < 4; ++j) { const size_t idx = (size_t)(tok0 + t0 + st * 16 + quad * 4 + j) * 1024 + ch; hg[st][j].x = HF[idx + (idx - ch)]; hg[st][j].y = GG[idx]; }
        }
        f32x4 rg[4], ig[4];
#pragma unroll
        for (int st = 0; st < 4; ++st) { rg[st] = (f32x4){0.f, 0.f, 0.f, 0.f}; ig[st] = (f32x4){0.f, 0.f, 0.f, 0.f};
#pragma unroll
            for (int ks = 0; ks < 4; ++ks) { const bf16x8 a = *(const LAS bf16x8*)(xcb + (st * 16 + l15) * 136 + ks * 32 + quad * 8);
                rg[st] = __builtin_amdgcn_mfma_f32_16x16x32_bf16(a, wrf[ks], rg[st], 0, 0, 0); ig[st] = __builtin_amdgcn_mfma_f32_16x16x32_bf16(a, wif[ks], ig[st], 0, 0, 0); } }
#pragma unroll
        for (int sti = 0; sti < 4; ++sti) {
            const int st = DIR ? 3 - sti : sti;
            float av[4], hv[4], pa[4];
#pragma unroll
            for (int j = 0; j < 4; ++j) { const float x = xcf[(st * 16 + quad * 4 + j) * 132 + chl];
                const float rr = fast_sigmoid(rg[st][j] + br), ii = fast_sigmoid(ig[st][j] + bi);
                const float a = __builtin_amdgcn_exp2f(cc * rr); av[j] = a; hv[j] = __builtin_amdgcn_sqrtf(fmaxf(1.0f - a * a, 0.f)) * ii * x; }
            float hl = 0.f, pr = 1.f;
#pragma unroll
            for (int s4 = 0; s4 < 4; ++s4) { const int j = DIR ? 3 - s4 : s4; hl = av[j] * hl + hv[j]; pr *= av[j]; hv[j] = hl; pa[j] = pr; }
            float Ar = 1.f, Hr = 0.f, Aex = 1.f, Hex = 0.f;
#pragma unroll
            for (int s4 = 0; s4 < 4; ++s4) { const int qq = DIR ? 3 - s4 : s4; const float Aq = shfl_idx(pr, qq * 16 + l15), Hq = shfl_idx(hl, qq * 16 + l15);
                if (qq == quad) { Aex = Ar; Hex = Hr; }
                Hr = Aq * Hr + Hq; Ar *= Aq; }
            const float cq = Aex * hin + Hex;
            hin = Ar * hin + Hr;
#pragma unroll
            for (int j = 0; j < 4; ++j) { const float hfin = hv[j] + pa[j] * cq; const size_t idx = (size_t)(tok0 + t0 + st * 16 + quad * 4 + j) * 1024 + ch;
                if (DIR == 0) HF[idx + (idx - ch)] = f2bf(hfin);
                else GG[idx] = f2bf((bf2f(hg[st][j].x) + hfin) * bf2f(hg[st][j].y)); }
        }
    }
    if (write_state && quad == 0) (p.out + zz)[(DIR ? OFF_LB : OFF_LF) + state_idx + ch] = hin * (DIR ? OS5 : OS4);
}
__device__ __forceinline__ void scan_phase(const Params& p, unsigned char* ws, int l, LAS unsigned char* lds) {
    const int zz = ozero();
    const int tid = otid(), l15 = tid & 15, wid = tid >> 6; const int bid = obid(), G = ogrid();
    for (int rr = 0; rr < 2; ++rr) {
        const int it = rr == 0 ? bid : ((G == 256 && bid >= 32 && bid < 64) ? 224 + bid : (G == 256 ? 288 : bid + G));
        if (it >= 288) break;
        int n, tok0, L, sidx; bool lat; float hf0 = 0.f, hb0 = 0.f;
        if (it < 32) { const int b = it >> 3; n = it & 7; tok0 = MP + b * 1024; L = 1024; lat = true; sidx = 0; const int ch = n * 128 + wid * 16 + l15;
            hf0 = p.in[zz + I_SF][(b * 2 + l) * 1024 + ch]; hb0 = p.in[zz + I_SB][(b * 2 + l) * 1024 + ch]; }
        else { const int j = it - 32, s = j >> 3; n = j & 7; tok0 = s * 256; L = 256; lat = false; sidx = (s * 2 + l) * 1024; }
        scan_pass<0>(p, ws, l, n, tok0, L, hf0, !lat, sidx, lds);
        scan_pass<1>(p, ws, l, n, tok0, L, hb0, !lat, sidx, lds);
    }
}

__device__ __forceinline__ unsigned char* opq_unused(unsigned char* x) { asm volatile("" : "+s"(x)); return x; }
__device__ __forceinline__ void grid_sync_all(unsigned* bar, int k, int G) {
    asm volatile("s_waitcnt vmcnt(0) lgkmcnt(0)" ::: "memory");
    __syncthreads();
    const int t = otid();
    if (k == 0) {
        if (t < 64) { __builtin_amdgcn_fence(__ATOMIC_RELEASE, "agent"); asm volatile("s_waitcnt vmcnt(0) lgkmcnt(0)" ::: "memory"); }
        cg::this_grid().sync();
    } else if (t < 64) {
        __builtin_amdgcn_fence(__ATOMIC_RELEASE, "agent"); asm volatile("s_waitcnt vmcnt(0) lgkmcnt(0)" ::: "memory");
        if (t == 0) {
            __hip_atomic_fetch_add(bar, 1u, __ATOMIC_RELAXED, __HIP_MEMORY_SCOPE_AGENT);
            const unsigned want = (unsigned)k * (unsigned)G;
            while (__hip_atomic_load(bar, __ATOMIC_RELAXED, __HIP_MEMORY_SCOPE_AGENT) < want) __builtin_amdgcn_s_sleep(2);
        }
    }
    if (t < 64) { __builtin_amdgcn_fence(__ATOMIC_ACQUIRE, "agent"); asm volatile("s_waitcnt vmcnt(0) lgkmcnt(0)" ::: "memory"); }
    __syncthreads();
}
__global__ void __launch_bounds__(NTHREADS) fwd_megakernel(Params p) {
    extern __shared__ __attribute__((aligned(16))) unsigned char smem[];
    LAS unsigned char* lds = (LAS unsigned char*)smem;
    int nsync = 0; unsigned* gbar = (unsigned*)(p.ws + WS_BAR);
    int ph = 0; (void)ph; int phc = 0; (void)phc;
#if defined(STOP_AFTER)
#define PHASE_IF if (phc <= STOP_AFTER)
#define PHASE_END do { ++phc; grid_sync_all(gbar, nsync++, (int)gridDim.x); } while (0)
#elif ONE_LAUNCH
#define PHASE_IF
#define PHASE_END do { grid_sync_all(gbar, nsync++, (int)gridDim.x); } while (0)
#else
#define PHASE_IF if (__builtin_amdgcn_readfirstlane((int)(ph >= p.ph_lo && ph < p.ph_hi)))
#define PHASE_END do { ++ph; } while (0)
#endif

    PHASE_IF PHK(0) { const int zz = ozero(); unsigned char* ws = p.ws + zz; const int G = ogrid(), bid = obid(); (void)G; (void)bid; const float* modv = (const float*)(ws + WS_MODV); const float* modl = modv; (void)modl;
        rope_table(p, ws);
        modv_phase(p, ws, (LAS float*)lds);
        for (int i = bid; i < CONV_ITEMS; i += 2 * G) { const bool hb = i + G < CONV_ITEMS; const CJob ja = conv_decode(p, ws, 0, i), jb = conv_decode(p, ws, 0, hb ? i + G : i); conv_pair(ja, jb, hb, (LAS float*)lds); }
    }
    PHASE_END;
    PHASE_IF PHK(1) { const int zz = ozero(); unsigned char* ws = p.ws + zz; const int G = ogrid(), bid = obid(); (void)G; (void)bid; const float* modv = (const float*)(ws + WS_MODV); const float* modl = modv; (void)modl; norm_phase<false, true>(p, ws, p.in[zz + I_XP], p.in[zz + I_XS], nullptr, nullptr, 0, nullptr, p.in[zz + I_GPM], 0, 1024, modv); }
    PHASE_END;
#pragma unroll 1
    for (int l = 0; l < 2; ++l) {
        PHASE_IF PHK(2) { const int zz = ozero(); unsigned char* ws = p.ws + zz; const int G = ogrid(), bid = obid(); (void)G; (void)bid; const float* modv = (const float*)(ws + WS_MODV); const float* modl = modv + (size_t)l * 5 * 6144; (void)modl; pg8::Gemm g{(const bf16_t*)(ws + WS_HBF), (const bf16_t*)(ws + WS_WIN), MT, INCP, 1024}; pg8::StaticOrder S; S.init(MT, INCP, G, bid);
            EpiIn E{(float*)(ws + WS_PSM), (float*)(ws + WS_LX), (bf16_t*)(ws + WS_GG), (bf16_t*)(ws + WS_SG), (bf16_t*)(ws + WS_HF)}; pg8::gemm_phase(lds, g, S, E); }
        PHASE_END;
        PHASE_IF PHK(3) { const int zz = ozero(); unsigned char* ws = p.ws + zz; const int G = ogrid(), bid = obid(); (void)G; (void)bid; const float* modv = (const float*)(ws + WS_MODV); const float* modl = modv + (size_t)l * 5 * 6144; (void)modl; postproj_phase(p, ws, l); }
        PHASE_END;
        PHASE_IF PHK(4) { const int zz = ozero(); unsigned char* ws = p.ws + zz; const int G = ogrid(), bid = obid(); (void)G; (void)bid; const float* modv = (const float*)(ws + WS_MODV); const float* modl = modv + (size_t)l * 5 * 6144; (void)modl;
            { pg8::Gemm g{(const bf16_t*)(ws + WS_QN), (const bf16_t*)(ws + WS_WQ), MT, 768, 384}; pg8::StaticOrder S; S.init(MT, 768, G, bid);
              EpiQ E{(bf16_t*)(ws + WS_QB), (const float*)(ws + WS_ROPE), (const float*)(ws + WS_ROPE) + 1024 * 16}; pg8::gemm_phase(lds, g, S, E); }
            { pg8::Gemm g{(const bf16_t*)(ws + WS_KEYS), (const bf16_t*)(ws + WS_WKV), NKEY, 512, 256}; pg8::StaticOrder S; S.init(NKEY, 512, G, (bid + G - 144 % G) % G);
              EpiBf16 E{(bf16_t*)(ws + WS_KN), 512}; pg8::gemm_phase(lds, g, S, E); }
            { pg8::Gemm g{(const bf16_t*)(ws + WS_WKV) + (size_t)512 * 256, (const bf16_t*)(ws + WS_KEYS), 512, NKEY, 256}; pg8::StaticOrder S; S.init(512, NKEY, G, (bid + G - 248 % G) % G);
              EpiBf16 E{(bf16_t*)(ws + WS_VT), NKEY}; pg8::gemm_phase(lds, g, S, E); }
        }
        PHASE_END;
        PHASE_IF PHK(5) { const int zz = ozero(); unsigned char* ws = p.ws + zz; const int G = ogrid(), bid = obid(); (void)G; (void)bid; const float* modv = (const float*)(ws + WS_MODV); const float* modl = modv + (size_t)l * 5 * 6144; (void)modl; attn_phase(p, ws, lds); }
        PHASE_IF PHK(6) { const int zz = ozero(); unsigned char* ws = p.ws + zz; const int G = ogrid(), bid = obid(); (void)G; (void)bid; const float* modv = (const float*)(ws + WS_MODV); const float* modl = modv + (size_t)l * 5 * 6144; (void)modl; scan_phase(p, ws, l, lds); }
        PHASE_END;
        PHASE_IF PHK(7) { const int zz = ozero(); unsigned char* ws = p.ws + zz; const int G = ogrid(), bid = obid(); (void)G; (void)bid; const float* modv = (const float*)(ws + WS_MODV); const float* modl = modv + (size_t)l * 5 * 6144; (void)modl;
            { pg8::Gemm g{(const bf16_t*)(ws + WS_AO), (const bf16_t*)(ws + WS_WOMLA), MT, 1024, 512}; pg8::StaticOrder S; S.init(MT, 1024, G, bid);
              EpiMla E{(float*)(ws + WS_LX), (const bf16_t*)(ws + WS_SG)}; pg8::gemm_phase(lds, g, S, E); }
            { pg8::Gemm g{(const bf16_t*)(ws + WS_GG), (const bf16_t*)(ws + WS_WOLRU), MT, 1024, 1024}; pg8::StaticOrder S; S.init(MT, 1024, G, bid);
              EpiLru E{(const float*)(ws + WS_LX), (const bf16_t*)(ws + WS_SG), (bf16_t*)(ws + WS_Z), (const bf16_t*)(ws + WS_HF)}; pg8::gemm_phase(lds, g, S, E); }
        }
        PHASE_END;
        PHASE_IF PHK(8) { const int zz = ozero(); unsigned char* ws = p.ws + zz; const int G = ogrid(), bid = obid(); (void)G; (void)bid; const float* modv = (const float*)(ws + WS_MODV); const float* modl = modv + (size_t)l * 5 * 6144; (void)modl; pg8::Gemm g{(const bf16_t*)(ws + WS_Z), (const bf16_t*)(ws + WS_WOUT), MT, 1024, 1024}; pg8::StaticOrder S; S.init(MT, 1024, G, bid);
            EpiF32 E{(float*)(ws + WS_LX), 1024}; pg8::gemm_phase(lds, g, S, E); }
        PHASE_END;
        PHASE_IF PHK(9) { const int zz = ozero(); unsigned char* ws = p.ws + zz; const int G = ogrid(), bid = obid(); (void)G; (void)bid; const float* modv = (const float*)(ws + WS_MODV); const float* modl = modv + (size_t)l * 5 * 6144; (void)modl; const float* xp = l == 0 ? p.in[zz + I_XP] : (p.out + zz); const float* xs = l == 0 ? p.in[zz + I_XS] : (p.out + zz) + (size_t)MP * D; norm_phase<true, true>(p, ws, xp, xs, (const float*)(ws + WS_LX), p.in[zz + I_GQM] + l * D, 2048, modl, p.in[zz + I_GPF] + l * D, 3072, 4096, modl); }
        PHASE_END;
        PHASE_IF PHK(10) { const int zz = ozero(); unsigned char* ws = p.ws + zz; const int G = ogrid(), bid = obid(); (void)G; (void)bid; const float* modv = (const float*)(ws + WS_MODV); const float* modl = modv + (size_t)l * 5 * 6144; (void)modl; pg8::Gemm g{(const bf16_t*)(ws + WS_HBF), (const bf16_t*)(ws + WS_WFFI), MT, 5632, 1024}; pg8::StaticOrder S; S.init(MT, 5632, G, bid);
            EpiFfi E{(bf16_t*)(ws + WS_HID)}; pg8::gemm_phase(lds, g, S, E); }
        PHASE_END;
        PHASE_IF PHK(11) { const int zz = ozero(); unsigned char* ws = p.ws + zz; const int G = ogrid(), bid = obid(); (void)G; (void)bid; const float* modv = (const float*)(ws + WS_MODV); const float* modl = modv + (size_t)l * 5 * 6144; (void)modl; pg8::Gemm g{(const bf16_t*)(ws + WS_HID), (const bf16_t*)(ws + WS_WFFO), MT, 1024, FF}; pg8::StaticOrder S; S.init(MT, 1024, G, bid);
            EpiF32 E{(float*)(ws + WS_LX), 1024}; pg8::gemm_phase(lds, g, S, E); }
        PHASE_END;
        PHASE_IF PHK(12) { const int zz = ozero(); unsigned char* ws = p.ws + zz; const int G = ogrid(), bid = obid(); (void)G; (void)bid; const float* modv = (const float*)(ws + WS_MODV); const float* modl = modv + (size_t)l * 5 * 6144; (void)modl;
            if (l == 0) {
                norm_phase<true, true>(p, ws, (p.out + zz), (p.out + zz) + (size_t)MP * D, (const float*)(ws + WS_LX), p.in[zz + I_GQF], 5120, modl, p.in[zz + I_GPM] + D, 0, 1024, modv + (size_t)5 * 6144);
                for (int i = bid; i < CONV_ITEMS; i += 2 * G) { const bool hb = i + G < CONV_ITEMS; const CJob ja = conv_decode(p, ws, 1, i), jb = conv_decode(p, ws, 1, hb ? i + G : i); conv_pair(ja, jb, hb, (LAS float*)lds); }
            } else {
                norm_phase<true, false>(p, ws, (p.out + zz), (p.out + zz) + (size_t)MP * D, (const float*)(ws + WS_LX), p.in[zz + I_GQF] + D, 5120, modl, nullptr, 0, 0, nullptr);
            }
        }
#if ONE_LAUNCH && !defined(STOP_AFTER)
        if (l == 0) grid_sync_all(gbar, nsync++, (int)gridDim.x);
#else
        PHASE_END;
#endif
    }
#if defined(STOP_AFTER)
    {
        const int tid = otid(), bid = obid(), G = ogrid(); const unsigned* wsu = (const unsigned*)p.ws; float* out = p.out;
        for (int i = bid * NTHREADS + tid; i < 17432576; i += G * NTHREADS) { float a = 0.f;
#pragma unroll
            for (int j = 0; j < 4; ++j) { const size_t idx = (size_t)i + (size_t)j * 17432576; if (idx * 4 < WS_END) { const unsigned u = wsu[idx]; a += (float)(u & 0xffu) + (float)((u >> 16) & 0xffu); } }
            out[i] = a; }
    }
#endif
}
constexpr int NPHASES = 2 + 11 * 2;

extern "C" void kernel_launch(void* const* d_in, const int* in_sizes, int n_in, void* d_out, int out_size, void* d_ws, size_t ws_size, hipStream_t stream) {
    static int grid = 0;
    if (grid == 0) {
        if (n_in != 31 || ws_size < WS_END) { fprintf(stderr, "kernel_launch: need 31 inputs and %zu bytes of workspace (got %d, %zu)\n", (size_t)WS_END, n_in, ws_size); grid = -1; return; }
        if (hipFuncSetAttribute((const void*)fwd_megakernel, hipFuncAttributeMaxDynamicSharedMemorySize, LDS_BYTES) != hipSuccess) { fprintf(stderr, "kernel_launch: hipFuncSetAttribute failed\n"); grid = -1; return; }
        int dev = 0, cus = 0, per_cu = 0;
        hipGetDevice(&dev); hipDeviceGetAttribute(&cus, hipDeviceAttributeMultiprocessorCount, dev);
        hipOccupancyMaxActiveBlocksPerMultiprocessor(&per_cu, (const void*)fwd_megakernel, NTHREADS, LDS_BYTES);
        if (per_cu < 1) { fprintf(stderr, "kernel_launch: occupancy query says %d blocks/CU\n", per_cu); per_cu = 1; }
        (void)hipGetLastError();
        grid = cus;
    }
    if (grid < 0) return;
    (void)hipMemsetAsync((unsigned char*)d_ws + WS_BAR, 0, 256, stream);
    Params p{};
    for (int i = 0; i < 31; ++i) p.in[i] = (const float*)d_in[i];
    p.out = (float*)d_out; p.ws = (unsigned char*)d_ws;
#if ONE_LAUNCH
    p.ph_lo = 0; p.ph_hi = NPHASES; p.coop = 1;
    void* args[] = {&p};
    hipError_t e = hipLaunchCooperativeKernel((const void*)fwd_megakernel, dim3(grid), dim3(NTHREADS), args, LDS_BYTES, stream);
    if (e != hipSuccess) fprintf(stderr, "cooperative launch failed: %s (grid %d)\n", hipGetErrorString(e), grid);
#else
    for (int ph = 0; ph < NPHASES; ++ph) {
        p.ph_lo = ph; p.ph_hi = ph + 1; p.coop = 0;
        hipLaunchKernelGGL(fwd_megakernel, dim3(grid), dim3(NTHREADS), LDS_BYTES, stream, p);
    }
#endif
}
```

```cpp
#include <hip/hip_runtime.h>
#include <hip/hip_cooperative_groups.h>
#include <cstdio>
namespace cg = cooperative_groups;

#ifndef ONE_LAUNCH
#define ONE_LAUNCH 1
#endif

#ifndef PHMASK
#define PHMASK 0xffff
#endif
#define PHK(k) if constexpr (((PHMASK) >> (k)) & 1)
#ifndef LSCALE
#define LSCALE 1.0f
#endif
#ifndef MSCALE
#define MSCALE 1.0f
#endif
#ifndef FSCALE
#define FSCALE 1.0f
#endif
#ifndef OS0
#define OS0 1.0f
#endif
#ifndef OS1
#define OS1 1.0f
#endif
#ifndef OS2
#define OS2 1.0f
#endif
#ifndef OS3
#define OS3 1.0f
#endif
#ifndef OS4
#define OS4 1.0f
#endif
#ifndef OS5
#define OS5 1.0f
#endif
#ifndef ZMASK
#define ZMASK(row, col) false
#endif
#ifndef HSCALE
#define HSCALE 1.0f
#endif
#ifndef BSCALE
#define BSCALE 1.0f
#endif
#ifndef GGVAL
#define GGVAL(x) (x)
#endif
#ifndef GLVAL
#define GLVAL(x) (x)
#endif
#ifndef GLOFF
#define GLOFF 1024
#endif
#ifndef ZSCALE
#define ZSCALE 1.0f
#endif
#define LAS __attribute__((address_space(3)))
typedef unsigned short bf16_t;
typedef short bf16x8 __attribute__((ext_vector_type(8)));
typedef float f32x4 __attribute__((ext_vector_type(4)));
typedef float f32x2 __attribute__((ext_vector_type(2)));
typedef unsigned u32x4 __attribute__((ext_vector_type(4)));
typedef unsigned u32x2 __attribute__((ext_vector_type(2)));

constexpr int D = 1024, MT = 12288, MP = 8192, NKEY = 13312, FF = 2816;
constexpr int INCP = 4864;
constexpr int NTHREADS = 512, LDS_BYTES = 131072;
constexpr float EPS = 1e-6f;
constexpr float LOG2E = 1.4426950408889634f;
constexpr float QSCALE = 0.10206207261596577f * 1.4426950408889634f;

constexpr size_t OFF_CKV = 12582912, OFF_KR = 16777216, OFF_LF = 17301504, OFF_LB = 17367040;

constexpr size_t WS_MODV = 0;
constexpr size_t WS_ROPE = WS_MODV + 2 * 5 * 6144 * 4;
constexpr size_t WS_WIN = WS_ROPE + 2 * 1024 * 16 * 4;
constexpr size_t WS_WFFI = WS_WIN + (size_t)INCP * 1024 * 2;
constexpr size_t WS_WFFO = WS_WFFI + (size_t)5632 * 1024 * 2;
constexpr size_t WS_WOUT = WS_WFFO + (size_t)1024 * 2816 * 2;
constexpr size_t WS_WOLRU = WS_WOUT + (size_t)1024 * 1024 * 2;
constexpr size_t WS_WOMLA = WS_WOLRU + (size_t)1024 * 1024 * 2;
constexpr size_t WS_WQ = WS_WOMLA + (size_t)1024 * 512 * 2;
constexpr size_t WS_WKV = WS_WQ + (size_t)768 * 384 * 2;
constexpr size_t WS_WG = WS_WKV + (size_t)1024 * 256 * 2;
constexpr size_t WS_HBF = WS_WG + (size_t)2 * 8 * 256 * 128 * 2;
constexpr size_t WS_QN = WS_HBF;
constexpr size_t WS_KEYS = WS_QN + (size_t)MT * 384 * 2;
constexpr size_t WS_KRB = WS_KEYS + (size_t)NKEY * 256 * 2;
constexpr size_t WS_AO = WS_HBF;
constexpr size_t WS_PSM = WS_HBF + (size_t)MT * 1024 * 2;
constexpr size_t WS_QB = WS_PSM;
constexpr size_t WS_KN = WS_QB + (size_t)MT * 768 * 2;
constexpr size_t WS_Z = WS_PSM;
constexpr size_t WS_LX = WS_PSM + (size_t)MT * 768 * 4;
constexpr size_t WS_GG = WS_LX + (size_t)MT * 1024 * 4;
constexpr size_t WS_SG = WS_GG + (size_t)MT * 1024 * 2;
constexpr size_t WS_HID = WS_GG;
constexpr size_t WS_VT = WS_SG + (size_t)MT * 2048 * 2;
constexpr size_t WS_HF = WS_VT + (size_t)512 * NKEY * 2;
constexpr size_t WS_BAR = WS_HF + (size_t)MT * 1024 * 2;
constexpr size_t WS_END = WS_BAR + 256;

struct Params {
    const float* in[31];
    float* out;
    unsigned char* ws;
    int ph_lo, ph_hi, coop, pad;
};
enum { I_XP = 0, I_XS, I_CCKV, I_CKR, I_SF, I_SB, I_C, I_CCTX, I_WMOD, I_BMOD, I_GPM, I_GQM, I_GPF, I_GQF, I_WIN, I_GQ, I_WQUP, I_GKV,
       I_WKVUP, I_WOMLA, I_CONVW, I_CONVB, I_WRG, I_BRG, I_WIG, I_BIG, I_LAM, I_WOLRU, I_WOUT, I_WFFI, I_WFFO };

__device__ __forceinline__ unsigned char* opq(unsigned char* x) { asm volatile("" : "+s"(x)); return x; }
__device__ __forceinline__ int ozero() { int t = 0; asm volatile("" : "+s"(t)); return t; }
__device__ __forceinline__ int otid() { int t = threadIdx.x; asm volatile("" : "+v"(t)); return t; }
__device__ __forceinline__ int obid() { int t = blockIdx.x; asm volatile("" : "+s"(t)); return t; }
__device__ __forceinline__ int ogrid() { int t = gridDim.x; asm volatile("" : "+s"(t)); return t; }
__device__ __forceinline__ unsigned cvt_pk_bf16(float lo, float hi) { unsigned r; asm volatile("v_cvt_pk_bf16_f32 %0, %1, %2" : "=v"(r) : "v"(lo), "v"(hi)); return r; }
__device__ __forceinline__ float bf2f(bf16_t b) { return __uint_as_float(((unsigned)b) << 16); }
__device__ __forceinline__ bf16_t f2bf(float f) { return (bf16_t)(cvt_pk_bf16(f, 0.f) & 0xffffu); }
__device__ __forceinline__ float shfl_idx(float v, int srclane) { return __int_as_float(__builtin_amdgcn_ds_bpermute(srclane << 2, __float_as_int(v))); }
__device__ __forceinline__ float wave_sum(float v, int lane) {
#pragma unroll
    for (int o = 32; o >= 1; o >>= 1) v += shfl_idx(v, lane ^ o);
    return v;
}
__device__ __forceinline__ float fast_sigmoid(float x) { return __builtin_amdgcn_rcpf(1.0f + __builtin_amdgcn_exp2f(-x * LOG2E)); }
__device__ __forceinline__ float gelu_tanh(float x) { const float z = 1.5957691216057308f * (x + 0.044715f * x * x * x); return x * fast_sigmoid(z); }
__device__ __forceinline__ int keyrow_of(int t) { return t < MP ? t : MP + ((t - MP) >> 10) * 1280 + ((t - MP) & 1023); }

namespace pg8 {
constexpr int BM = 256, BK = 64, HALF = 128, HTB = HALF * BK * 2, NXCD = 8, WGM = 8;
__device__ __forceinline__ int lds_byte(int r, int c) { const int st = (r >> 4) * 2 + (c >> 5), rr = r & 15, cc = c & 31, ob = rr * 64 + cc * 2; return st * 1024 + (ob ^ (((ob >> 9) & 1) << 5)); }
__device__ __forceinline__ void stage_rc(int b, int& R, int& C) { const int st = b / 1024, sb = b % 1024, swz = sb ^ (((sb >> 9) & 1) << 5); R = (st >> 1) * 16 + swz / 64; C = (st & 1) * 32 + (swz % 64) / 2; }
__device__ __forceinline__ int perm32(int rho) { const int n = rho >> 4, i = rho & 15; return 8 * (i >> 2) + 4 * n + (i & 3); }
struct Unit { int pm, pn; };
struct Gemm { const bf16_t* A; const bf16_t* Bt; int M, N, K; };
struct StaticOrder {
    int nM, nN, nwg, G, c;
    __device__ void init(int M, int N, int G_, int c_) { nM = M / BM; nN = N / BM; nwg = nM * nN; G = G_; c = c_; }
    __device__ bool next(int i, Unit& u) const {
        const int L = i * G + c; if (L >= nwg) return false;
        int wgid = L; { const int q = nwg / NXCD, r = nwg % NXCD, xcd = wgid % NXCD, off = wgid / NXCD; wgid = (xcd < r ? xcd * (q + 1) : r * (q + 1) + (xcd - r) * q) + off; }
        const int nig = WGM * nN, gid = wgid / nig, fm = gid * WGM, gsz = (nM - fm) < WGM ? (nM - fm) : WGM;
        u.pm = fm + ((wgid % nig) % gsz); u.pn = (wgid % nig) / gsz; return true;
    }
};
template <class Epi>
__device__ __forceinline__ void gemm_phase(LAS unsigned char* lds, const Gemm g, const StaticOrder& S, const Epi& E) {
    int tid_ = threadIdx.x; asm volatile("" : "+v"(tid_));
    const int tid = tid_, wid = __builtin_amdgcn_readfirstlane(tid >> 6), lane = tid & 63, wr = wid >> 2, wc = wid & 3, fr = lane & 15, fq = lane >> 4;
    const int K = g.K, nt = K / BK;
    unsigned voffA[2], voffB[2];
#pragma unroll
    for (int i = 0; i < 2; ++i) { int R, C; stage_rc(tid * 16 + i * 8192, R, C); const int Rb = Epi::PERM ? ((R & ~31) + perm32(R & 31)) : R;
        voffA[i] = (unsigned)(R * K + C) * 2u; voffB[i] = (unsigned)(Rb * K + C) * 2u; }
    const size_t kstep = (size_t)(BK * 2);
    const size_t hstep = (size_t)HALF * K * 2;
    const size_t tstep = 2 * hstep;
    const unsigned ldsw = (unsigned)wid * 1024u;
    const int aoff = lds_byte(wr * 64 + fr, fq * 8), boff = lds_byte(wc * 32 + fr, fq * 8);
#define PG8_SA(b, h) (((b) * 2 + (h)) * HTB)
#define PG8_SB(b, h) ((4 + (b) * 2 + (h)) * HTB)
#define PG8_STAGE(bufoff, gbase, voff) do { _Pragma("unroll") for (int _i = 0; _i < 2; ++_i) \
        __builtin_amdgcn_global_load_lds((const unsigned*)((const char*)(gbase) + (voff)[_i]), (LAS unsigned*)(lds + (bufoff) + ldsw + _i * 8192), 16, 0, 0); } while (0)
#define PG8_LDA(dst, b, h) do { _Pragma("unroll") for (int m = 0; m < 4; ++m) _Pragma("unroll") for (int k = 0; k < 2; ++k) dst[m][k] = *(const LAS bf16x8*)(lds + PG8_SA(b, h) + aoff + m * 2048 + k * 1024); } while (0)
#define PG8_LDB(dst, b, h) do { _Pragma("unroll") for (int n = 0; n < 2; ++n) _Pragma("unroll") for (int k = 0; k < 2; ++k) dst[n][k] = *(const LAS bf16x8*)(lds + PG8_SB(b, h) + boff + n * 2048 + k * 1024); } while (0)
#define PG8_MMA(ai, bj, At, Bt) do { __builtin_amdgcn_s_setprio(1); _Pragma("unroll") for (int m = 0; m < 4; ++m) _Pragma("unroll") for (int n = 0; n < 2; ++n) _Pragma("unroll") for (int k = 0; k < 2; ++k) \
        acc[ai][bj][m][n] = __builtin_amdgcn_mfma_f32_16x16x32_bf16(Bt[n][k], At[m][k], acc[ai][bj][m][n], 0, 0, 0); __builtin_amdgcn_s_setprio(0); } while (0)
#define PG8_WAIT_V(n) asm volatile("s_waitcnt vmcnt(" #n ")" ::: "memory")
#define PG8_WAIT_L(n) asm volatile("s_waitcnt lgkmcnt(" #n ")" ::: "memory")
#define PG8_BAR __builtin_amdgcn_s_barrier()
#define PG8_SCHED __builtin_amdgcn_sched_barrier(0)
    Unit cur, nxt; int ui = 0;
    if (!S.next(0, cur)) return;
    f32x4 acc[2][2][4][2];
#pragma unroll
    for (int a = 0; a < 2; ++a)
#pragma unroll
        for (int b = 0; b < 2; ++b)
#pragma unroll
            for (int m = 0; m < 4; ++m)
#pragma unroll
                for (int n = 0; n < 2; ++n) acc[a][b][m][n] = (f32x4){0.f, 0.f, 0.f, 0.f};
    bf16x8 At[4][2], B0[2][2], B1[2][2];
    const char* cA = (const char*)g.A + (size_t)cur.pm * tstep; const char* cB = (const char*)g.Bt + (size_t)cur.pn * tstep;
    PG8_STAGE(PG8_SB(0, 0), cB, voffB); PG8_STAGE(PG8_SA(0, 0), cA, voffA); PG8_STAGE(PG8_SB(0, 1), cB + hstep, voffB); PG8_STAGE(PG8_SA(0, 1), cA + hstep, voffA);
    if (wr == 1) PG8_BAR;
    PG8_WAIT_V(4); PG8_BAR;
    PG8_STAGE(PG8_SB(1, 0), cB + kstep, voffB); PG8_STAGE(PG8_SA(1, 0), cA + kstep, voffA); PG8_STAGE(PG8_SB(1, 1), cB + hstep + kstep, voffB);
    PG8_WAIT_V(6); PG8_BAR;
    for (;;) {
        const bool has_next = S.next(ui + 1, nxt);
        const char* nA = has_next ? (const char*)g.A + (size_t)nxt.pm * tstep : cA; const char* nB = has_next ? (const char*)g.Bt + (size_t)nxt.pn * tstep : cB;
        for (int t = 0; t < nt; t += 2) {
            const bool last = (t == nt - 2);
            const char* a1 = cA + (size_t)(t + 1) * kstep;
            const char* a2 = last ? nA : cA + (size_t)(t + 2) * kstep; const char* b2 = last ? nB : cB + (size_t)(t + 2) * kstep;
            const char* a3 = a2 + kstep; const char* b3 = b2 + kstep;
            PG8_LDB(B0, 0, 0); PG8_SCHED; PG8_LDA(At, 0, 0); PG8_STAGE(PG8_SA(1, 1), a1 + hstep, voffA);
            PG8_WAIT_L(8); PG8_BAR; PG8_WAIT_L(0); PG8_MMA(0, 0, At, B0); PG8_BAR; PG8_SCHED;
            PG8_LDB(B1, 0, 1); PG8_STAGE(PG8_SB(0, 0), b2, voffB);
            PG8_BAR; PG8_WAIT_L(0); PG8_MMA(0, 1, At, B1); PG8_BAR;
            PG8_LDA(At, 0, 1); PG8_STAGE(PG8_SA(0, 0), a2, voffA);
            PG8_BAR; PG8_WAIT_L(0); PG8_MMA(1, 0, At, B0); PG8_BAR; PG8_SCHED;
            PG8_STAGE(PG8_SB(0, 1), b2 + hstep, voffB);
            PG8_WAIT_V(6); PG8_BAR; PG8_MMA(1, 1, At, B1); PG8_BAR;
            PG8_LDB(B0, 1, 0); PG8_SCHED; PG8_LDA(At, 1, 0); PG8_STAGE(PG8_SA(0, 1), a2 + hstep, voffA);
            PG8_WAIT_L(8); PG8_BAR; PG8_WAIT_L(0); PG8_MMA(0, 0, At, B0); PG8_BAR; PG8_SCHED;
            PG8_LDB(B1, 1, 1); PG8_STAGE(PG8_SB(1, 0), b3, voffB);
            PG8_BAR; PG8_WAIT_L(0); PG8_MMA(0, 1, At, B1); PG8_BAR;
            PG8_LDA(At, 1, 1); PG8_STAGE(PG8_SA(1, 0), a3, voffA);
            PG8_BAR; PG8_WAIT_L(0); PG8_MMA(1, 0, At, B0); PG8_BAR; PG8_SCHED;
            PG8_STAGE(PG8_SB(1, 1), b3 + hstep, voffB);
            PG8_WAIT_V(6); PG8_BAR; PG8_MMA(1, 1, At, B1); PG8_BAR;
        }
        E(acc, cur, wr, wc, fr, fq);
        if (!has_next) break;
#pragma unroll
        for (int a = 0; a < 2; ++a)
#pragma unroll
            for (int b = 0; b < 2; ++b)
#pragma unroll
                for (int m = 0; m < 4; ++m)
#pragma unroll
                    for (int n = 0; n < 2; ++n) acc[a][b][m][n] = (f32x4){0.f, 0.f, 0.f, 0.f};
        cur = nxt; cA = nA; cB = nB; ++ui;
    }
    PG8_WAIT_V(0);
    if (wr == 0) PG8_BAR;
    PG8_BAR;
#undef PG8_SA
#undef PG8_SB
#undef PG8_STAGE
#undef PG8_LDA
#undef PG8_LDB
#undef PG8_MMA
#undef PG8_WAIT_V
#undef PG8_WAIT_L
#undef PG8_BAR
#undef PG8_SCHED
}
}
using pg8::Unit;
typedef f32x4 AccT[2][2][4][2];

__device__ __forceinline__ u32x4 pack8(f32x4 a, f32x4 b) { u32x4 w; w.x = cvt_pk_bf16(a[0], a[1]); w.y = cvt_pk_bf16(a[2], a[3]); w.z = cvt_pk_bf16(b[0], b[1]); w.w = cvt_pk_bf16(b[2], b[3]); return w; }
__device__ __forceinline__ u32x2 pack4(f32x4 a) { u32x2 w; w.x = cvt_pk_bf16(a[0], a[1]); w.y = cvt_pk_bf16(a[2], a[3]); return w; }
__device__ __forceinline__ void unpack8(u32x4 w, f32x4& a, f32x4& b) {
    a[0] = __uint_as_float(w.x << 16); a[1] = __uint_as_float(w.x & 0xffff0000u); a[2] = __uint_as_float(w.y << 16); a[3] = __uint_as_float(w.y & 0xffff0000u);
    b[0] = __uint_as_float(w.z << 16); b[1] = __uint_as_float(w.z & 0xffff0000u); b[2] = __uint_as_float(w.w << 16); b[3] = __uint_as_float(w.w & 0xffff0000u);
}

struct EpiIn {
    static constexpr bool PERM = true;
    float* psm; float* lx; bf16_t* gg; bf16_t* sg; bf16_t* g2;
    __device__ __forceinline__ void operator()(const AccT& acc, const Unit& u, int wr, int wc, int fr, int fq) const {
        const int row0 = u.pm * 256 + wr * 64 + fr, colb = u.pn * 256 + wc * 32 + 8 * fq;
#pragma unroll
        for (int ai = 0; ai < 2; ++ai)
#pragma unroll
            for (int m = 0; m < 4; ++m) {
                const size_t row = (size_t)(row0 + ai * 128 + m * 16);
#pragma unroll
                for (int bj = 0; bj < 2; ++bj) {
                    const int col = colb + bj * 128; f32x4 v0 = acc[ai][bj][m][0], v1 = acc[ai][bj][m][1];
                    if (u.pn < 3) { float* q = psm + row * 768 + col; *(f32x4*)q = v0; *(f32x4*)(q + 4) = v1; }
                    else if (u.pn < 7) { float* q = lx + row * 1024 + (col - 768); *(f32x4*)q = v0; *(f32x4*)(q + 4) = v1; }
                    else if (u.pn < 11) {
#pragma unroll
                        for (int j = 0; j < 4; ++j) { v0[j] = gelu_tanh(v0[j]); v1[j] = gelu_tanh(v1[j]); }
                        *(u32x4*)(gg + row * 1024 + (col - 1792)) = pack8(v0, v1); }
                    else {
#pragma unroll
                        for (int j = 0; j < 4; ++j) { v0[j] = fast_sigmoid(v0[j]); v1[j] = fast_sigmoid(v1[j]); }
                        *(u32x4*)(sg + row * 2048 + (col - 2816)) = pack8(v0, v1);
                        if (u.pn >= 15) *(u32x4*)(g2 + row * 1024 + (col - 3840)) = pack8(v0, v1); }
                }
            }
    }
};
struct EpiQ {
    static constexpr bool PERM = false;
    bf16_t* q; const float* ropec; const float* ropes;
    __device__ __forceinline__ void operator()(const AccT& acc, const Unit& u, int wr, int wc, int fr, int fq) const {
        const int row0 = u.pm * 256 + wr * 64 + fr;
#pragma unroll
        for (int ai = 0; ai < 2; ++ai)
#pragma unroll
            for (int m = 0; m < 4; ++m) {
                const int row = row0 + ai * 128 + m * 16; const bool lat = row >= MP; const int pos = (row - MP) & 1023;
#pragma unroll
                for (int bj = 0; bj < 2; ++bj) {
                    const int base = u.pn * 256 + bj * 128 + wc * 32; const bool rope = lat && (((base >> 5) % 3) == 2);
                    f32x4 v0 = acc[ai][bj][m][0], v1 = acc[ai][bj][m][1];
                    if (rope) { const f32x4 cs = *(const f32x4*)(ropec + pos * 16 + 4 * fq), sn = *(const f32x4*)(ropes + pos * 16 + 4 * fq);
                        const f32x4 o0 = v0 * cs - v1 * sn, o1 = v0 * sn + v1 * cs; v0 = o0; v1 = o1; }
                    v0 *= QSCALE; v1 *= QSCALE;
                    bf16_t* dst = q + (size_t)row * 768 + base + 4 * fq;
                    *(u32x2*)dst = pack4(v0); *(u32x2*)(dst + 16) = pack4(v1);
                }
                asm volatile("" ::: "memory");
            }
    }
};
struct EpiBf16 {
    static constexpr bool PERM = true;
    bf16_t* o; int ldc;
    __device__ __forceinline__ void operator()(const AccT& acc, const Unit& u, int wr, int wc, int fr, int fq) const {
        const int row0 = u.pm * 256 + wr * 64 + fr, colb = u.pn * 256 + wc * 32 + 8 * fq;
#pragma unroll
        for (int ai = 0; ai < 2; ++ai)
#pragma unroll
            for (int m = 0; m < 4; ++m) {
                const size_t row = (size_t)(row0 + ai * 128 + m * 16);
#pragma unroll
                for (int bj = 0; bj < 2; ++bj) *(u32x4*)(o + row * ldc + colb + bj * 128) = pack8(acc[ai][bj][m][0], acc[ai][bj][m][1]);
            }
    }
};
struct EpiF32 {
    static constexpr bool PERM = true;
    float* o; int ldc;
    __device__ __forceinline__ void operator()(const AccT& acc, const Unit& u, int wr, int wc, int fr, int fq) const {
        const int row0 = u.pm * 256 + wr * 64 + fr, colb = u.pn * 256 + wc * 32 + 8 * fq;
#pragma unroll
        for (int ai = 0; ai < 2; ++ai)
#pragma unroll
            for (int m = 0; m < 4; ++m) {
                const size_t row = (size_t)(row0 + ai * 128 + m * 16);
#pragma unroll
                for (int bj = 0; bj < 2; ++bj) { float* q = o + row * ldc + colb + bj * 128; *(f32x4*)q = acc[ai][bj][m][0]; *(f32x4*)(q + 4) = acc[ai][bj][m][1]; }
            }
    }
};
struct EpiMla {
    static constexpr bool PERM = true;
    float* z1; const bf16_t* sg;
    __device__ __forceinline__ void operator()(const AccT& acc, const Unit& u, int wr, int wc, int fr, int fq) const {
        const int row0 = u.pm * 256 + wr * 64 + fr, colb = u.pn * 256 + wc * 32 + 8 * fq;
#pragma unroll
        for (int ai = 0; ai < 2; ++ai)
#pragma unroll
            for (int m = 0; m < 4; ++m) {
                const size_t row = (size_t)(row0 + ai * 128 + m * 16);
#pragma unroll
                for (int bj = 0; bj < 2; ++bj) { const int col = colb + bj * 128; f32x4 g0, g1; unpack8(*(const u32x4*)(sg + row * 2048 + col), g0, g1);
                    float* q = z1 + row * 1024 + col; *(f32x4*)q = acc[ai][bj][m][0] * g0 * ZSCALE; *(f32x4*)(q + 4) = acc[ai][bj][m][1] * g1 * ZSCALE; }
                asm volatile("" ::: "memory");
            }
    }
};
struct EpiLru {
    static constexpr bool PERM = true;
    const float* z1; const bf16_t* sg; bf16_t* z; const bf16_t* g2;
    __device__ __forceinline__ void operator()(const AccT& acc, const Unit& u, int wr, int wc, int fr, int fq) const {
        const int row0 = u.pm * 256 + wr * 64 + fr, colb = u.pn * 256 + wc * 32 + 8 * fq;
#pragma unroll
        for (int ai = 0; ai < 2; ++ai)
#pragma unroll
            for (int m = 0; m < 4; ++m) {
                const size_t row = (size_t)(row0 + ai * 128 + m * 16);
#pragma unroll
                for (int bj = 0; bj < 2; ++bj) { const int col = colb + bj * 128; f32x4 g0, g1; unpack8(*(const u32x4*)(g2 + row * 1024 + col), g0, g1);
                    const float* q = z1 + row * 1024 + col; const f32x4 a0 = *(const f32x4*)q + acc[ai][bj][m][0] * GLVAL(g0) * LSCALE, a1 = *(const f32x4*)(q + 4) + acc[ai][bj][m][1] * GLVAL(g1) * LSCALE;
                    *(u32x4*)(z + row * 1024 + col) = pack8(a0, a1); }
                asm volatile("" ::: "memory");
            }
    }
};
struct EpiFfi {
    static constexpr bool PERM = false;
    bf16_t* hid;
    __device__ __forceinline__ void operator()(const AccT& acc, const Unit& u, int wr, int wc, int fr, int fq) const {
        const int row0 = u.pm * 256 + wr * 64 + fr;
#pragma unroll
        for (int ai = 0; ai < 2; ++ai)
#pragma unroll
            for (int m = 0; m < 4; ++m) {
                const size_t row = (size_t)(row0 + ai * 128 + m * 16);
#pragma unroll
                for (int bj = 0; bj < 2; ++bj) { const int hc = ((u.pn * 256 + bj * 128 + wc * 32) >> 1) + 4 * fq; const f32x4 gv = acc[ai][bj][m][0], uv = acc[ai][bj][m][1]; f32x4 h;
#pragma unroll
                    for (int j = 0; j < 4; ++j) h[j] = gv[j] * fast_sigmoid(gv[j]) * uv[j];
                    *(u32x2*)(hid + row * FF + hc) = pack4(h); }
            }
    }
};

__device__ __forceinline__ int map_row(int mode, int n) {
    if (mode == 1) return n < 672 ? n : n + 96;
    if (mode == 2) { const int up = n >= FF, j = up ? n - FF : n; return (j >> 4) * 32 + (j & 15) + (up ? 16 : 0); }
    if (mode == 3) { const int h = n >> 7, r = n & 127; return r < 64 ? h * 64 + r : 512 + h * 64 + (r - 64); }
    return n;
}
__device__ __forceinline__ void conv_tile(const float* src, int ld, int K, int k0, int n0, bf16_t* dst, int mode, LAS float* tile) {
    const int tid = otid();
    __syncthreads();
#pragma unroll
    for (int i = 0; i < 2; ++i) { const int kk = (tid >> 3) + 64 * i, c4 = (tid & 7) * 4; const f32x4 v = *(const f32x4*)(src + (size_t)(k0 + kk) * ld + n0 + c4);
        tile[kk * 33 + c4] = v[0]; tile[kk * 33 + c4 + 1] = v[1]; tile[kk * 33 + c4 + 2] = v[2]; tile[kk * 33 + c4 + 3] = v[3]; }
    __syncthreads();
    const int n = tid >> 4, k8 = (tid & 15) * 8; f32x4 a, b;
#pragma unroll
    for (int j = 0; j < 4; ++j) { a[j] = tile[(k8 + j) * 33 + n]; b[j] = tile[(k8 + 4 + j) * 33 + n]; }
    *(u32x4*)(dst + (size_t)map_row(mode, n0 + n) * K + k0 + k8) = pack8(a, b);
}
constexpr int CONV_ITEMS = 4208;
struct CJob { const float* src; bf16_t* dst; int ld, K, k0, n0, mode; };
__device__ __forceinline__ CJob conv_decode(const Params& p, unsigned char* ws, int l, int idx) {
    const int zz = ozero();
    int inidx, K, N, mode = 0; size_t soff, doff;
    if (idx < 1192) { inidx = I_WIN; soff = (size_t)l * 1024 * 4768; doff = WS_WIN; K = 1024; N = 4768; mode = 1; }
    else if ((idx -= 1192) < 1408) { inidx = I_WFFI; soff = (size_t)l * 1024 * 5632; doff = WS_WFFI; K = 1024; N = 5632; mode = 2; }
    else if ((idx -= 1408) < 704) { inidx = I_WFFO; soff = (size_t)l * 2816 * 1024; doff = WS_WFFO; K = 2816; N = 1024; }
    else if ((idx -= 704) < 256) { inidx = I_WOUT; soff = (size_t)l * 1024 * 1024; doff = WS_WOUT; K = 1024; N = 1024; }
    else if ((idx -= 256) < 256) { inidx = I_WOLRU; soff = (size_t)l * 1024 * 1024; doff = WS_WOLRU; K = 1024; N = 1024; }
    else if ((idx -= 256) < 128) { inidx = I_WOMLA; soff = (size_t)l * 512 * 1024; doff = WS_WOMLA; K = 512; N = 1024; }
    else if ((idx -= 128) < 72) { inidx = I_WQUP; soff = (size_t)l * 384 * 768; doff = WS_WQ; K = 384; N = 768; }
    else if ((idx -= 72) < 64) { inidx = I_WKVUP; soff = (size_t)l * 256 * 1024; doff = WS_WKV; K = 256; N = 1024; mode = 3; }
    else { idx -= 64; const int mat = idx >> 2, ig = mat >> 4, dir = (mat >> 3) & 1, n = mat & 7;
        inidx = ig ? I_WIG : I_WRG; soff = (size_t)((l * 2 + dir) * 8 + n) * 16384; doff = WS_WG + (size_t)((dir * 8 + n) * 256 + ig * 128) * 128 * 2; K = 128; N = 128; idx &= 3; }
    const float* src = p.in[zz + inidx] + soff; bf16_t* dst = (bf16_t*)(ws + doff);
    const int nk = K / 128, kt = idx % nk, ntile = idx / nk;
    CJob j; j.src = src; j.dst = dst; j.ld = N; j.K = K; j.k0 = kt * 128; j.n0 = ntile * 32; j.mode = mode; return j;
}
__device__ __forceinline__ void conv_pair(const CJob& ja, const CJob& jb, bool hasb, LAS float* tile) {
    const int tid = otid();
    __syncthreads();
    f32x4 va[2], vb[2];
#pragma unroll
    for (int i = 0; i < 2; ++i) { const int kk = (tid >> 3) + 64 * i, c4 = (tid & 7) * 4; va[i] = *(const f32x4*)(ja.src + (size_t)(ja.k0 + kk) * ja.ld + ja.n0 + c4); }
    if (hasb) {
#pragma unroll
        for (int i = 0; i < 2; ++i) { const int kk = (tid >> 3) + 64 * i, c4 = (tid & 7) * 4; vb[i] = *(const f32x4*)(jb.src + (size_t)(jb.k0 + kk) * jb.ld + jb.n0 + c4); }
    }
#pragma unroll
    for (int i = 0; i < 2; ++i) { const int kk = (tid >> 3) + 64 * i, c4 = (tid & 7) * 4;
        tile[kk * 33 + c4] = va[i][0]; tile[kk * 33 + c4 + 1] = va[i][1]; tile[kk * 33 + c4 + 2] = va[i][2]; tile[kk * 33 + c4 + 3] = va[i][3];
        if (hasb) { tile[4224 + kk * 33 + c4] = vb[i][0]; tile[4224 + kk * 33 + c4 + 1] = vb[i][1]; tile[4224 + kk * 33 + c4 + 2] = vb[i][2]; tile[4224 + kk * 33 + c4 + 3] = vb[i][3]; } }
    __syncthreads();
    const int n = tid >> 4, k8 = (tid & 15) * 8; f32x4 a, b;
#pragma unroll
    for (int j = 0; j < 4; ++j) { a[j] = tile[(k8 + j) * 33 + n]; b[j] = tile[(k8 + 4 + j) * 33 + n]; }
    *(u32x4*)(ja.dst + (size_t)map_row(ja.mode, ja.n0 + n) * ja.K + ja.k0 + k8) = pack8(a, b);
    if (hasb) {
#pragma unroll
        for (int j = 0; j < 4; ++j) { a[j] = tile[4224 + (k8 + j) * 33 + n]; b[j] = tile[4224 + (k8 + 4 + j) * 33 + n]; }
        *(u32x4*)(jb.dst + (size_t)map_row(jb.mode, jb.n0 + n) * jb.K + jb.k0 + k8) = pack8(a, b);
    }
}
__device__ __forceinline__ void modv_phase(const Params& p, unsigned char* ws, LAS float* lds) {
    const int zz = ozero();
    LAS float* sc = lds + 128 * 33;
    LAS float* red = sc + 5 * 1024;
    const int tid = otid();
    __syncthreads();
    for (int i = tid; i < 5 * 1024; i += NTHREADS) { const float c = i < 1024 ? p.in[zz + I_CCTX][i] : p.in[zz + I_C][i - 1024]; sc[i] = c / (1.0f + __expf(-c)); }
    __syncthreads();
    float* modv = (float*)(ws + WS_MODV); const int bid = obid(), G = ogrid();
    const int col = tid & 31, kg = tid >> 5;
    for (int it = bid; it < 384; it += G) {
        const int l = it / 192, j0 = (it % 192) * 32;
        const float* w = p.in[zz + I_WMOD] + (size_t)l * 1024 * 6144 + j0 + col;
        float a0 = 0.f, a1 = 0.f, a2 = 0.f, a3 = 0.f, a4 = 0.f;
#pragma unroll 8
        for (int k = kg * 64; k < kg * 64 + 64; ++k) { const float wv = w[(size_t)k * 6144]; a0 += sc[k] * wv; a1 += sc[1024 + k] * wv; a2 += sc[2048 + k] * wv; a3 += sc[3072 + k] * wv; a4 += sc[4096 + k] * wv; }
        red[(kg * 5 + 0) * 32 + col] = a0; red[(kg * 5 + 1) * 32 + col] = a1; red[(kg * 5 + 2) * 32 + col] = a2; red[(kg * 5 + 3) * 32 + col] = a3; red[(kg * 5 + 4) * 32 + col] = a4;
        __syncthreads();
        if (tid < 160) { const int v = tid >> 5, c = tid & 31; float s = p.in[zz + I_BMOD][l * 6144 + j0 + c];
#pragma unroll
            for (int g = 0; g < 16; ++g) s += red[(g * 5 + v) * 32 + c];
            modv[(size_t)(l * 5 + v) * 6144 + j0 + c] = s; }
        __syncthreads();
    }
}
__device__ __forceinline__ void rope_table(const Params& p, unsigned char* ws) {
    const int zz = ozero();
    float* rc = (float*)(ws + WS_ROPE); float* rs = rc + 1024 * 16;
    const int G = ogrid(); for (int i = obid() * NTHREADS + otid(); i < 1024 * 16; i += G * NTHREADS) {
        const int pos = i >> 4, f = i & 15; const float posv = (float)(f < 8 ? (pos >> 6) : (pos & 63));
        const float inv = exp2f(-(float)(f & 7) * (13.287712379549449f / 8.0f));
        const float rev = posv * inv * 0.15915494309189535f;
        rc[i] = __builtin_amdgcn_cosf(rev); rs[i] = __builtin_amdgcn_sinf(rev);
    }
}

template <bool HAS_Y, bool DO_H>
__device__ __forceinline__ void norm_phase(const Params& p, unsigned char* ws, const float* xp, const float* xs, const float* Y, const float* gA, int gate_off, const float* modA,
                                           const float* gB, int sh_off, int sc_off, const float* modB) {
    const int zz = ozero();
    const int tid = otid(), wid = tid >> 6, lane = tid & 63; const int bid = obid(), G = ogrid();
    bf16_t* hbf = (bf16_t*)(ws + WS_HBF);
    f32x4 gav[4], gbv[4];
#pragma unroll
    for (int i = 0; i < 4; ++i) { gav[i] = HAS_Y ? *(const f32x4*)(gA + i * 256 + lane * 4) : (f32x4){0.f, 0.f, 0.f, 0.f}; gbv[i] = DO_H ? *(const f32x4*)(gB + i * 256 + lane * 4) : (f32x4){0.f, 0.f, 0.f, 0.f}; }
    int row = bid * 8 + wid;
    f32x4 xn[4], yn[4];
    if (row < MT) {
        const float* xin = row < MP ? xp + (size_t)row * D : xs + (size_t)(row - MP) * D;
#pragma unroll
        for (int i = 0; i < 4; ++i) { xn[i] = *(const f32x4*)(xin + i * 256 + lane * 4); if (HAS_Y) yn[i] = *(const f32x4*)(Y + (size_t)row * D + i * 256 + lane * 4); }
    }
    for (; row < MT; row += G * 8) {
        const int mv = row < MP ? 0 : 1 + ((row - MP) >> 10);
        f32x4 x[4], y[4];
#pragma unroll
        for (int i = 0; i < 4; ++i) { x[i] = xn[i]; if (HAS_Y) y[i] = yn[i]; }
        const int nrow = row + G * 8;
        if (nrow < MT) {
            const float* xin = nrow < MP ? xp + (size_t)nrow * D : xs + (size_t)(nrow - MP) * D;
#pragma unroll
            for (int i = 0; i < 4; ++i) { xn[i] = *(const f32x4*)(xin + i * 256 + lane * 4); if (HAS_Y) yn[i] = *(const f32x4*)(Y + (size_t)nrow * D + i * 256 + lane * 4); }
        }
        if (HAS_Y) {
            float ss = 0.f;
#pragma unroll
            for (int i = 0; i < 4; ++i) ss += y[i][0] * y[i][0] + y[i][1] * y[i][1] + y[i][2] * y[i][2] + y[i][3] * y[i][3];
            ss = wave_sum(ss, lane); const float rstd = rsqrtf(ss * (1.0f / D) + EPS);
            const float* mg = modA + (size_t)mv * 6144 + gate_off;
#pragma unroll
            for (int i = 0; i < 4; ++i) { const f32x4 gt = *(const f32x4*)(mg + i * 256 + lane * 4);
                x[i] = x[i] + gt * (y[i] * rstd * gav[i]); *(f32x4*)((p.out + zz) + (size_t)row * D + i * 256 + lane * 4) = x[i]; }
        }
        if (DO_H) {
            float ss = 0.f;
#pragma unroll
            for (int i = 0; i < 4; ++i) ss += x[i][0] * x[i][0] + x[i][1] * x[i][1] + x[i][2] * x[i][2] + x[i][3] * x[i][3];
            ss = wave_sum(ss, lane); const float rstd = rsqrtf(ss * (1.0f / D) + EPS);
            const float* msh = modB + (size_t)mv * 6144 + sh_off; const float* msc = modB + (size_t)mv * 6144 + sc_off;
#pragma unroll
            for (int i = 0; i < 4; ++i) { const f32x4 sh = *(const f32x4*)(msh + i * 256 + lane * 4), sc = *(const f32x4*)(msc + i * 256 + lane * 4);
                const f32x4 h = (x[i] * rstd * gbv[i]) * (sc + 1.0f) + sh; *(u32x2*)(hbf + (size_t)row * D + i * 256 + lane * 4) = pack4(h); }
        }
    }
}

__device__ __forceinline__ void postproj_phase(const Params& p, unsigned char* ws, int l) {
    const int zz = ozero();
    const int tid = otid(), wid = tid >> 6, lane = tid & 63; const int bid = obid(), G = ogrid();
    const float* psm = (const float*)(ws + WS_PSM);
    bf16_t* qn = (bf16_t*)(ws + WS_QN); bf16_t* keys = (bf16_t*)(ws + WS_KEYS); bf16_t* krb = (bf16_t*)(ws + WS_KRB);
    const float* ropec = (const float*)(ws + WS_ROPE); const float* ropes = ropec + 1024 * 16;
    const float* gq = p.in[zz + I_GQ] + l * 384; const float* gkv = p.in[zz + I_GKV] + l * 256;
    for (int t = bid * 8 + wid; t < NKEY; t += G * 8) {
        if (t < MT) {
            const float* pr = psm + (size_t)t * 768;
            f32x2 q[3]; float ss = 0.f;
#pragma unroll
            for (int i = 0; i < 3; ++i) { q[i] = *(const f32x2*)(pr + i * 128 + lane * 2); ss += q[i][0] * q[i][0] + q[i][1] * q[i][1]; }
            ss = wave_sum(ss, lane); float rstd = rsqrtf(ss * (1.0f / 384.0f) + EPS);
#pragma unroll
            for (int i = 0; i < 3; ++i) { const f32x2 g = *(const f32x2*)(gq + i * 128 + lane * 2); *(unsigned*)(qn + (size_t)t * 384 + i * 128 + lane * 2) = cvt_pk_bf16(q[i][0] * rstd * g[0], q[i][1] * rstd * g[1]); }
            f32x4 kv = *(const f32x4*)(pr + 384 + lane * 4);
            ss = wave_sum(kv[0] * kv[0] + kv[1] * kv[1] + kv[2] * kv[2] + kv[3] * kv[3], lane); rstd = rsqrtf(ss * (1.0f / 256.0f) + EPS);
            const f32x4 ckv = kv * rstd * *(const f32x4*)(gkv + lane * 4);
            const int kr = keyrow_of(t);
            *(u32x2*)(keys + (size_t)kr * 256 + lane * 4) = pack4(ckv);
            const int s = t >> 8, pp = t & 255;
            if (t < MP) *(f32x4*)((p.out + zz) + OFF_CKV + ((size_t)(s * 2 + l) * 256 + pp) * 256 + lane * 4) = ckv * OS2;
            if (lane < 16) {
                float x1 = pr[640 + lane], x2 = pr[656 + lane];
                if (t >= MP) { const int pos = (t - MP) & 1023; const float cs = ropec[pos * 16 + lane], sn = ropes[pos * 16 + lane]; const float o1 = x1 * cs - x2 * sn, o2 = x1 * sn + x2 * cs; x1 = o1; x2 = o2; }
                krb[(size_t)kr * 32 + lane] = f2bf(x1); krb[(size_t)kr * 32 + 16 + lane] = f2bf(x2);
                if (t < MP) { float* o = (p.out + zz) + OFF_KR + ((size_t)(s * 2 + l) * 256 + pp) * 32; o[lane] = x1 * OS3; o[16 + lane] = x2 * OS3; }
            }
        } else {
            const int j = t - MT, b = j >> 8, jj = j & 255, kr = MP + b * 1280 + 1024 + jj;
            const f32x4 v = *(const f32x4*)(p.in[zz + I_CCKV] + ((size_t)(b * 2 + l) * 256 + jj) * 256 + lane * 4);
            *(u32x2*)(keys + (size_t)kr * 256 + lane * 4) = pack4(v);
            if (lane < 8) { const f32x4 w = *(const f32x4*)(p.in[zz + I_CKR] + ((size_t)(b * 2 + l) * 256 + jj) * 32 + lane * 4); *(u32x2*)(krb + (size_t)kr * 32 + lane * 4) = pack4(w); }
        }
    }
}

__device__ __forceinline__ void attn_phase(const Params& p, unsigned char* ws, LAS unsigned char* lds) {
    const int zz = ozero();
    const bf16_t* Qb = (const bf16_t*)(ws + WS_QB); const bf16_t* Kn = (const bf16_t*)(ws + WS_KN); const bf16_t* KR = (const bf16_t*)(ws + WS_KRB);
    const bf16_t* Vt = (const bf16_t*)(ws + WS_VT); bf16_t* AO = (bf16_t*)(ws + WS_AO);
    LAS bf16_t* Ks = (LAS bf16_t*)lds;
    LAS bf16_t* Vs = (LAS bf16_t*)(lds + 64 * 208);
    const int tid = otid(), wid = tid >> 6, lane = tid & 63, l15 = lane & 15, quad = lane >> 4; const int bid = obid(), G = ogrid();
    const bool split = (G == 256);
    for (int it = split ? (bid < 32 ? 768 : (bid - 64 + 224) % 224) : bid; it < 768; it += split ? 224 : G) {
        int tq, kb, nk, h;
        if (it < 256) { const int b = it >> 6; h = (it >> 3) & 7; tq = MP + b * 1024 + (it & 7) * 128; kb = MP + b * 1280; nk = 1280; }
        else { const int j = it - 256, s = j >> 4; h = (j >> 1) & 7; tq = s * 256 + (j & 1) * 128; kb = s * 256; nk = 256; }
        const int qrow = tq + wid * 16 + l15;
        bf16x8 qf[3];
#pragma unroll
        for (int ks = 0; ks < 3; ++ks) qf[ks] = *(const bf16x8*)(Qb + (size_t)qrow * 768 + h * 96 + ks * 32 + quad * 8);
        f32x4 o[4];
#pragma unroll
        for (int i = 0; i < 4; ++i) o[i] = (f32x4){0.f, 0.f, 0.f, 0.f};
        float mrun = -1e30f, lsum = 0.f;
        for (int k0 = 0; k0 < nk; k0 += 64) {
            __syncthreads();
            for (int c = tid; c < 768; c += NTHREADS) { const int r = c / 12, cc = c % 12;
                const bf16_t* src = cc < 8 ? Kn + (size_t)(kb + k0 + r) * 512 + h * 64 + cc * 8 : KR + (size_t)(kb + k0 + r) * 32 + (cc - 8) * 8;
                *(LAS u32x4*)(Ks + r * 104 + cc * 8) = *(const u32x4*)src; }
            { const int r = tid >> 3, cc = tid & 7; *(LAS u32x4*)(Vs + r * 72 + cc * 8) = *(const u32x4*)(Vt + (size_t)(h * 64 + r) * NKEY + kb + k0 + cc * 8); }
            __syncthreads();
            f32x4 s[4];
#pragma unroll
            for (int js = 0; js < 4; ++js) { s[js] = (f32x4){0.f, 0.f, 0.f, 0.f};
#pragma unroll
                for (int ks = 0; ks < 3; ++ks) { const bf16x8 a = *(const LAS bf16x8*)(Ks + (js * 16 + l15) * 104 + ks * 32 + quad * 8); s[js] = __builtin_amdgcn_mfma_f32_16x16x32_bf16(a, qf[ks], s[js], 0, 0, 0); } }
            float mx = s[0][0];
#pragma unroll
            for (int js = 0; js < 4; ++js)
#pragma unroll
                for (int j = 0; j < 4; ++j) mx = fmaxf(mx, s[js][j]);
            mx = fmaxf(mx, shfl_idx(mx, lane ^ 16)); mx = fmaxf(mx, shfl_idx(mx, lane ^ 32));
            const float mnew = fmaxf(mrun, mx), alpha = __builtin_amdgcn_exp2f(mrun - mnew); mrun = mnew;
            float psum = 0.f;
#pragma unroll
            for (int js = 0; js < 4; ++js)
#pragma unroll
                for (int j = 0; j < 4; ++j) { s[js][j] = __builtin_amdgcn_exp2f(s[js][j] - mnew); psum += s[js][j]; }
            lsum = lsum * alpha + psum;
#pragma unroll
            for (int i = 0; i < 4; ++i) o[i] *= alpha;
#pragma unroll
            for (int kk = 0; kk < 2; ++kk) {
                const u32x4 pw = pack8(s[2 * kk], s[2 * kk + 1]); bf16x8 pf; __builtin_memcpy(&pf, &pw, 16);
#pragma unroll
                for (int dv = 0; dv < 4; ++dv) {
                    const LAS bf16_t* vp = Vs + (dv * 16 + l15) * 72 + kk * 32 + quad * 4;
                    u32x4 vw; const u32x2 v0 = *(const LAS u32x2*)vp, v1 = *(const LAS u32x2*)(vp + 16); vw.x = v0.x; vw.y = v0.y; vw.z = v1.x; vw.w = v1.y;
                    bf16x8 va; __builtin_memcpy(&va, &vw, 16);
                    o[dv] = __builtin_amdgcn_mfma_f32_16x16x32_bf16(va, pf, o[dv], 0, 0, 0);
                }
            }
        }
        lsum += shfl_idx(lsum, lane ^ 16); lsum += shfl_idx(lsum, lane ^ 32);
        const float inv = 1.0f / lsum;
#pragma unroll
        for (int dv = 0; dv < 4; ++dv) *(u32x2*)(AO + (size_t)qrow * 512 + h * 64 + dv * 16 + quad * 4) = pack4(o[dv] * inv);
    }
}

template <int DIR>
__device__ __forceinline__ void scan_pass(const Params& p, unsigned char* ws, int l, int n, int tok0, int L, float h0, bool write_state, int state_idx, LAS unsigned char* lds) {
    const int zz = ozero();
    LAS float* xcf = (LAS float*)lds;
    LAS bf16_t* xcb = (LAS bf16_t*)(lds + 64 * 132 * 4);
    const int tid = otid(), wid = tid >> 6, lane = tid & 63, l15 = lane & 15, quad = lane >> 4;
    const int chl = wid * 16 + l15, ch = n * 128 + chl;
    const float* LXp = (const float*)(ws + WS_LX); bf16_t* HF = (bf16_t*)(ws + WS_SG) + 1024;   bf16_t* GG = (bf16_t*)(ws + WS_GG);
    const float lam = p.in[zz + I_LAM][(l * 2 + DIR) * 1024 + ch];
    const float nl = -lam, sp = fmaxf(nl, 0.f) + log1pf(__expf(-fabsf(nl)));
    const float cc = -8.0f * sp * LOG2E;
    const float br = p.in[zz + I_BRG][(l * 2 + DIR) * 1024 + ch], bi = p.in[zz + I_BIG][(l * 2 + DIR) * 1024 + ch];
    const bf16_t* wg = (const bf16_t*)(ws + WS_WG) + (size_t)((DIR * 8 + n) * 256) * 128;
    bf16x8 wrf[4], wif[4];
#pragma unroll
    for (int ks = 0; ks < 4; ++ks) { wrf[ks] = *(const bf16x8*)(wg + (size_t)chl * 128 + ks * 32 + quad * 8); wif[ks] = *(const bf16x8*)(wg + (size_t)(128 + chl) * 128 + ks * 32 + quad * 8); }
    const int c4 = (tid & 31) * 4, tg = tid >> 5;
    const float* cw = p.in[zz + I_CONVW] + (size_t)l * 4 * 1024 + n * 128 + c4;
    const f32x4 w0 = *(const f32x4*)cw, w1 = *(const f32x4*)(cw + 1024), w2 = *(const f32x4*)(cw + 2048), w3 = *(const f32x4*)(cw + 3072);
    const f32x4 cb = *(const f32x4*)(p.in[zz + I_CONVB] + l * 1024 + n * 128 + c4);
    float hin = h0;
    const int nchunk = L >> 6;
    f32x4 xr[7];
    {
        const int t0f = (DIR ? nchunk - 1 : 0) * 64;
#pragma unroll
        for (int r = 0; r < 7; ++r) { const int tt = t0f + tg * 4 - 2 + r; xr[r] = (tt >= 0 && tt < L) ? *(const f32x4*)(LXp + (size_t)(tok0 + tt) * 1024 + n * 128 + c4) : (f32x4){0.f, 0.f, 0.f, 0.f}; }
    }
    for (int ci = 0; ci < nchunk; ++ci) {
        const int t0 = (DIR ? nchunk - 1 - ci : ci) * 64;
        __syncthreads();
#pragma unroll
        for (int j = 0; j < 4; ++j) { const f32x4 xc = cb + xr[j] * w0 + xr[j + 1] * w1 + xr[j + 2] * w2 + xr[j + 3] * w3;
            *(LAS f32x4*)(xcf + (tg * 4 + j) * 132 + c4) = xc; *(LAS u32x2*)(xcb + (tg * 4 + j) * 136 + c4) = pack4(xc); }
        __syncthreads();
        if (ci + 1 < nchunk) {
            const int t0n = (DIR ? nchunk - 2 - ci : ci + 1) * 64;
#pragma unroll
            for (int r = 0; r < 7; ++r) { const int tt = t0n + tg * 4 - 2 + r; xr[r] = (tt >= 0 && tt < L) ? *(const f32x4*)(LXp + (size_t)(tok0 + tt) * 1024 + n * 128 + c4) : (f32x4){0.f, 0.f, 0.f, 0.f}; }
        }
        typedef unsigned short us2 __attribute__((ext_vector_type(2)));
        us2 hg[4][4];
        if (DIR == 1) {
#pragma unroll
            for (int st = 0; st < 4; ++st)
#pragma unroll
                for (int j = 0; j < 4; ++j) { const size_t idx = (size_t)(tok0 + t0 + st * 16 + quad * 4 + j) * 1024 + ch; hg[st][j].x = HF[idx + (idx - ch)]; hg[st][j].y = GG[idx]; }
        }
        f32x4 rg[4], ig[4];
#pragma unroll
        for (int st = 0; st < 4; ++st) { rg[st] = (f32x4){0.f, 0.f, 0.f, 0.f}; ig[st] = (f32x4){0.f, 0.f, 0.f, 0.f};
#pragma unroll
            for (int ks = 0; ks < 4; ++ks) { const bf16x8 a = *(const LAS bf16x8*)(xcb + (st * 16 + l15) * 136 + ks * 32 + quad * 8);
                rg[st] = __builtin_amdgcn_mfma_f32_16x16x32_bf16(a, wrf[ks], rg[st], 0, 0, 0); ig[st] = __builtin_amdgcn_mfma_f32_16x16x32_bf16(a, wif[ks], ig[st], 0, 0, 0); } }
#pragma unroll
        for (int sti = 0; sti < 4; ++sti) {
            const int st = DIR ? 3 - sti : sti;
            float av[4], hv[4], pa[4];
#pragma unroll
            for (int j = 0; j < 4; ++j) { const float x = xcf[(st * 16 + quad * 4 + j) * 132 + chl];
                const float rr = fast_sigmoid(rg[st][j] + br), ii = fast_sigmoid(ig[st][j] + bi);
                const float a = __builtin_amdgcn_exp2f(cc * rr); av[j] = a; hv[j] = __builtin_amdgcn_sqrtf(fmaxf(1.0f - a * a, 0.f)) * ii * x; }
            float hl = 0.f, pr = 1.f;
#pragma unroll
            for (int s4 = 0; s4 < 4; ++s4) { const int j = DIR ? 3 - s4 : s4; hl = av[j] * hl + hv[j]; pr *= av[j]; hv[j] = hl; pa[j] = pr; }
            float Ar = 1.f, Hr = 0.f, Aex = 1.f, Hex = 0.f;
#pragma unroll
            for (int s4 = 0; s4 < 4; ++s4) { const int qq = DIR ? 3 - s4 : s4; const float Aq = shfl_idx(pr, qq * 16 + l15), Hq = shfl_idx(hl, qq * 16 + l15);
                if (qq == quad) { Aex = Ar; Hex = Hr; }
                Hr = Aq * Hr + Hq; Ar *= Aq; }
            const float cq = Aex * hin + Hex;
            hin = Ar * hin + Hr;
#pragma unroll
            for (int j = 0; j < 4; ++j) { const float hfin = hv[j] + pa[j] * cq; const size_t idx = (size_t)(tok0 + t0 + st * 16 + quad * 4 + j) * 1024 + ch;
                if (DIR == 0) HF[idx + (idx - ch)] = f2bf(hfin);
                else GG[idx] = f2bf((bf2f(hg[st][j].x) + hfin) * bf2f(hg[st][j].y)); }
        }
    }
    if (write_state && quad == 0) (p.out + zz)[(DIR ? OFF_LB : OFF_LF) + state_idx + ch] = hin * (DIR ? OS5 : OS4);
}
__device__ __forceinline__ void scan_phase(const Params& p, unsigned char* ws, int l, LAS unsigned char* lds) {
    const int zz = ozero();
    const int tid = otid(), l15 = tid & 15, wid = tid >> 6; const int bid = obid(), G = ogrid();
    for (int rr = 0; rr < 2; ++rr) {
        const int it = rr == 0 ? bid : ((G == 256 && bid >= 32 && bid < 64) ? 224 + bid : (G == 256 ? 288 : bid + G));
        if (it >= 288) break;
        int n, tok0, L, sidx; bool lat; float hf0 = 0.f, hb0 = 0.f;
        if (it < 32) { const int b = it >> 3; n = it & 7; tok0 = MP + b * 1024; L = 1024; lat = true; sidx = 0; const int ch = n * 128 + wid * 16 + l15;
            hf0 = p.in[zz + I_SF][(b * 2 + l) * 1024 + ch]; hb0 = p.in[zz + I_SB][(b * 2 + l) * 1024 + ch]; }
        else { const int j = it - 32, s = j >> 3; n = j & 7; tok0 = s * 256; L = 256; lat = false; sidx = (s * 2 + l) * 1024; }
        scan_pass<0>(p, ws, l, n, tok0, L, hf0, !lat, sidx, lds);
        scan_pass<1>(p, ws, l, n, tok0, L, hb0, !lat, sidx, lds);
    }
}

__device__ __forceinline__ unsigned char* opq_unused(unsigned char* x) { asm volatile("" : "+s"(x)); return x; }
__device__ __forceinline__ void grid_sync_all(unsigned* bar, int k, int G) {
    asm volatile("s_waitcnt vmcnt(0) lgkmcnt(0)" ::: "memory");
    __syncthreads();
    const int t = otid();
    if (k == 0) {
        if (t < 64) { __builtin_amdgcn_fence(__ATOMIC_RELEASE, "agent"); asm volatile("s_waitcnt vmcnt(0) lgkmcnt(0)" ::: "memory"); }
        cg::this_grid().sync();
    } else if (t < 64) {
        __builtin_amdgcn_fence(__ATOMIC_RELEASE, "agent"); asm volatile("s_waitcnt vmcnt(0) lgkmcnt(0)" ::: "memory");
        if (t == 0) {
            __hip_atomic_fetch_add(bar, 1u, __ATOMIC_RELAXED, __HIP_MEMORY_SCOPE_AGENT);
            const unsigned want = (unsigned)k * (unsigned)G;
            while (__hip_atomic_load(bar, __ATOMIC_RELAXED, __HIP_MEMORY_SCOPE_AGENT) < want) __builtin_amdgcn_s_sleep(2);
        }
    }
    if (t < 64) { __builtin_amdgcn_fence(__ATOMIC_ACQUIRE, "agent"); asm volatile("s_waitcnt vmcnt(0) lgkmcnt(0)" ::: "memory"); }
    __syncthreads();
}
__global__ void __launch_bounds__(NTHREADS) fwd_megakernel(Params p) {
    extern __shared__ __attribute__((aligned(16))) unsigned char smem[];
    LAS unsigned char* lds = (LAS unsigned char*)smem;
    int nsync = 0; unsigned* gbar = (unsigned*)(p.ws + WS_BAR);
    int ph = 0; (void)ph; int phc = 0; (void)phc;
#if defined(STOP_AFTER)
#define PHASE_IF if (phc <= STOP_AFTER)
#define PHASE_END do { ++phc; grid_sync_all(gbar, nsync++, (int)gridDim.x); } while (0)
#elif ONE_LAUNCH
#define PHASE_IF
#define PHASE_END do { grid_sync_all(gbar, nsync++, (int)gridDim.x); } while (0)
#else
#define PHASE_IF if (__builtin_amdgcn_readfirstlane((int)(ph >= p.ph_lo && ph < p.ph_hi)))
#define PHASE_END do { ++ph; } while (0)
#endif

    PHASE_IF PHK(0) { const int zz = ozero(); unsigned char* ws = p.ws + zz; const int G = ogrid(), bid = obid(); (void)G; (void)bid; const float* modv = (const float*)(ws + WS_MODV); const float* modl = modv; (void)modl;
        rope_table(p, ws);
        modv_phase(p, ws, (LAS float*)lds);
        for (int i = bid; i < CONV_ITEMS; i += 2 * G) { const bool hb = i + G < CONV_ITEMS; const CJob ja = conv_decode(p, ws, 0, i), jb = conv_decode(p, ws, 0, hb ? i + G : i); conv_pair(ja, jb, hb, (LAS float*)lds); }
    }
    PHASE_END;
    PHASE_IF PHK(1) { const int zz = ozero(); unsigned char* ws = p.ws + zz; const int G = ogrid(), bid = obid(); (void)G; (void)bid; const float* modv = (const float*)(ws + WS_MODV); const float* modl = modv; (void)modl; norm_phase<false, true>(p, ws, p.in[zz + I_XP], p.in[zz + I_XS], nullptr, nullptr, 0, nullptr, p.in[zz + I_GPM], 0, 1024, modv); }
    PHASE_END;
#pragma unroll 1
    for (int l = 0; l < 2; ++l) {
        PHASE_IF PHK(2) { const int zz = ozero(); unsigned char* ws = p.ws + zz; const int G = ogrid(), bid = obid(); (void)G; (void)bid; const float* modv = (const float*)(ws + WS_MODV); const float* modl = modv + (size_t)l * 5 * 6144; (void)modl; pg8::Gemm g{(const bf16_t*)(ws + WS_HBF), (const bf16_t*)(ws + WS_WIN), MT, INCP, 1024}; pg8::StaticOrder S; S.init(MT, INCP, G, bid);
            EpiIn E{(float*)(ws + WS_PSM), (float*)(ws + WS_LX), (bf16_t*)(ws + WS_GG), (bf16_t*)(ws + WS_SG), (bf16_t*)(ws + WS_HF)}; pg8::gemm_phase(lds, g, S, E); }
        PHASE_END;
        PHASE_IF PHK(3) { const int zz = ozero(); unsigned char* ws = p.ws + zz; const int G = ogrid(), bid = obid(); (void)G; (void)bid; const float* modv = (const float*)(ws + WS_MODV); const float* modl = modv + (size_t)l * 5 * 6144; (void)modl; postproj_phase(p, ws, l); }
        PHASE_END;
        PHASE_IF PHK(4) { const int zz = ozero(); unsigned char* ws = p.ws + zz; const int G = ogrid(), bid = obid(); (void)G; (void)bid; const float* modv = (const float*)(ws + WS_MODV); const float* modl = modv + (size_t)l * 5 * 6144; (void)modl;
            { pg8::Gemm g{(const bf16_t*)(ws + WS_QN), (const bf16_t*)(ws + WS_WQ), MT, 768, 384}; pg8::StaticOrder S; S.init(MT, 768, G, bid);
              EpiQ E{(bf16_t*)(ws + WS_QB), (const float*)(ws + WS_ROPE), (const float*)(ws + WS_ROPE) + 1024 * 16}; pg8::gemm_phase(lds, g, S, E); }
            { pg8::Gemm g{(const bf16_t*)(ws + WS_KEYS), (const bf16_t*)(ws + WS_WKV), NKEY, 512, 256}; pg8::StaticOrder S; S.init(NKEY, 512, G, (bid + G - 144 % G) % G);
              EpiBf16 E{(bf16_t*)(ws + WS_KN), 512}; pg8::gemm_phase(lds, g, S, E); }
            { pg8::Gemm g{(const bf16_t*)(ws + WS_WKV) + (size_t)512 * 256, (const bf16_t*)(ws + WS_KEYS), 512, NKEY, 256}; pg8::StaticOrder S; S.init(512, NKEY, G, (bid + G - 248 % G) % G);
              EpiBf16 E{(bf16_t*)(ws + WS_VT), NKEY}; pg8::gemm_phase(lds, g, S, E); }
        }
        PHASE_END;
        PHASE_IF PHK(5) { const int zz = ozero(); unsigned char* ws = p.ws + zz; const int G = ogrid(), bid = obid(); (void)G; (void)bid; const float* modv = (const float*)(ws + WS_MODV); const float* modl = modv + (size_t)l * 5 * 6144; (void)modl; attn_phase(p, ws, lds); }
        PHASE_IF PHK(6) { const int zz = ozero(); unsigned char* ws = p.ws + zz; const int G = ogrid(), bid = obid(); (void)G; (void)bid; const float* modv = (const float*)(ws + WS_MODV); const float* modl = modv + (size_t)l * 5 * 6144; (void)modl; scan_phase(p, ws, l, lds); }
        PHASE_END;
        PHASE_IF PHK(7) { const int zz = ozero(); unsigned char* ws = p.ws + zz; const int G = ogrid(), bid = obid(); (void)G; (void)bid; const float* modv = (const float*)(ws + WS_MODV); const float* modl = modv + (size_t)l * 5 * 6144; (void)modl;
            { pg8::Gemm g{(const bf16_t*)(ws + WS_AO), (const bf16_t*)(ws + WS_WOMLA), MT, 1024, 512}; pg8::StaticOrder S; S.init(MT, 1024, G, bid);
              EpiMla E{(float*)(ws + WS_LX), (const bf16_t*)(ws + WS_SG)}; pg8::gemm_phase(lds, g, S, E); }
            { pg8::Gemm g{(const bf16_t*)(ws + WS_GG), (const bf16_t*)(ws + WS_WOLRU), MT, 1024, 1024}; pg8::StaticOrder S; S.init(MT, 1024, G, bid);
              EpiLru E{(const float*)(ws + WS_LX), (const bf16_t*)(ws + WS_SG), (bf16_t*)(ws + WS_Z), (const bf16_t*)(ws + WS_HF)}; pg8::gemm_phase(lds, g, S, E); }
        }
        PHASE_END;
        PHASE_IF PHK(8) { const int zz = ozero(); unsigned char* ws = p.ws + zz; const int G = ogrid(), bid = obid(); (void)G; (void)bid; const float* modv = (const float*)(ws + WS_MODV); const float* modl = modv + (size_t)l * 5 * 6144; (void)modl; pg8::Gemm g{(const bf16_t*)(ws + WS_Z), (const bf16_t*)(ws + WS_WOUT), MT, 1024, 1024}; pg8::StaticOrder S; S.init(MT, 1024, G, bid);
            EpiF32 E{(float*)(ws + WS_LX), 1024}; pg8::gemm_phase(lds, g, S, E); }
        PHASE_END;
        PHASE_IF PHK(9) { const int zz = ozero(); unsigned char* ws = p.ws + zz; const int G = ogrid(), bid = obid(); (void)G; (void)bid; const float* modv = (const float*)(ws + WS_MODV); const float* modl = modv + (size_t)l * 5 * 6144; (void)modl; const float* xp = l == 0 ? p.in[zz + I_XP] : (p.out + zz); const float* xs = l == 0 ? p.in[zz + I_XS] : (p.out + zz) + (size_t)MP * D; norm_phase<true, true>(p, ws, xp, xs, (const float*)(ws + WS_LX), p.in[zz + I_GQM] + l * D, 2048, modl, p.in[zz + I_GPF] + l * D, 3072, 4096, modl); }
        PHASE_END;
        PHASE_IF PHK(10) { const int zz = ozero(); unsigned char* ws = p.ws + zz; const int G = ogrid(), bid = obid(); (void)G; (void)bid; const float* modv = (const float*)(ws + WS_MODV); const float* modl = modv + (size_t)l * 5 * 6144; (void)modl; pg8::Gemm g{(const bf16_t*)(ws + WS_HBF), (const bf16_t*)(ws + WS_WFFI), MT, 5632, 1024}; pg8::StaticOrder S; S.init(MT, 5632, G, bid);
            EpiFfi E{(bf16_t*)(ws + WS_HID)}; pg8::gemm_phase(lds, g, S, E); }
        PHASE_END;
        PHASE_IF PHK(11) { const int zz = ozero(); unsigned char* ws = p.ws + zz; const int G = ogrid(), bid = obid(); (void)G; (void)bid; const float* modv = (const float*)(ws + WS_MODV); const float* modl = modv + (size_t)l * 5 * 6144; (void)modl; pg8::Gemm g{(const bf16_t*)(ws + WS_HID), (const bf16_t*)(ws + WS_WFFO), MT, 1024, FF}; pg8::StaticOrder S; S.init(MT, 1024, G, bid);
            EpiF32 E{(float*)(ws + WS_LX), 1024}; pg8::gemm_phase(lds, g, S, E); }
        PHASE_END;
        PHASE_IF PHK(12) { const int zz = ozero(); unsigned char* ws = p.ws + zz; const int G = ogrid(), bid = obid(); (void)G; (void)bid; const float* modv = (const float*)(ws + WS_MODV); const float* modl = modv + (size_t)l * 5 * 6144; (void)modl;
            if (l == 0) {
                norm_phase<true, true>(p, ws, (p.out + zz), (p.out + zz) + (size_t)MP * D, (const float*)(ws + WS_LX), p.in[zz + I_GQF], 5120, modl, p.in[zz + I_GPM] + D, 0, 1024, modv + (size_t)5 * 6144);
                for (int i = bid; i < CONV_ITEMS; i += 2 * G) { const bool hb = i + G < CONV_ITEMS; const CJob ja = conv_decode(p, ws, 1, i), jb = conv_decode(p, ws, 1, hb ? i + G : i); conv_pair(ja, jb, hb, (LAS float*)lds); }
            } else {
                norm_phase<true, false>(p, ws, (p.out + zz), (p.out + zz) + (size_t)MP * D, (const float*)(ws + WS_LX), p.in[zz + I_GQF] + D, 5120, modl, nullptr, 0, 0, nullptr);
            }
        }
#if ONE_LAUNCH && !defined(STOP_AFTER)
        if (l == 0) grid_sync_all(gbar, nsync++, (int)gridDim.x);
#else
        PHASE_END;
#endif
    }
#if defined(STOP_AFTER)
    {
        const int tid = otid(), bid = obid(), G = ogrid(); const unsigned* wsu = (const unsigned*)p.ws; float* out = p.out;
        for (int i = bid * NTHREADS + tid; i < 17432576; i += G * NTHREADS) { float a = 0.f;
#pragma unroll
            for (int j = 0; j < 4; ++j) { const size_t idx = (size_t)i + (size_t)j * 17432576; if (idx * 4 < WS_END) { const unsigned u = wsu[idx]; a += (float)(u & 0xffu) + (float)((u >> 16) & 0xffu); } }
            out[i] = a; }
    }
#endif
}
constexpr int NPHASES = 2 + 11 * 2;

extern "C" void kernel_launch(void* const* d_in, const int* in_sizes, int n_in, void* d_out, int out_size, void* d_ws, size_t ws_size, hipStream_t stream) {
    static int grid = 0;
    if (grid == 0) {
        if (n_in != 31 || ws_size < WS_END) { fprintf(stderr, "kernel_launch: need 31 inputs and %zu bytes of workspace (got %d, %zu)\n", (size_t)WS_END, n_in, ws_size); grid = -1; return; }
        if (hipFuncSetAttribute((const void*)fwd_megakernel, hipFuncAttributeMaxDynamicSharedMemorySize, LDS_BYTES) != hipSuccess) { fprintf(stderr, "kernel_launch: hipFuncSetAttribute failed\n"); grid = -1; return; }
        int dev = 0, cus = 0, per_cu = 0;
        hipGetDevice(&dev); hipDeviceGetAttribute(&cus, hipDeviceAttributeMultiprocessorCount, dev);
        hipOccupancyMaxActiveBlocksPerMultiprocessor(&per_cu, (const void*)fwd_megakernel, NTHREADS, LDS_BYTES);
        if (per_cu < 1) { fprintf(stderr, "kernel_launch: occupancy query says %d blocks/CU\n", per_cu); per_cu = 1; }
        (void)hipGetLastError();
        grid = cus;
    }
    if (grid < 0) return;
    (void)hipMemsetAsync((unsigned char*)d_ws + WS_BAR, 0, 256, stream);
    Params p{};
    for (int i = 0; i < 31; ++i) p.in[i] = (const float*)d_in[i];
    p.out = (float*)d_out; p.ws = (unsigned char*)d_ws;
#if ONE_LAUNCH
    p.ph_lo = 0; p.ph_hi = NPHASES; p.coop = 1;
    void* args[] = {&p};
    hipError_t e = hipLaunchCooperativeKernel((const void*)fwd_megakernel, dim3(grid), dim3(NTHREADS), args, LDS_BYTES, stream);
    if (e != hipSuccess) fprintf(stderr, "cooperative launch failed: %s (grid %d)\n", hipGetErrorString(e), grid);
#else
    for (int ph = 0; ph < NPHASES; ++ph) {
        p.ph_lo = ph; p.ph_hi = ph + 1; p.coop = 0;
        hipLaunchKernelGGL(fwd_megakernel, dim3(grid), dim3(NTHREADS), LDS_BYTES, stream, p);
    }
#endif
}
```
